# Optimizing an MI355X kernel written in HIP

```python
import math
import jax, jax.numpy as jnp
from jax import lax
import numpy as np

D_MODEL = 1024
BATCH = 8
SEQ = 2048
DEPTH = 2
DEC_BATCH = 128
DEC_SEQ = 1
PAST_LEN = 16384
PAGE_SIZE = 128

D_A = D_MODEL // 2
D_B = D_MODEL // 2
D_MIX = D_A + D_B
N_POOL = 4
POOL_WINDOWS = (2, 4, 8, 16)
POOL_GC = D_A // N_POOL
POOL_BUF = max(POOL_WINDOWS) - 1
HEAD_DIM = 128
N_HEADS_B = D_B // HEAD_DIM
D_QKV = 3 * D_B
CONV_K = 4
GDN_CHUNK = 64
D_IN = 2 * D_A + D_QKV + D_B + 2 * N_HEADS_B
EPS = 1e-6

kernel_name = 'hybrid_pool_gdn_decoder_step'


def rms_norm(x, w):
    xf = x.astype(jnp.float32)
    y = xf * lax.rsqrt(jnp.mean(xf * xf, axis=-1, keepdims=True) + EPS)
    return (y * w.astype(jnp.float32)).astype(x.dtype)


def l2_normalize(x):
    return x * lax.rsqrt(jnp.sum(x * x, axis=-1, keepdims=True) + EPS)


def causal_conv(u, buf, w):
    T = u.shape[1]
    xx = jnp.concatenate([buf.astype(u.dtype), u], axis=1)
    out = sum(xx[:, j:j + T] * w[j] for j in range(CONV_K))
    return jax.nn.silu(out), xx[:, -(CONV_K - 1):]


def pool_mix(u, buf, start_pos, w_pool, scale):
    B, T, _ = u.shape
    xx = jnp.concatenate([buf.astype(u.dtype), u], axis=1)
    xf = xx.astype(jnp.float32)
    cs = jnp.concatenate([jnp.zeros((B, 1, D_A), jnp.float32), jnp.cumsum(xf, axis=1)], axis=1)
    pos = start_pos + jnp.arange(T)
    outs = []
    for gi, w in enumerate(POOL_WINDOWS):
        sl = slice(gi * POOL_GC, (gi + 1) * POOL_GC)
        win = cs[:, POOL_BUF + 1:POOL_BUF + 1 + T, sl] - cs[:, POOL_BUF + 1 - w:POOL_BUF + 1 - w + T, sl]
        cnt = jnp.minimum(pos + 1, w).astype(jnp.float32)
        outs.append(win / cnt[None, :, None])
    pooled = jnp.concatenate(outs, axis=-1) - u.astype(jnp.float32)
    pooled = pooled.reshape(B, T, N_POOL, POOL_GC)
    y = jnp.einsum('btgc,gcd->btgd', pooled, w_pool.astype(jnp.float32)).reshape(B, T, D_A)
    y = y * scale.astype(jnp.float32)
    return y.astype(u.dtype), xx[:, -POOL_BUF:]


def gdn_chunked(q, k, v, g, beta, S0):
    B, T, H, DK = q.shape
    DV = v.shape[-1]
    C = GDN_CHUNK
    n = -(-T // C)
    pad = n * C - T

    def to_chunks(a):
        a = jnp.pad(a, [(0, 0), (0, pad)] + [(0, 0)] * (a.ndim - 2))
        a = a.reshape((B, n, C) + a.shape[2:])
        return jnp.moveaxis(a, (1, 3), (0, 2))

    qc, kc, vc, gc, bc = (to_chunks(a) for a in (q, k, v, g, beta))
    gc = jnp.cumsum(gc, axis=-1)
    idx = jnp.arange(C)
    causal = idx[:, None] >= idx[None, :]
    strict = idx[:, None] > idx[None, :]
    decay = jnp.exp(jnp.where(causal, gc[..., :, None] - gc[..., None, :], -jnp.inf))
    kb = kc * bc[..., None]
    vb = vc * bc[..., None]
    Lm = jnp.where(strict, jnp.einsum('nbhid,nbhjd->nbhij', kb, kc) * decay, 0.0)
    A = Lm + jnp.eye(C, dtype=Lm.dtype)
    rhs = jnp.concatenate([vb, kb * jnp.exp(gc)[..., None]], axis=-1)
    sol = lax.linalg.triangular_solve(A, rhs, left_side=True, lower=True, unit_diagonal=True)
    uc, wc = sol[..., :DV], sol[..., DV:]
    qk = jnp.einsum('nbhid,nbhjd->nbhij', qc, kc) * decay
    qg = qc * jnp.exp(gc)[..., None]
    kg = kc * jnp.exp(gc[..., -1:] - gc)[..., None]
    g_last = jnp.exp(gc[..., -1])

    def step(S, xs):
        qg_i, kg_i, u_i, w_i, qk_i, gl_i = xs
        v_new = u_i - jnp.einsum('bhcd,bhde->bhce', w_i, S)
        o = jnp.einsum('bhcd,bhde->bhce', qg_i, S) + jnp.einsum('bhij,bhje->bhie', qk_i, v_new)
        S = S * gl_i[..., None, None] + jnp.einsum('bhcd,bhce->bhde', kg_i, v_new)
        return S, o

    S, o = lax.scan(step, S0, (qg, kg, uc, wc, qk, g_last))
    o = jnp.moveaxis(o, (0, 2), (1, 3)).reshape(B, n * C, H, DV)[:, :T]
    return o, S


def gdn_recurrent(q, k, v, g, beta, S0):
    xs = tuple(jnp.moveaxis(a, 1, 0) for a in (q, k, v, g, beta))

    def step(S, xt):
        q_t, k_t, v_t, g_t, b_t = xt
        S = S * jnp.exp(g_t)[..., None, None]
        kv = jnp.einsum('bhd,bhde->bhe', k_t, S)
        delta = (v_t - kv) * b_t[..., None]
        S = S + jnp.einsum('bhd,bhe->bhde', k_t, delta)
        o = jnp.einsum('bhd,bhde->bhe', q_t, S)
        return S, o

    S, o = lax.scan(step, S0, xs)
    return jnp.moveaxis(o, 0, 1), S


def mixer_layer(x, c, start_pos, pool_buf, conv_buf, S0, chunked,
                w_ada, b_ada, pre_norm_w, post_norm_w, w_in, conv_w, pool_w, pool_scale,
                a_log, dt_bias, o_norm_w, w_out):
    B, T, _ = x.shape
    mod = jax.nn.silu(c) @ w_ada + b_ada
    shift, scale, gate = jnp.split(mod, 3, axis=-1)
    h = rms_norm(x, pre_norm_w) * (1.0 + scale[:, None]) + shift[:, None]
    proj = h @ w_in
    cuts = np.cumsum([D_A, D_A, D_QKV, D_B, N_HEADS_B]).tolist()
    u_a, z_a, qkv, z_b, b_raw, a_raw = jnp.split(proj, cuts, axis=-1)

    y_a, new_pool = pool_mix(u_a, pool_buf, start_pos, pool_w, pool_scale)
    y_a = y_a * jax.nn.silu(z_a)

    qkv_c, new_conv = causal_conv(qkv, conv_buf, conv_w)
    qkv_c = qkv_c.astype(jnp.float32)
    q, k, v = (a.reshape(B, T, N_HEADS_B, HEAD_DIM) for a in jnp.split(qkv_c, 3, axis=-1))
    q = l2_normalize(q) * (HEAD_DIM ** -0.5)
    k = l2_normalize(k)
    beta = jax.nn.sigmoid(b_raw.astype(jnp.float32))
    g = -jnp.exp(a_log.astype(jnp.float32)) * jax.nn.softplus(a_raw.astype(jnp.float32) + dt_bias.astype(jnp.float32))
    S0f = S0.astype(jnp.float32)
    if chunked:
        o, S = gdn_chunked(q, k, v, g, beta, S0f)
    else:
        o, S = gdn_recurrent(q, k, v, g, beta, S0f)
    o = rms_norm(o, o_norm_w) * jax.nn.silu(z_b.astype(jnp.float32)).reshape(B, T, N_HEADS_B, HEAD_DIM)
    y_b = o.reshape(B, T, D_B).astype(x.dtype)

    y = jnp.concatenate([y_a, y_b], axis=-1) @ w_out
    x = x + gate[:, None] * rms_norm(y, post_norm_w)
    return x, new_pool, new_conv, S.astype(S0.dtype)


def setup_inputs(seed: int = 0) -> dict:
    key = jax.random.key(seed)
    ks = jax.random.split(key, 20)

    def nrm(k, shape, s):
        return jax.random.normal(k, shape, jnp.float32) * s

    dt = jnp.exp(jax.random.uniform(ks[16], (DEPTH, N_HEADS_B), jnp.float32, math.log(1e-3), math.log(1e-1)))
    return {
        'x_prompt': nrm(ks[0], (BATCH, SEQ, D_MODEL), 1.0),
        'x_sample': nrm(ks[1], (DEC_BATCH, DEC_SEQ, D_MODEL), 1.0),
        'c_prompt': nrm(ks[2], (BATCH, D_MODEL), 1.0),
        'c_sample': nrm(ks[3], (DEC_BATCH, D_MODEL), 1.0),
        'state_pool': nrm(ks[4], (DEPTH, DEC_BATCH, POOL_BUF, D_A), 1.0),
        'state_conv': nrm(ks[5], (DEPTH, DEC_BATCH, CONV_K - 1, D_QKV), 1.0),
        'state_ssm': nrm(ks[6], (DEPTH, DEC_BATCH, N_HEADS_B, HEAD_DIM, HEAD_DIM), 0.05),
        'w_ada': nrm(ks[7], (DEPTH, D_MODEL, 3 * D_MODEL), 0.1 * D_MODEL ** -0.5),
        'b_ada': nrm(ks[8], (DEPTH, 3 * D_MODEL), 0.01),
        'pre_norm_w': 1.0 + nrm(ks[9], (DEPTH, D_MODEL), 0.05),
        'post_norm_w': 1.0 + nrm(ks[10], (DEPTH, D_MODEL), 0.05),
        'w_in': nrm(ks[11], (DEPTH, D_MODEL, D_IN), D_MODEL ** -0.5),
        'conv_w': nrm(ks[12], (DEPTH, CONV_K, D_QKV), CONV_K ** -0.5),
        'pool_w': nrm(ks[13], (DEPTH, N_POOL, POOL_GC, POOL_GC), POOL_GC ** -0.5),
        'pool_scale': 1.0 + nrm(ks[14], (DEPTH, D_A), 0.05),
        'a_log': jnp.log(jax.random.uniform(ks[15], (DEPTH, N_HEADS_B), jnp.float32, 1.0, 16.0)),
        'dt_bias': dt + jnp.log(-jnp.expm1(-dt)),
        'o_norm_w': 1.0 + nrm(ks[17], (DEPTH, HEAD_DIM), 0.05),
        'w_out': nrm(ks[18], (DEPTH, D_MIX, D_MODEL), D_MIX ** -0.5),
    }


def reference(x_prompt, x_sample, c_prompt, c_sample, state_pool, state_conv, state_ssm,
              w_ada, b_ada, pre_norm_w, post_norm_w, w_in, conv_w, pool_w, pool_scale,
              a_log, dt_bias, o_norm_w, w_out):
    bp = x_prompt.shape[0]
    yp, ys = x_prompt, x_sample
    pp, cp, sp, ps, cs, ss = [], [], [], [], [], []
    for l in range(DEPTH):
        params = (w_ada[l], b_ada[l], pre_norm_w[l], post_norm_w[l], w_in[l], conv_w[l],
                  pool_w[l], pool_scale[l], a_log[l], dt_bias[l], o_norm_w[l], w_out[l])
        zero_pool = jnp.zeros((bp, POOL_BUF, D_A), x_prompt.dtype)
        zero_conv = jnp.zeros((bp, CONV_K - 1, D_QKV), x_prompt.dtype)
        zero_ssm = jnp.zeros((bp, N_HEADS_B, HEAD_DIM, HEAD_DIM), state_ssm.dtype)
        yp, a1, a2, a3 = mixer_layer(yp, c_prompt, 0, zero_pool, zero_conv, zero_ssm, True, *params)
        ys, b1, b2, b3 = mixer_layer(ys, c_sample, PAST_LEN, state_pool[l], state_conv[l], state_ssm[l], False, *params)
        pp.append(a1); cp.append(a2); sp.append(a3)
        ps.append(b1); cs.append(b2); ss.append(b3)
    return (yp, ys, jnp.stack(pp), jnp.stack(cp), jnp.stack(sp), jnp.stack(ps), jnp.stack(cs), jnp.stack(ss))
```

```cpp
#include <hip/hip_runtime.h>
#include <hip/hip_cooperative_groups.h>
#include <cstdio>
namespace cg = cooperative_groups;
__device__ __forceinline__ int opq_tid() { int t = (int)threadIdx.x; asm volatile("" : "+v"(t)); return t; }
namespace pg8 {
#define PG8_LAS __attribute__((address_space(3)))
typedef unsigned short bf16_t;
typedef short bf16x8 __attribute__((ext_vector_type(8)));
typedef float f32x4 __attribute__((ext_vector_type(4)));
typedef unsigned u32x4 __attribute__((ext_vector_type(4)));
constexpr int BM = 256, BK = 64, HALF = 128, HTB = HALF * BK * 2  , STAGE_BYTES = 8 * HTB, NXCD = 8, WGM = 8;

__host__ __device__ __forceinline__ int lds_byte(int r, int c) { const int st = (r >> 4) * 2 + (c >> 5), rr = r & 15, cc = c & 31, ob = rr * 64 + cc * 2; return st * 1024 + (ob ^ (((ob >> 9) & 1) << 5)); }
__host__ __device__ __forceinline__ void stage_rc(int b, int& R, int& C) { const int st = b / 1024, sb = b % 1024, swz = sb ^ (((sb >> 9) & 1) << 5); R = (st >> 1) * 16 + swz / 64; C = (st & 1) * 32 + (swz % 64) / 2; }
__host__ __device__ __forceinline__ int perm32(int rho) { const int n = rho >> 4, i = rho & 15; return 8 * (i >> 2) + 4 * n + (i & 3); }

struct Unit { int pm, pn; };
struct Gemm { const bf16_t* A; const bf16_t* Bt; int M, N, K; };
struct StaticOrder {
    int nM, nN, nwg, G, c;
    __host__ __device__ void init(int M, int N, int G_, int c_) { nM = M / BM; nN = N / BM; nwg = nM * nN; G = G_; c = c_; }
    __host__ __device__ bool next(int i, Unit& u) const {
        const long L = (long)i * G + c; if (L >= nwg) return false;
        int wgid = (int)L; { const int q = nwg / NXCD, r = nwg % NXCD, xcd = wgid % NXCD, off = wgid / NXCD; wgid = (xcd < r ? xcd * (q + 1) : r * (q + 1) + (xcd - r) * q) + off; }
        const int nig = WGM * nN, gid = wgid / nig, fm = gid * WGM, gsz = (nM - fm) < WGM ? (nM - fm) : WGM;
        u.pm = fm + ((wgid % nig) % gsz); u.pn = (wgid % nig) / gsz; return true;
    }
    __device__ __forceinline__ void a_ready(const Unit&) const {}
    __device__ __forceinline__ void done(const Unit&) const {}
};
__device__ __forceinline__ unsigned cvt_pk_bf16(float lo, float hi) { unsigned r; asm volatile("v_cvt_pk_bf16_f32 %0, %1, %2" : "=v"(r) : "v"(lo), "v"(hi)); return r; }
typedef float f32x2 __attribute__((ext_vector_type(2)));
__device__ __forceinline__ f32x2 gelu_pk(f32x2 v) {
    const f32x2 av = __builtin_elementwise_abs(v), d = av * 0.2316418882f + 1.0f;
    f32x2 t; t.x = __builtin_amdgcn_rcpf(d.x); t.y = __builtin_amdgcn_rcpf(d.y);
    f32x2 q = t * 0.5307027145f + (-0.7265760135f); q = q * t + 0.7107068705f; q = q * t + (-0.142248368f); q = q * t + 0.127414796f; q = q * t;
    const f32x2 s = (v * v) * (-0.72134752044f);
    f32x2 e; e.x = __builtin_amdgcn_exp2f(s.x); e.y = __builtin_amdgcn_exp2f(s.y);
    const f32x2 m = v * (q * e), r = v - m;
    f32x2 o; o.x = v.x < 0.f ? m.x : r.x; o.y = v.y < 0.f ? m.y : r.y; return o;
}

struct EpiF32 {
    static constexpr bool PERM = false, AFTER_DRAIN = false;
    float* C; int ldc; const float* bias;
    __device__ __forceinline__ void operator()(const f32x4 (&acc)[2][2][4][2], const Unit& u, int wr, int wc, int fr, int fq) const {
        const int row0 = u.pm * BM + wr * 64 + fr, col0 = u.pn * BM + wc * 32 + 4 * fq;
        f32x4 bv[2][2];
#pragma unroll
        for (int bj = 0; bj < 2; ++bj)
#pragma unroll
            for (int n = 0; n < 2; ++n) bv[bj][n] = bias ? *(const f32x4*)(bias + col0 + bj * HALF + n * 16) : (f32x4){0.f, 0.f, 0.f, 0.f};
#pragma unroll
        for (int ai = 0; ai < 2; ++ai)
#pragma unroll
            for (int m = 0; m < 4; ++m) { float* rowp = C + (size_t)(row0 + ai * HALF + m * 16) * ldc + col0;
#pragma unroll
                for (int bj = 0; bj < 2; ++bj)
#pragma unroll
                    for (int n = 0; n < 2; ++n) *(f32x4*)(rowp + bj * HALF + n * 16) = acc[ai][bj][m][n] + bv[bj][n]; }
    }
};
template <int ACT  > struct EpiBf16 {
    static constexpr bool PERM = true, AFTER_DRAIN = false;
    bf16_t* O; int ldc; const float* bias; int split_cols; size_t split_stride;
    __device__ __forceinline__ void operator()(const f32x4 (&acc)[2][2][4][2], const Unit& u, int wr, int wc, int fr, int fq) const {
        const int row0 = u.pm * BM + wr * 64 + fr; int colt = u.pn * BM; bf16_t* base = O;
        if (split_cols) { const int t = colt / split_cols; base += (size_t)t * split_stride; colt -= t * split_cols; }
        const int col0 = colt + wc * 32 + 8 * fq, bcol0 = u.pn * BM + wc * 32 + 8 * fq;
        f32x4 bv[2][2];
#pragma unroll
        for (int bj = 0; bj < 2; ++bj)
#pragma unroll
            for (int n = 0; n < 2; ++n) bv[bj][n] = bias ? *(const f32x4*)(bias + bcol0 + bj * HALF + 4 * n) : (f32x4){0.f, 0.f, 0.f, 0.f};
#pragma unroll
        for (int ai = 0; ai < 2; ++ai)
#pragma unroll
            for (int m = 0; m < 4; ++m) { bf16_t* rowp = base + (size_t)(row0 + ai * HALF + m * 16) * ldc + col0;
#pragma unroll
                for (int bj = 0; bj < 2; ++bj) { f32x4 v0 = acc[ai][bj][m][0] + bv[bj][0], v1 = acc[ai][bj][m][1] + bv[bj][1];
                    if (ACT == 1) { f32x2 a = gelu_pk((f32x2){v0[0], v0[1]}), b = gelu_pk((f32x2){v0[2], v0[3]}), c = gelu_pk((f32x2){v1[0], v1[1]}), d = gelu_pk((f32x2){v1[2], v1[3]});
                        v0 = (f32x4){a.x, a.y, b.x, b.y}; v1 = (f32x4){c.x, c.y, d.x, d.y}; }
                    if (ACT == 2) {
#pragma unroll
                        for (int j = 0; j < 4; ++j) { v0[j] = 0.5f * v0[j] * (1.0f + erff(v0[j] * 0.70710678f)); v1[j] = 0.5f * v1[j] * (1.0f + erff(v1[j] * 0.70710678f)); } }
                    u32x4 w; w.x = cvt_pk_bf16(v0[0], v0[1]); w.y = cvt_pk_bf16(v0[2], v0[3]); w.z = cvt_pk_bf16(v1[0], v1[1]); w.w = cvt_pk_bf16(v1[2], v1[3]);
                    *(u32x4*)(rowp + bj * HALF) = w; } }
    }
};
template <class Epi, class Sched, bool STAMP = false>
__device__ __forceinline__ void gemm_phase(PG8_LAS unsigned char* lds, const Gemm g, const Sched& S, const Epi& E, unsigned long long* stamps) {
    const int tid = opq_tid(), wid = __builtin_amdgcn_readfirstlane(tid >> 6), lane = tid & 63, wr = wid >> 2, wc = wid & 3, fr = lane & 15, fq = lane >> 4;
    const int K = g.K, nt = K / BK;
    int ts_lo = 0, ts_hi = 0, nts = 0; const unsigned long long rt_entry = STAMP ? (unsigned long long)wall_clock64() : 0ull;
#define PG8_STAMP() do { if (STAMP && wid == 0 && nts < 64) { const unsigned long long _c = (unsigned long long)clock64(); \
        ts_lo = (lane == nts) ? (int)(unsigned)_c : ts_lo; ts_hi = (lane == nts) ? (int)(unsigned)(_c >> 32) : ts_hi; ++nts; } } while (0)
    PG8_STAMP();
    unsigned voffA[2], voffB[2];
#pragma unroll
    for (int i = 0; i < 2; ++i) { int R, C; stage_rc(tid * 16 + i * 8192, R, C); const int Rb = Epi::PERM ? ((R & ~31) + perm32(R & 31)) : R;
        voffA[i] = (unsigned)(R * K + C) * 2u; voffB[i] = (unsigned)(Rb * K + C) * 2u; }
    const size_t kstep = (size_t)(BK * 2);
    const size_t hstep = (size_t)HALF * K * 2;
    const size_t tstep = 2 * hstep;
    const unsigned ldsw = (unsigned)wid * 1024u;
    const int aoff = lds_byte(wr * 64 + fr, fq * 8), boff = lds_byte(wc * 32 + fr, fq * 8);
#define PG8_SA(b, h) (((b) * 2 + (h)) * HTB)
#define PG8_SB(b, h) ((4 + (b) * 2 + (h)) * HTB)
#define PG8_STAGE(bufoff, gbase, voff) do { _Pragma("unroll") for (int _i = 0; _i < 2; ++_i) \
        __builtin_amdgcn_global_load_lds((const unsigned*)((const char*)(gbase) + (voff)[_i]), (PG8_LAS unsigned*)(lds + (bufoff) + ldsw + _i * 8192), 16, 0, 0); } while (0)
#define PG8_LDA(dst, b, h) do { _Pragma("unroll") for (int m = 0; m < 4; ++m) _Pragma("unroll") for (int k = 0; k < 2; ++k) dst[m][k] = *(const PG8_LAS bf16x8*)(lds + PG8_SA(b, h) + aoff + m * 2048 + k * 1024); } while (0)
#define PG8_LDB(dst, b, h) do { _Pragma("unroll") for (int n = 0; n < 2; ++n) _Pragma("unroll") for (int k = 0; k < 2; ++k) dst[n][k] = *(const PG8_LAS bf16x8*)(lds + PG8_SB(b, h) + boff + n * 2048 + k * 1024); } while (0)
#define PG8_MMA(ai, bj, At, Bt) do { __builtin_amdgcn_s_setprio(1); _Pragma("unroll") for (int m = 0; m < 4; ++m) _Pragma("unroll") for (int n = 0; n < 2; ++n) _Pragma("unroll") for (int k = 0; k < 2; ++k) \
        acc[ai][bj][m][n] = __builtin_amdgcn_mfma_f32_16x16x32_bf16(Bt[n][k], At[m][k], acc[ai][bj][m][n], 0, 0, 0); __builtin_amdgcn_s_setprio(0); } while (0)
#define PG8_WAIT_V(n) asm volatile("s_waitcnt vmcnt(" #n ")" ::: "memory")
#define PG8_WAIT_L(n) asm volatile("s_waitcnt lgkmcnt(" #n ")" ::: "memory")
#define PG8_BAR __builtin_amdgcn_s_barrier()
#define PG8_SCHED __builtin_amdgcn_sched_barrier(0)
    Unit cur, nxt; int ui = 0;
    if (!S.next(0, cur)) return;
    f32x4 acc[2][2][4][2];
#pragma unroll
    for (int a = 0; a < 2; ++a)
#pragma unroll
        for (int b = 0; b < 2; ++b)
#pragma unroll
            for (int m = 0; m < 4; ++m)
#pragma unroll
                for (int n = 0; n < 2; ++n) acc[a][b][m][n] = (f32x4){0.f, 0.f, 0.f, 0.f};
    bf16x8 At[4][2], B0[2][2], B1[2][2];
    const char* cA = (const char*)g.A + (size_t)cur.pm * tstep; const char* cB = (const char*)g.Bt + (size_t)cur.pn * tstep;
    S.a_ready(cur);
    PG8_STAGE(PG8_SB(0, 0), cB, voffB); PG8_STAGE(PG8_SA(0, 0), cA, voffA); PG8_STAGE(PG8_SB(0, 1), cB + hstep, voffB); PG8_STAGE(PG8_SA(0, 1), cA + hstep, voffA);
    if (wr == 1) PG8_BAR;
    PG8_WAIT_V(4); PG8_BAR;
    PG8_STAGE(PG8_SB(1, 0), cB + kstep, voffB); PG8_STAGE(PG8_SA(1, 0), cA + kstep, voffA); PG8_STAGE(PG8_SB(1, 1), cB + hstep + kstep, voffB);
    PG8_WAIT_V(6); PG8_BAR;
    PG8_STAMP();
    for (;;) {
        const bool has_next = S.next(ui + 1, nxt);
        const char* nA = has_next ? (const char*)g.A + (size_t)nxt.pm * tstep : cA; const char* nB = has_next ? (const char*)g.Bt + (size_t)nxt.pn * tstep : cB;
        for (int t = 0; t < nt; t += 2) {
            const bool last = (t == nt - 2);
            const char* a1 = cA + (size_t)(t + 1) * kstep;
            const char* a2 = last ? nA : cA + (size_t)(t + 2) * kstep; const char* b2 = last ? nB : cB + (size_t)(t + 2) * kstep;
            const char* a3 = a2 + kstep; const char* b3 = b2 + kstep;
            if (last && has_next) S.a_ready(nxt);
            PG8_LDB(B0, 0, 0); PG8_SCHED; PG8_LDA(At, 0, 0); PG8_STAGE(PG8_SA(1, 1), a1 + hstep, voffA);
            PG8_WAIT_L(8); PG8_BAR; PG8_WAIT_L(0); PG8_MMA(0, 0, At, B0); PG8_BAR; PG8_SCHED;
            PG8_LDB(B1, 0, 1); PG8_STAGE(PG8_SB(0, 0), b2, voffB);
            PG8_BAR; PG8_WAIT_L(0); PG8_MMA(0, 1, At, B1); PG8_BAR;
            PG8_LDA(At, 0, 1); PG8_STAGE(PG8_SA(0, 0), a2, voffA);
            PG8_BAR; PG8_WAIT_L(0); PG8_MMA(1, 0, At, B0); PG8_BAR; PG8_SCHED;
            PG8_STAGE(PG8_SB(0, 1), b2 + hstep, voffB);
            PG8_WAIT_V(6); PG8_BAR; PG8_MMA(1, 1, At, B1); PG8_BAR;
            PG8_LDB(B0, 1, 0); PG8_SCHED; PG8_LDA(At, 1, 0); PG8_STAGE(PG8_SA(0, 1), a2 + hstep, voffA);
            PG8_WAIT_L(8); PG8_BAR; PG8_WAIT_L(0); PG8_MMA(0, 0, At, B0); PG8_BAR; PG8_SCHED;
            PG8_LDB(B1, 1, 1); PG8_STAGE(PG8_SB(1, 0), b3, voffB);
            PG8_BAR; PG8_WAIT_L(0); PG8_MMA(0, 1, At, B1); PG8_BAR;
            PG8_LDA(At, 1, 1); PG8_STAGE(PG8_SA(1, 0), a3, voffA);
            PG8_BAR; PG8_WAIT_L(0); PG8_MMA(1, 0, At, B0); PG8_BAR; PG8_SCHED;
            PG8_STAGE(PG8_SB(1, 1), b3 + hstep, voffB);
            PG8_WAIT_V(6); PG8_BAR; PG8_MMA(1, 1, At, B1); PG8_BAR;
        }
        PG8_STAMP();
        if constexpr (!Epi::AFTER_DRAIN) { E(acc, cur, wr, wc, fr, fq); S.done(cur); }
        PG8_STAMP();
        if (!has_next) break;
#pragma unroll
        for (int a = 0; a < 2; ++a)
#pragma unroll
            for (int b = 0; b < 2; ++b)
#pragma unroll
                for (int m = 0; m < 4; ++m)
#pragma unroll
                    for (int n = 0; n < 2; ++n) acc[a][b][m][n] = (f32x4){0.f, 0.f, 0.f, 0.f};
        cur = nxt; cA = nA; cB = nB; ++ui;
    }
    PG8_WAIT_V(0);
    if (wr == 0) PG8_BAR;
    PG8_BAR;
    if constexpr (Epi::AFTER_DRAIN) { E.fused(acc, cur, wr, wc, fr, fq, lds, wid, lane); S.done(cur); }
    PG8_STAMP();
    if (STAMP && wid == 0) { stamps[lane] = lane < nts ? (((unsigned long long)(unsigned)ts_hi << 32) | (unsigned)ts_lo) : 0ull;
        if (lane == 62) stamps[62] = rt_entry; if (lane == 63) stamps[63] = (unsigned long long)wall_clock64(); }
#undef PG8_STAMP
#undef PG8_SA
#undef PG8_SB
#undef PG8_STAGE
#undef PG8_LDA
#undef PG8_LDB
#undef PG8_MMA
#undef PG8_WAIT_V
#undef PG8_WAIT_L
#undef PG8_BAR
#undef PG8_SCHED
}
}
#ifndef SKIP
#define SKIP 0
#endif
#define LAS PG8_LAS
typedef pg8::bf16_t bf16_t;
typedef pg8::bf16x8 bf16x8;
typedef pg8::f32x4 f32x4;
typedef pg8::u32x4 u32x4;
typedef unsigned u32x2 __attribute__((ext_vector_type(2)));
constexpr int NP = 16384, NS = 128, NR = NP + NS, MPAD = 16640, DM = 1024, DIN = 3080;
constexpr int LDS_BYTES = 131072;
constexpr size_t OYS = 16777216, OPP = 16908288, OCP = 17031168, OSP = 17104896, OPS = 18153472, OCS = 20119552, OSS = 21299200;
constexpr size_t WS_WTIN = 0;
constexpr size_t WS_WTOUT = WS_WTIN + 12582912;
constexpr size_t WS_WTPOOL = WS_WTOUT + 4194304;
constexpr size_t WS_MOD = WS_WTPOOL + 262144;
constexpr size_t WS_H = WS_MOD + 6291456;
constexpr size_t WS_P0 = WS_H + 34078720;
constexpr size_t WS_P1 = WS_P0 + 34078720;
constexpr size_t WS_P2 = WS_P1 + 34078720;
constexpr size_t WS_G = WS_P2 + 34078720;
constexpr size_t WS_BETA = WS_G + 264192;
constexpr size_t WS_GL = WS_BETA + 264192;
constexpr size_t WS_W = WS_GL + 4096;
constexpr size_t WS_QG = WS_W + 16777216;
constexpr size_t WS_KGT = WS_QG + 16777216;
constexpr size_t WS_QK = WS_KGT + 16777216;
constexpr size_t WS_U = WS_QK + 8388608;
constexpr size_t WS_WTADA = WS_U;
constexpr size_t WS_AC = WS_U + 12582912;
constexpr size_t WS_END = WS_U + 33554432;

struct Params {
    const float* x_prompt; const float* x_sample; const float* c_prompt; const float* c_sample;
    const float* state_pool; const float* state_conv; const float* state_ssm;
    const float* w_ada; const float* b_ada; const float* pre_norm_w; const float* post_norm_w; const float* w_in; const float* conv_w;
    const float* pool_w; const float* pool_scale; const float* a_log; const float* dt_bias; const float* o_norm_w; const float* w_out;
    float* out; unsigned char* ws; int ph_lo, ph_hi;
};

__device__ __forceinline__ float bf2f(unsigned short b) { return __uint_as_float(((unsigned)b) << 16); }
__device__ __forceinline__ unsigned pk2(float lo, float hi) { return pg8::cvt_pk_bf16(lo, hi); }
__device__ __forceinline__ unsigned short f2bf(float f) { return (unsigned short)(pk2(f, 0.f) & 0xffffu); }
__device__ __forceinline__ float silu_f(float x) { return __fdividef(x, 1.0f + __expf(-x)); }
__device__ __forceinline__ void unpack8(const u32x4 v, float* x) {
    x[0] = __uint_as_float(v.x << 16); x[1] = __uint_as_float(v.x & 0xffff0000u); x[2] = __uint_as_float(v.y << 16); x[3] = __uint_as_float(v.y & 0xffff0000u);
    x[4] = __uint_as_float(v.z << 16); x[5] = __uint_as_float(v.z & 0xffff0000u); x[6] = __uint_as_float(v.w << 16); x[7] = __uint_as_float(v.w & 0xffff0000u);
}
__device__ __forceinline__ u32x4 pack8(const float* x) { u32x4 w; w.x = pk2(x[0], x[1]); w.y = pk2(x[2], x[3]); w.z = pk2(x[4], x[5]); w.w = pk2(x[6], x[7]); return w; }
__device__ __forceinline__ float wave_sum(float v) {
#pragma unroll
    for (int o = 32; o >= 1; o >>= 1) v += __shfl_xor(v, o);
    return v;
}

__device__ __forceinline__ void transpose_tile(const float* __restrict__ src, int ld, bf16_t* __restrict__ dst, int ldd, int k0, int n0, LAS float* tile) {
    const int tid = opq_tid();
#pragma unroll
    for (int p = 0; p < 2; ++p) {
        const int kk = (tid >> 4) + 32 * p, n4 = (tid & 15) * 4;
        const float4 v = *(const float4*)(src + (size_t)(k0 + kk) * ld + n0 + n4);
        tile[kk * 65 + n4 + 0] = v.x; tile[kk * 65 + n4 + 1] = v.y; tile[kk * 65 + n4 + 2] = v.z; tile[kk * 65 + n4 + 3] = v.w;
    }
    __syncthreads();
    const int n = tid >> 3, k8 = (tid & 7) * 8;
    float x[8];
#pragma unroll
    for (int i = 0; i < 8; ++i) x[i] = tile[(k8 + i) * 65 + n];
    *(u32x4*)(dst + (size_t)(n0 + n) * ldd + k0 + k8) = pack8(x);
    __syncthreads();
}

__device__ __forceinline__ void phase_convert(const Params& p, LAS unsigned char* lds) {
    LAS float* tile = (LAS float*)lds;
    bf16_t* WtIn = (bf16_t*)(p.ws + WS_WTIN); bf16_t* WtAda = (bf16_t*)(p.ws + WS_WTADA); bf16_t* WtOut = (bf16_t*)(p.ws + WS_WTOUT); bf16_t* WtPool = (bf16_t*)(p.ws + WS_WTPOOL);
    for (int t = blockIdx.x; t < 3616; t += gridDim.x) {
        if (t < 1536) { const int l = t / 768, rem = t % 768; transpose_tile(p.w_in + (size_t)l * 1024 * DIN, DIN, WtIn + (size_t)l * 3072 * 1024, 1024, (rem / 48) * 64, (rem % 48) * 64, tile); }
        else if (t < 3072) { const int tt = t - 1536, l = tt / 768, rem = tt % 768; transpose_tile(p.w_ada + (size_t)l * 1024 * 3072, 3072, WtAda + (size_t)l * 3072 * 1024, 1024, (rem / 48) * 64, (rem % 48) * 64, tile); }
        else if (t < 3584) { const int tt = t - 3072, l = tt / 256, rem = tt % 256; transpose_tile(p.w_out + (size_t)l * 1024 * 1024, 1024, WtOut + (size_t)l * 1024 * 1024, 1024, (rem / 16) * 64, (rem % 16) * 64, tile); }
        else { const int tt = t - 3584, lg = tt / 4, rem = tt % 4; transpose_tile(p.pool_w + (size_t)lg * 16384, 128, WtPool + (size_t)lg * 16384, 128, (rem / 2) * 64, (rem % 2) * 64, tile); }
    }
    bf16_t* Ac = (bf16_t*)(p.ws + WS_AC);
    for (int i = blockIdx.x * 512 + opq_tid(); i < 65536; i += gridDim.x * 512) {
        const int row = i >> 8, c4 = (i & 255) * 4;
        float4 v = make_float4(0.f, 0.f, 0.f, 0.f);
        if (row < 8) v = *(const float4*)(p.c_prompt + row * 1024 + c4); else if (row < 136) v = *(const float4*)(p.c_sample + (row - 8) * 1024 + c4);
        uint2 w; w.x = pk2(silu_f(v.x), silu_f(v.y)); w.y = pk2(silu_f(v.z), silu_f(v.w));
        *(uint2*)(Ac + row * 1024 + c4) = w;
    }
}

__device__ __forceinline__ void phase_rows(const Params& p, int lF, int lA, LAS unsigned char* lds) {
    const int tid = opq_tid(), wid = tid >> 6, lane = tid & 63;
    LAS float* W8t = (LAS float*)lds;
    const float* mod = (const float*)(p.ws + WS_MOD);
    const float* Y = (const float*)(p.ws + WS_P0);
    bf16_t* H = (bf16_t*)(p.ws + WS_H);
    float* Gd = (float*)(p.ws + WS_G); float* Bd = (float*)(p.ws + WS_BETA);
    if (lA >= 0) {
        for (int i = tid; i < 8192; i += 512) { const int k = i >> 3, j = i & 7; W8t[j * 1024 + k] = p.w_in[(size_t)lA * 1024 * DIN + (size_t)k * DIN + 3072 + j]; }
        __syncthreads();
    }
    for (int row = blockIdx.x * 8 + wid; row < NR; row += gridDim.x * 8) {
        const int mrow = row < NP ? (row >> 11) : (8 + row - NP);
        const float* xorig = row < NP ? p.x_prompt + (size_t)row * 1024 : p.x_sample + (size_t)(row - NP) * 1024;
        float* xout = p.out + (size_t)row * 1024;
        float4 xv[4];
        if (lF >= 0) {
            const float* yrow = Y + (size_t)row * 1024; const float* mF = mod + (size_t)mrow * 6144 + lF * 3072 + 2048;
            const float* xsrc = (lF == 0) ? xorig : xout;
            float4 yv[4]; float ss = 0.f;
#pragma unroll
            for (int i = 0; i < 4; ++i) { yv[i] = *(const float4*)(yrow + lane * 4 + 256 * i); ss += yv[i].x * yv[i].x + yv[i].y * yv[i].y + yv[i].z * yv[i].z + yv[i].w * yv[i].w; }
            ss = wave_sum(ss);
            const float rstd = rsqrtf(ss * (1.0f / 1024.0f) + 1e-6f);
#pragma unroll
            for (int i = 0; i < 4; ++i) {
                const int c = lane * 4 + 256 * i;
                const float4 gt = *(const float4*)(mF + c), pw = *(const float4*)(p.post_norm_w + lF * 1024 + c), xi = *(const float4*)(xsrc + c);
                xv[i].x = xi.x + gt.x * (yv[i].x * rstd * pw.x); xv[i].y = xi.y + gt.y * (yv[i].y * rstd * pw.y);
                xv[i].z = xi.z + gt.z * (yv[i].z * rstd * pw.z); xv[i].w = xi.w + gt.w * (yv[i].w * rstd * pw.w);
                *(float4*)(xout + c) = xv[i];
            }
        } else {
#pragma unroll
            for (int i = 0; i < 4; ++i) xv[i] = *(const float4*)(xorig + lane * 4 + 256 * i);
        }
        if (lA >= 0) {
            float ss = 0.f;
#pragma unroll
            for (int i = 0; i < 4; ++i) ss += xv[i].x * xv[i].x + xv[i].y * xv[i].y + xv[i].z * xv[i].z + xv[i].w * xv[i].w;
            ss = wave_sum(ss);
            const float rstd = rsqrtf(ss * (1.0f / 1024.0f) + 1e-6f);
            const float* mA = mod + (size_t)mrow * 6144 + lA * 3072;
            float d[8];
#pragma unroll
            for (int j = 0; j < 8; ++j) d[j] = 0.f;
#pragma unroll
            for (int i = 0; i < 4; ++i) {
                const int c = lane * 4 + 256 * i;
                const float4 sh = *(const float4*)(mA + c), sc = *(const float4*)(mA + 1024 + c), pw = *(const float4*)(p.pre_norm_w + lA * 1024 + c);
                float4 hv;
                hv.x = xv[i].x * rstd * pw.x * (1.0f + sc.x) + sh.x; hv.y = xv[i].y * rstd * pw.y * (1.0f + sc.y) + sh.y;
                hv.z = xv[i].z * rstd * pw.z * (1.0f + sc.z) + sh.z; hv.w = xv[i].w * rstd * pw.w * (1.0f + sc.w) + sh.w;
                uint2 w; w.x = pk2(hv.x, hv.y); w.y = pk2(hv.z, hv.w);
                *(uint2*)(H + (size_t)row * 1024 + c) = w;
#pragma unroll
                for (int j = 0; j < 8; ++j) { const f32x4 wv = *(const LAS f32x4*)(W8t + j * 1024 + c); d[j] += hv.x * wv[0] + hv.y * wv[1] + hv.z * wv[2] + hv.w * wv[3]; }
            }
#pragma unroll
            for (int j = 0; j < 8; ++j) d[j] = wave_sum(d[j]);
            if (lane < 4) {
                const float br = lane == 0 ? d[0] : lane == 1 ? d[1] : lane == 2 ? d[2] : d[3];
                const float ar = lane == 0 ? d[4] : lane == 1 ? d[5] : lane == 2 ? d[6] : d[7];
                const float xs = ar + p.dt_bias[lA * 4 + lane];
                const float sp = fmaxf(xs, 0.f) + log1pf(__expf(-fabsf(xs)));
                Bd[row * 4 + lane] = 1.0f / (1.0f + __expf(-br));
                Gd[row * 4 + lane] = -__expf(p.a_log[lA * 4 + lane]) * sp;
            }
        }
    }
}

__device__ __forceinline__ void conv8(const bf16_t* __restrict__ colp, int tok, const float* __restrict__ cw, float* out, float* xcur) {
    float acc[8];
#pragma unroll
    for (int i = 0; i < 8; ++i) acc[i] = 0.f;
#pragma unroll
    for (int j = 0; j < 4; ++j) {
        if (tok - 3 + j >= 0) {
            const u32x4 v = *(const u32x4*)(colp + (long)(j - 3) * 1024);
            float x[8]; unpack8(v, x);
            const float4 w0 = *(const float4*)(cw + j * 1536), w1 = *(const float4*)(cw + j * 1536 + 4);
            acc[0] += x[0] * w0.x; acc[1] += x[1] * w0.y; acc[2] += x[2] * w0.z; acc[3] += x[3] * w0.w;
            acc[4] += x[4] * w1.x; acc[5] += x[5] * w1.y; acc[6] += x[6] * w1.z; acc[7] += x[7] * w1.w;
            if (j == 3) {
#pragma unroll
                for (int i = 0; i < 8; ++i) xcur[i] = x[i];
            }
        }
    }
#pragma unroll
    for (int i = 0; i < 8; ++i) out[i] = silu_f(acc[i]);
}

__device__ __forceinline__ void chunk_item(const Params& p, int l, int idx, LAS unsigned char* lds) {
    const int tid = opq_tid(), wid = tid >> 6, lane = tid & 63;
    const int b = idx >> 7, h = (idx >> 5) & 3, n = idx & 31, R0 = b * 2048 + n * 64;
    LAS bf16_t* KB = (LAS bf16_t*)lds; LAS bf16_t* QB = (LAS bf16_t*)(lds + 17408);
    LAS float* AT = (LAS float*)(lds + 34816); LAS float* RHS = (LAS float*)(lds + 51200);
    LAS float* GC = (LAS float*)(lds + 116736); LAS float* BT = GC + 64; LAS float* EG = GC + 128;
    const float* Gd = (const float*)(p.ws + WS_G); const float* Bd = (const float*)(p.ws + WS_BETA);
    const bf16_t* P1 = (const bf16_t*)(p.ws + WS_P1); const bf16_t* P2 = (const bf16_t*)(p.ws + WS_P2);
    bf16_t* Wd = (bf16_t*)(p.ws + WS_W) + (size_t)idx * 8192; bf16_t* QGd = (bf16_t*)(p.ws + WS_QG) + (size_t)idx * 8192;
    bf16_t* KGTd = (bf16_t*)(p.ws + WS_KGT) + (size_t)idx * 8192; bf16_t* QKd = (bf16_t*)(p.ws + WS_QK) + (size_t)idx * 4096;
    float* Ud = (float*)(p.ws + WS_U) + (size_t)idx * 8192; float* GLd = (float*)(p.ws + WS_GL);
    if (tid < 64) {
        float v = Gd[(R0 + tid) * 4 + h];
#pragma unroll
        for (int o = 1; o < 64; o <<= 1) { const float t = __shfl_up(v, o); if (lane >= o) v += t; }
        GC[tid] = v; BT[tid] = Bd[(R0 + tid) * 4 + h]; const float e = __expf(v); EG[tid] = e;
        if (tid == 63) GLd[idx] = e;
    }
    __syncthreads();
    {
        const int t = tid >> 3, c0 = (tid & 7) * 16, tok = n * 64 + t;
        const size_t row = (size_t)(R0 + t);
        const float bt = BT[t], eg = EG[t];
        const float* cwl = p.conv_w + (size_t)l * 4 * 1536;
        float s[16], xc[16];
        conv8(P1 + row * 1024 + h * 128 + c0, tok, cwl + h * 128 + c0, s, xc); conv8(P1 + row * 1024 + h * 128 + c0 + 8, tok, cwl + h * 128 + c0 + 8, s + 8, xc + 8);
        if (n == 31 && t >= 61) { float* o = p.out + OCP + ((size_t)(l * 8 + b) * 3 + (t - 61)) * 1536 + h * 128 + c0;
#pragma unroll
            for (int i = 0; i < 16; ++i) o[i] = xc[i]; }
        float ss = 0.f;
#pragma unroll
        for (int i = 0; i < 16; ++i) ss += s[i] * s[i];
        ss += __shfl_xor(ss, 1); ss += __shfl_xor(ss, 2); ss += __shfl_xor(ss, 4);
        float rs = rsqrtf(ss + 1e-6f) * 0.08838834764831845f;
        float qn[16];
#pragma unroll
        for (int i = 0; i < 16; ++i) qn[i] = s[i] * rs;
        *(LAS u32x4*)(QB + t * 136 + c0) = pack8(qn); *(LAS u32x4*)(QB + t * 136 + c0 + 8) = pack8(qn + 8);
#pragma unroll
        for (int i = 0; i < 16; ++i) qn[i] *= eg;
        *(u32x4*)(QGd + t * 128 + c0) = pack8(qn); *(u32x4*)(QGd + t * 128 + c0 + 8) = pack8(qn + 8);
        conv8(P1 + row * 1024 + 512 + h * 128 + c0, tok, cwl + 512 + h * 128 + c0, s, xc); conv8(P1 + row * 1024 + 512 + h * 128 + c0 + 8, tok, cwl + 512 + h * 128 + c0 + 8, s + 8, xc + 8);
        if (n == 31 && t >= 61) { float* o = p.out + OCP + ((size_t)(l * 8 + b) * 3 + (t - 61)) * 1536 + 512 + h * 128 + c0;
#pragma unroll
            for (int i = 0; i < 16; ++i) o[i] = xc[i]; }
        ss = 0.f;
#pragma unroll
        for (int i = 0; i < 16; ++i) ss += s[i] * s[i];
        ss += __shfl_xor(ss, 1); ss += __shfl_xor(ss, 2); ss += __shfl_xor(ss, 4);
        rs = rsqrtf(ss + 1e-6f);
#pragma unroll
        for (int i = 0; i < 16; ++i) s[i] *= rs;
        *(LAS u32x4*)(KB + t * 136 + c0) = pack8(s); *(LAS u32x4*)(KB + t * 136 + c0 + 8) = pack8(s + 8);
        const float be = bt * eg;
#pragma unroll
        for (int i = 0; i < 16; i += 4) *(LAS f32x4*)(RHS + t * 256 + 128 + c0 + i) = (f32x4){s[i] * be, s[i + 1] * be, s[i + 2] * be, s[i + 3] * be};
        conv8(P2 + row * 1024 + h * 128 + c0, tok, cwl + 1024 + h * 128 + c0, s, xc); conv8(P2 + row * 1024 + h * 128 + c0 + 8, tok, cwl + 1024 + h * 128 + c0 + 8, s + 8, xc + 8);
        if (n == 31 && t >= 61) { float* o = p.out + OCP + ((size_t)(l * 8 + b) * 3 + (t - 61)) * 1536 + 1024 + h * 128 + c0;
#pragma unroll
            for (int i = 0; i < 16; ++i) o[i] = xc[i]; }
#pragma unroll
        for (int i = 0; i < 16; i += 4) *(LAS f32x4*)(RHS + t * 256 + c0 + i) = (f32x4){s[i] * bt, s[i + 1] * bt, s[i + 2] * bt, s[i + 3] * bt};
    }
    __syncthreads();
    {
        const int lr = lane & 15, lq = lane >> 4;
#pragma unroll 1
        for (int jj = 0; jj < 4; ++jj) {
            const int job = wid * 4 + jj, which = job >> 4, tile = job & 15, mi = tile >> 2, nj = tile & 3;
            LAS bf16_t* As = which ? QB : KB;
            f32x4 acc = {0.f, 0.f, 0.f, 0.f};
#pragma unroll
            for (int s = 0; s < 4; ++s) {
                const bf16x8 a = *(const LAS bf16x8*)(As + (16 * mi + lr) * 136 + 32 * s + 8 * lq);
                const bf16x8 bb = *(const LAS bf16x8*)(KB + (16 * nj + lr) * 136 + 32 * s + 8 * lq);
                acc = __builtin_amdgcn_mfma_f32_16x16x32_bf16(a, bb, acc, 0, 0, 0);
            }
            const int j = 16 * nj + lr, i0 = 16 * mi + 4 * lq;
            const float gj = GC[j];
            if (!which) {
                f32x4 o;
#pragma unroll
                for (int r = 0; r < 4; ++r) { const int i = i0 + r; o[r] = (i > j) ? BT[i] * acc[r] * __expf(GC[i] - gj) : 0.f; }
                *(LAS f32x4*)(AT + j * 64 + i0) = o;
            } else {
#pragma unroll
                for (int r = 0; r < 4; ++r) { const int i = i0 + r; const float v = (i >= j) ? acc[r] * __expf(GC[i] - gj) : 0.f; QKd[i * 64 + j] = f2bf(v); }
            }
        }
    }
    __syncthreads();
    if (tid < 256) {
        const int c = tid;
        float r[64];
#pragma unroll
        for (int i = 0; i < 64; ++i) r[i] = RHS[i * 256 + c];
#pragma unroll
        for (int j = 0; j < 63; ++j) {
            const float xj = r[j];
#pragma unroll
            for (int i4 = ((j + 1) & ~3); i4 < 64; i4 += 4) {
                const f32x4 a = *(const LAS f32x4*)(AT + j * 64 + i4);
                r[i4 + 0] -= a[0] * xj; r[i4 + 1] -= a[1] * xj; r[i4 + 2] -= a[2] * xj; r[i4 + 3] -= a[3] * xj;
            }
        }
        if (c < 128) {
#pragma unroll
            for (int i = 0; i < 64; ++i) Ud[i * 128 + c] = r[i];
        } else {
#pragma unroll
            for (int i = 0; i < 64; ++i) Wd[i * 128 + (c - 128)] = f2bf(r[i]);
        }
    } else {
        const int d = (tid - 256) >> 1, th = tid & 1;
        const float gcl = GC[63];
        float x[32];
#pragma unroll
        for (int i = 0; i < 32; ++i) { const int t = 32 * th + i; x[i] = bf2f(KB[t * 136 + d]) * __expf(gcl - GC[t]); }
#pragma unroll
        for (int q = 0; q < 4; ++q) *(u32x4*)(KGTd + d * 64 + 32 * th + 8 * q) = pack8(x + 8 * q);
    }
    __syncthreads();
}

__device__ __forceinline__ void pool_item(const Params& p, int l, int pidx, LAS unsigned char* lds) {
    const int tid = opq_tid(), wid = tid >> 6, lane = tid & 63;
    const bool sample = pidx >= 512;
    const int g = sample ? (pidx - 512) : (pidx & 3), T = pidx >> 2, w = 2 << g;
    const int rowbase = sample ? NP : T * 128, b = rowbase >> 11, t0 = rowbase & 2047;
    LAS bf16_t* UT = (LAS bf16_t*)lds; LAS bf16_t* PB = (LAS bf16_t*)(lds + 38912); LAS bf16_t* WB = (LAS bf16_t*)(lds + 73728);
    const bf16_t* P0 = (const bf16_t*)(p.ws + WS_P0);
    const bf16_t* WtPool = (const bf16_t*)(p.ws + WS_WTPOOL) + (size_t)(l * 4 + g) * 16384;
    bf16_t* YM = (bf16_t*)(p.ws + WS_H);
#pragma unroll
    for (int q = 0; q < 4; ++q) { const int piece = tid + 512 * q, d = piece >> 4, k8 = (piece & 15) * 8; *(LAS u32x4*)(WB + d * 136 + k8) = *(const u32x4*)(WtPool + d * 128 + k8); }
    if (!sample) {
        for (int piece = tid; piece < 143 * 16; piece += 512) {
            const int rr = piece >> 4, c8 = (piece & 15) * 8, tok = t0 - 15 + rr;
            u32x4 v = {0u, 0u, 0u, 0u};
            if (tok >= 0) v = *(const u32x4*)(P0 + (size_t)(b * 2048 + tok) * 1024 + g * 128 + c8);
            *(LAS u32x4*)(UT + rr * 136 + c8) = v;
        }
    } else {
        for (int piece = tid; piece < 128 * 16; piece += 512) {
            const int rr = piece >> 4, c8 = (piece & 15) * 8;
            *(LAS u32x4*)(UT + rr * 136 + c8) = *(const u32x4*)(P0 + (size_t)(NP + rr) * 1024 + g * 128 + c8);
        }
    }
    __syncthreads();
    {
        const int c = tid & 127, q = tid >> 7, i0 = 32 * q;
        if (!sample) {
            float s = 0.f;
            for (int j = 1; j < w; ++j) s += bf2f(UT[(i0 + 15 - j) * 136 + c]);
            for (int i = i0; i < i0 + 32; ++i) {
                const float cur = bf2f(UT[(i + 15) * 136 + c]);
                s += cur;
                const int tk = t0 + i + 1; const float cnt = (float)(tk < w ? tk : w);
                PB[i * 136 + c] = f2bf(s / cnt - cur);
                s -= bf2f(UT[(i + 15 - (w - 1)) * 136 + c]);
                if (t0 == 1920 && i >= 113) p.out[OPP + ((size_t)(l * 8 + b) * 15 + (i - 113)) * 512 + g * 128 + c] = cur;
            }
        } else {
            for (int i = i0; i < i0 + 32; ++i) {
                const float cur = bf2f(UT[i * 136 + c]);
                const float* sp = p.state_pool + ((size_t)(l * 128 + i) * 15) * 512 + g * 128 + c;
                float* op = p.out + OPS + ((size_t)(l * 128 + i) * 15) * 512 + g * 128 + c;
                float s = cur;
                if (w == 16) s += sp[0];
                for (int j = 0; j < 14; ++j) { const float v = sp[(size_t)(j + 1) * 512]; op[(size_t)j * 512] = v; if (14 - (j + 1) <= w - 2) s += v; }
                op[(size_t)14 * 512] = cur;
                PB[i * 136 + c] = f2bf(s / (float)w - cur);
            }
        }
    }
    __syncthreads();
    {
        const int lr = lane & 15, lq = lane >> 4;
        bf16x8 a[4];
#pragma unroll
        for (int s = 0; s < 4; ++s) a[s] = *(const LAS bf16x8*)(PB + (16 * wid + lr) * 136 + 32 * s + 8 * lq);
#pragma unroll 2
        for (int nt = 0; nt < 8; ++nt) {
            f32x4 acc = {0.f, 0.f, 0.f, 0.f};
#pragma unroll
            for (int s = 0; s < 4; ++s) { const bf16x8 bb = *(const LAS bf16x8*)(WB + (16 * nt + lr) * 136 + 32 * s + 8 * lq); acc = __builtin_amdgcn_mfma_f32_16x16x32_bf16(a[s], bb, acc, 0, 0, 0); }
            const int d = g * 128 + 16 * nt + lr;
            const float ps = p.pool_scale[l * 512 + d];
#pragma unroll
            for (int r = 0; r < 4; ++r) {
                const size_t row = (size_t)(rowbase + 16 * wid + 4 * lq + r);
                const float za = bf2f(P0[row * 1024 + 512 + d]);
                YM[row * 1024 + d] = f2bf(acc[r] * ps * silu_f(za));
            }
        }
    }
    __syncthreads();
}

__device__ __forceinline__ void sample_item(const Params& p, int l, int b, LAS unsigned char* lds) {
    const int tid = opq_tid(), wid = tid >> 6, lane = tid & 63;
    const int hd = tid >> 7, e = tid & 127;
    const size_t r = (size_t)(NP + b);
    LAS float* SQ = (LAS float*)lds; LAS float* SK = SQ + 512; LAS float* SV = SQ + 1024; LAS float* SO = SQ + 1536;
    LAS float* RED = SQ + 2048; LAS float* RED2 = SQ + 2560; LAS float* RW = SQ + 3072;
    const bf16_t* P1 = (const bf16_t*)(p.ws + WS_P1); const bf16_t* P2 = (const bf16_t*)(p.ws + WS_P2);
    const float* Gd = (const float*)(p.ws + WS_G); const float* Bd = (const float*)(p.ws + WS_BETA);
    bf16_t* YM = (bf16_t*)(p.ws + WS_H);
    const float* sc = p.state_conv + (size_t)(l * 128 + b) * 3 * 1536; const float* cw = p.conv_w + (size_t)l * 4 * 1536;
    float* oc = p.out + OCS + (size_t)(l * 128 + b) * 3 * 1536;
    float xin[3], cv[3];
    xin[0] = bf2f(P1[r * 1024 + tid]); xin[1] = bf2f(P1[r * 1024 + 512 + tid]); xin[2] = bf2f(P2[r * 1024 + tid]);
#pragma unroll
    for (int k = 0; k < 3; ++k) {
        const int ch = tid + 512 * k;
        const float b0 = sc[ch], b1 = sc[1536 + ch], b2 = sc[3072 + ch];
        cv[k] = silu_f(b0 * cw[ch] + b1 * cw[1536 + ch] + b2 * cw[3072 + ch] + xin[k] * cw[4608 + ch]);
        oc[ch] = b1; oc[1536 + ch] = b2; oc[3072 + ch] = xin[k];
    }
    const float sq = wave_sum(cv[0] * cv[0]), sk = wave_sum(cv[1] * cv[1]);
    if (lane == 0) { RW[wid] = sq; RW[8 + wid] = sk; }
    __syncthreads();
    {
        const float ssq = RW[2 * hd] + RW[2 * hd + 1], ssk = RW[8 + 2 * hd] + RW[8 + 2 * hd + 1];
        SQ[tid] = cv[0] * rsqrtf(ssq + 1e-6f) * 0.08838834764831845f; SK[tid] = cv[1] * rsqrtf(ssk + 1e-6f); SV[tid] = cv[2];
    }
    __syncthreads();
#pragma unroll 1
    for (int hh = 0; hh < 4; ++hh) {
        const int part = hd;
        const float eg = __expf(Gd[r * 4 + hh]), bt = Bd[r * 4 + hh];
        const float* Sin = p.state_ssm + ((size_t)((l * 128 + b) * 4 + hh) * 128) * 128;
        float* Sout = p.out + OSS + ((size_t)((l * 128 + b) * 4 + hh) * 128) * 128;
        float kvp = 0.f;
#pragma unroll 8
        for (int dd = 0; dd < 32; ++dd) { const int d = part * 32 + dd; kvp += SK[hh * 128 + d] * Sin[d * 128 + e]; }
        RED[part * 128 + e] = kvp * eg;
        __syncthreads();
        const float kv = RED[e] + RED[128 + e] + RED[256 + e] + RED[384 + e];
        const float delta = (SV[hh * 128 + e] - kv) * bt;
        float op = 0.f;
#pragma unroll 8
        for (int dd = 0; dd < 32; ++dd) { const int d = part * 32 + dd; const float sv = Sin[d * 128 + e] * eg + SK[hh * 128 + d] * delta; Sout[d * 128 + e] = sv; op += SQ[hh * 128 + d] * sv; }
        RED2[part * 128 + e] = op;
        __syncthreads();
        if (part == 0) SO[hh * 128 + e] = RED2[e] + RED2[128 + e] + RED2[256 + e] + RED2[384 + e];
    }
    __syncthreads();
    const float o = SO[tid];
    const float so = wave_sum(o * o);
    if (lane == 0) RW[16 + wid] = so;
    __syncthreads();
    {
        const float rstd = rsqrtf((RW[16 + 2 * hd] + RW[16 + 2 * hd + 1]) * (1.0f / 128.0f) + 1e-6f);
        const float zb = bf2f(P2[r * 1024 + 512 + tid]);
        YM[r * 1024 + 512 + tid] = f2bf(o * rstd * p.o_norm_w[l * 128 + e] * silu_f(zb));
    }
    __syncthreads();
}

__device__ __forceinline__ void phase_post(const Params& p, int l, LAS unsigned char* lds) {
    for (int idx = blockIdx.x; idx < 1024 + 516 + 128; idx += gridDim.x) {
        if (idx < 1024) { if (!(SKIP & 128)) chunk_item(p, l, idx, lds); }
        else if (idx < 1540) { if (!(SKIP & 256)) pool_item(p, l, idx - 1024, lds); }
        else { if (!(SKIP & 512)) sample_item(p, l, idx - 1540, lds); }
    }
}

struct ScanOps { bf16x8 wA[4], qA[4], qkA[2], kgA[2]; float u[4]; float gl; };
__device__ __forceinline__ void scan_load(ScanOps& o, const Params& p, int ci, int m, int n, int wid, int lr, int lq, int slice) {
    const bf16_t* Wd = (const bf16_t*)(p.ws + WS_W) + (size_t)ci * 8192; const bf16_t* QGd = (const bf16_t*)(p.ws + WS_QG) + (size_t)ci * 8192;
    const bf16_t* KGTd = (const bf16_t*)(p.ws + WS_KGT) + (size_t)ci * 8192; const bf16_t* QKd = (const bf16_t*)(p.ws + WS_QK) + (size_t)ci * 4096;
    const float* Ud = (const float*)(p.ws + WS_U) + (size_t)ci * 8192;
#pragma unroll
    for (int s = 0; s < 4; ++s) { o.wA[s] = *(const bf16x8*)(Wd + (16 * m + lr) * 128 + 32 * s + 8 * lq); o.qA[s] = *(const bf16x8*)(QGd + (16 * m + lr) * 128 + 32 * s + 8 * lq); }
#pragma unroll
    for (int s = 0; s < 2; ++s) { o.qkA[s] = *(const bf16x8*)(QKd + (16 * m + lr) * 64 + 32 * s + 8 * lq); o.kgA[s] = *(const bf16x8*)(KGTd + (16 * wid + lr) * 64 + 32 * s + 8 * lq); }
#pragma unroll
    for (int r = 0; r < 4; ++r) o.u[r] = Ud[(16 * m + 4 * lq + r) * 128 + 32 * slice + 16 * n + lr];
    o.gl = ((const float*)(p.ws + WS_GL))[ci];
}

__device__ __forceinline__ void scan_item(const Params& p, int l, int bh, int slice, LAS unsigned char* lds) {
    const int tid = opq_tid(), wid = tid >> 6, lane = tid & 63, lr = lane & 15, lq = lane >> 4, m = wid & 3, n = wid >> 2;
    const int b = bh >> 2, h = bh & 3;
    LAS bf16_t* ST = (LAS bf16_t*)lds;
    LAS bf16_t* VT = (LAS bf16_t*)(lds + 8704);
    float* Od = (float*)(p.ws + WS_P0);
    for (int i = tid; i < 32 * 136 / 2; i += 512) ((LAS unsigned*)ST)[i] = 0u;
    f32x4 Sacc[2] = {{0.f, 0.f, 0.f, 0.f}, {0.f, 0.f, 0.f, 0.f}};
    ScanOps cur; scan_load(cur, p, bh * 32, m, n, wid, lr, lq, slice);
    __syncthreads();
#pragma unroll 1
    for (int nc = 0; nc < 32; ++nc) {
        ScanOps nxt; scan_load(nxt, p, bh * 32 + (nc < 31 ? nc + 1 : nc), m, n, wid, lr, lq, slice);
        f32x4 P = {0.f, 0.f, 0.f, 0.f}, Q = {0.f, 0.f, 0.f, 0.f};
#pragma unroll
        for (int s = 0; s < 4; ++s) {
            const bf16x8 sb = *(const LAS bf16x8*)(ST + (16 * n + lr) * 136 + 32 * s + 8 * lq);
            P = __builtin_amdgcn_mfma_f32_16x16x32_bf16(cur.wA[s], sb, P, 0, 0, 0);
            Q = __builtin_amdgcn_mfma_f32_16x16x32_bf16(cur.qA[s], sb, Q, 0, 0, 0);
        }
        {
            u32x2 w; w.x = pk2(cur.u[0] - P[0], cur.u[1] - P[1]); w.y = pk2(cur.u[2] - P[2], cur.u[3] - P[3]);
            *(LAS u32x2*)(VT + (16 * n + lr) * 72 + 16 * m + 4 * lq) = w;
        }
        __syncthreads();
        bf16x8 vb[2][2];
#pragma unroll
        for (int nn = 0; nn < 2; ++nn)
#pragma unroll
            for (int s = 0; s < 2; ++s) vb[nn][s] = *(const LAS bf16x8*)(VT + (16 * nn + lr) * 72 + 32 * s + 8 * lq);
        Q = __builtin_amdgcn_mfma_f32_16x16x32_bf16(cur.qkA[0], n ? vb[1][0] : vb[0][0], Q, 0, 0, 0);
        Q = __builtin_amdgcn_mfma_f32_16x16x32_bf16(cur.qkA[1], n ? vb[1][1] : vb[0][1], Q, 0, 0, 0);
        {
            const size_t R0 = (size_t)b * 2048 + nc * 64;
#pragma unroll
            for (int r = 0; r < 4; ++r) Od[(R0 + 16 * m + 4 * lq + r) * 512 + h * 128 + 32 * slice + 16 * n + lr] = Q[r];
        }
#pragma unroll
        for (int nn = 0; nn < 2; ++nn) {
            Sacc[nn] = Sacc[nn] * cur.gl;
            Sacc[nn] = __builtin_amdgcn_mfma_f32_16x16x32_bf16(cur.kgA[0], vb[nn][0], Sacc[nn], 0, 0, 0);
            Sacc[nn] = __builtin_amdgcn_mfma_f32_16x16x32_bf16(cur.kgA[1], vb[nn][1], Sacc[nn], 0, 0, 0);
            u32x2 w; w.x = pk2(Sacc[nn][0], Sacc[nn][1]); w.y = pk2(Sacc[nn][2], Sacc[nn][3]);
            *(LAS u32x2*)(ST + (16 * nn + lr) * 136 + 16 * wid + 4 * lq) = w;
        }
        __syncthreads();
        cur = nxt;
    }
    float* So = p.out + OSP + ((size_t)((l * 8 + b) * 4 + h) * 128) * 128;
#pragma unroll
    for (int nn = 0; nn < 2; ++nn)
#pragma unroll
        for (int r = 0; r < 4; ++r) So[(16 * wid + 4 * lq + r) * 128 + 32 * slice + 16 * nn + lr] = Sacc[nn][r];
}

__device__ __forceinline__ void phase_scan(const Params& p, int l, LAS unsigned char* lds) {
    for (int blk = blockIdx.x; blk < 128; blk += gridDim.x) {
        const int bh = (blk & 7) + 8 * (blk >> 5), slice = (blk >> 3) & 3;
        scan_item(p, l, bh, slice, lds);
        __syncthreads();
    }
}

__device__ __forceinline__ void phase_onorm(const Params& p, int l) {
    const int tid = opq_tid(), wid = tid >> 6, lane = tid & 63;
    const float* Od = (const float*)(p.ws + WS_P0); const bf16_t* P2 = (const bf16_t*)(p.ws + WS_P2); bf16_t* YM = (bf16_t*)(p.ws + WS_H);
    const int c = lane * 8;
    const float4 w0 = *(const float4*)(p.o_norm_w + l * 128 + (c & 127)), w1 = *(const float4*)(p.o_norm_w + l * 128 + (c & 127) + 4);
    for (int row = blockIdx.x * 8 + wid; row < NP; row += gridDim.x * 8) {
        const float4 a = *(const float4*)(Od + (size_t)row * 512 + c), bq = *(const float4*)(Od + (size_t)row * 512 + c + 4);
        float ss = a.x * a.x + a.y * a.y + a.z * a.z + a.w * a.w + bq.x * bq.x + bq.y * bq.y + bq.z * bq.z + bq.w * bq.w;
        ss += __shfl_xor(ss, 1); ss += __shfl_xor(ss, 2); ss += __shfl_xor(ss, 4); ss += __shfl_xor(ss, 8);
        const float rstd = rsqrtf(ss * (1.0f / 128.0f) + 1e-6f);
        float z[8]; unpack8(*(const u32x4*)(P2 + (size_t)row * 1024 + 512 + c), z);
        float y[8];
        y[0] = a.x * rstd * w0.x * silu_f(z[0]); y[1] = a.y * rstd * w0.y * silu_f(z[1]); y[2] = a.z * rstd * w0.z * silu_f(z[2]); y[3] = a.w * rstd * w0.w * silu_f(z[3]);
        y[4] = bq.x * rstd * w1.x * silu_f(z[4]); y[5] = bq.y * rstd * w1.y * silu_f(z[5]); y[6] = bq.z * rstd * w1.z * silu_f(z[6]); y[7] = bq.w * rstd * w1.w * silu_f(z[7]);
        *(u32x4*)(YM + (size_t)row * 1024 + 512 + c) = pack8(y);
    }
}

__global__ void __launch_bounds__(512, 2) mk_fwd(Params p) {
    extern __shared__ __attribute__((aligned(16))) unsigned char shm[];
    LAS unsigned char* lds = (LAS unsigned char*)shm;
    cg::grid_group grid = cg::this_grid();
    for (int ph = p.ph_lo; ph < p.ph_hi; ++ph) {
        if (ph == 0) { if (!(SKIP & 1)) phase_convert(p, lds); }
        else if (ph == 2) { if (!(SKIP & 2)) phase_rows(p, -1, 0, lds); }
        else {
            const int l = ph >= 3 ? (ph - 3) / 6 : 0, k = ph >= 3 ? (ph - 3) % 6 : -1;
            if (ph == 1 || k == 4) { if (!(SKIP & 4)) {
                pg8::Gemm g; pg8::EpiF32 E;
                if (ph == 1) { g.A = (const bf16_t*)(p.ws + WS_AC); g.Bt = (const bf16_t*)(p.ws + WS_WTADA); g.M = 256; g.N = 6144; g.K = 1024; E.C = (float*)(p.ws + WS_MOD); E.ldc = 6144; E.bias = p.b_ada; }
                else { g.A = (const bf16_t*)(p.ws + WS_H); g.Bt = (const bf16_t*)(p.ws + WS_WTOUT) + (size_t)l * 1024 * 1024; g.M = MPAD; g.N = 1024; g.K = 1024; E.C = (float*)(p.ws + WS_P0); E.ldc = 1024; E.bias = nullptr; }
                pg8::StaticOrder S; S.init(g.M, g.N, (int)gridDim.x, (int)blockIdx.x);
                pg8::gemm_phase<pg8::EpiF32, pg8::StaticOrder, false>(lds, g, S, E, nullptr); }
            } else if (k == 0) { if (!(SKIP & 8)) {
                pg8::Gemm g; g.A = (const bf16_t*)(p.ws + WS_H); g.Bt = (const bf16_t*)(p.ws + WS_WTIN) + (size_t)l * 3072 * 1024; g.M = MPAD; g.N = 3072; g.K = 1024;
                pg8::EpiBf16<0> E; E.O = (bf16_t*)(p.ws + WS_P0); E.ldc = 1024; E.bias = nullptr; E.split_cols = 1024; E.split_stride = (size_t)MPAD * 1024;
                pg8::StaticOrder S; S.init(g.M, g.N, (int)gridDim.x, (int)blockIdx.x);
                pg8::gemm_phase<pg8::EpiBf16<0>, pg8::StaticOrder, false>(lds, g, S, E, nullptr); }
            } else if (k == 1) { if (!(SKIP & 16)) phase_post(p, l, lds); }
            else if (k == 2) { if (!(SKIP & 32)) phase_scan(p, l, lds); }
            else if (k == 3) { if (!(SKIP & 64)) phase_onorm(p, l); }
            else if (k == 5) { if (!(SKIP & 2)) phase_rows(p, l, l + 1 < 2 ? l + 1 : -1, lds); }
        }
        if (ph + 1 < p.ph_hi) grid.sync();
    }
}

extern "C" void kernel_launch(void* const* d_in, const int* in_sizes, int n_in, void* d_out, int out_size, void* d_ws, size_t ws_size, hipStream_t stream) {
    static int grid = 0;
    if (grid == 0) {
        if (n_in != 19 || ws_size < WS_END) { fprintf(stderr, "kernel_launch: unexpected n_in %d or ws_size %zu (< %zu)\n", n_in, ws_size, (size_t)WS_END); grid = -1; return; }
        int dev = 0, cus = 0, per_cu = 0;
        hipGetDevice(&dev); hipDeviceGetAttribute(&cus, hipDeviceAttributeMultiprocessorCount, dev);
        if (hipFuncSetAttribute((const void*)mk_fwd, hipFuncAttributeMaxDynamicSharedMemorySize, LDS_BYTES) != hipSuccess) { fprintf(stderr, "kernel_launch: hipFuncSetAttribute failed\n"); }
        if (hipOccupancyMaxActiveBlocksPerMultiprocessor(&per_cu, (const void*)mk_fwd, 512, LDS_BYTES) != hipSuccess || per_cu < 1) per_cu = 1;
        (void)hipGetLastError();
        grid = cus * 1;
        if (grid <= 0) grid = 256;
    }
    if (grid < 0) return;
    Params p{};
    const float** f = (const float**)&p;
    for (int i = 0; i < 19; ++i) f[i] = (const float*)d_in[i];
    p.out = (float*)d_out; p.ws = (unsigned char*)d_ws; p.ph_lo = 0; p.ph_hi = 15;
    void* args[] = {&p};
    hipError_t e = hipLaunchCooperativeKernel((const void*)mk_fwd, dim3(grid), dim3(512), args, LDS_BYTES, stream);
    if (e != hipSuccess) fprintf(stderr, "cooperative launch failed: %s (grid %d)\n", hipGetErrorString(e), grid);
}
```

```cpp
#include <hip/hip_runtime.h>
#include <hip/hip_cooperative_groups.h>
#include <cstdio>
namespace cg = cooperative_groups;
__device__ __forceinline__ int opq_tid() { int t = (int)threadIdx.x; asm volatile("" : "+v"(t)); return t; }
namespace pg8 {
#define PG8_LAS __attribute__((address_space(3)))
typedef unsigned short bf16_t;
typedef short bf16x8 __attribute__((ext_vector_type(8)));
typedef float f32x4 __attribute__((ext_vector_type(4)));
typedef unsigned u32x4 __attribute__((ext_vector_type(4)));
constexpr int BM = 256, BK = 64, HALF = 128, HTB = HALF * BK * 2  , STAGE_BYTES = 8 * HTB, NXCD = 8, WGM = 8;

__host__ __device__ __forceinline__ int lds_byte(int r, int c) { const int st = (r >> 4) * 2 + (c >> 5), rr = r & 15, cc = c & 31, ob = rr * 64 + cc * 2; return st * 1024 + (ob ^ (((ob >> 9) & 1) << 5)); }
__host__ __device__ __forceinline__ void stage_rc(int b, int& R, int& C) { const int st = b / 1024, sb = b % 1024, swz = sb ^ (((sb >> 9) & 1) << 5); R = (st >> 1) * 16 + swz / 64; C = (st & 1) * 32 + (swz % 64) / 2; }
__host__ __device__ __forceinline__ int perm32(int rho) { const int n = rho >> 4, i = rho & 15; return 8 * (i >> 2) + 4 * n + (i & 3); }

struct Unit { int pm, pn; };
struct Gemm { const bf16_t* A; const bf16_t* Bt; int M, N, K; };
struct StaticOrder {
    int nM, nN, nwg, G, c;
    __host__ __device__ void init(int M, int N, int G_, int c_) { nM = M / BM; nN = N / BM; nwg = nM * nN; G = G_; c = c_; }
    __host__ __device__ bool next(int i, Unit& u) const {
        const long L = (long)i * G + c; if (L >= nwg) return false;
        int wgid = (int)L; { const int q = nwg / NXCD, r = nwg % NXCD, xcd = wgid % NXCD, off = wgid / NXCD; wgid = (xcd < r ? xcd * (q + 1) : r * (q + 1) + (xcd - r) * q) + off; }
        const int nig = WGM * nN, gid = wgid / nig, fm = gid * WGM, gsz = (nM - fm) < WGM ? (nM - fm) : WGM;
        u.pm = fm + ((wgid % nig) % gsz); u.pn = (wgid % nig) / gsz; return true;
    }
    __device__ __forceinline__ void a_ready(const Unit&) const {}
    __device__ __forceinline__ void done(const Unit&) const {}
};
__device__ __forceinline__ unsigned cvt_pk_bf16(float lo, float hi) { unsigned r; asm volatile("v_cvt_pk_bf16_f32 %0, %1, %2" : "=v"(r) : "v"(lo), "v"(hi)); return r; }
typedef float f32x2 __attribute__((ext_vector_type(2)));
__device__ __forceinline__ f32x2 gelu_pk(f32x2 v) {
    const f32x2 av = __builtin_elementwise_abs(v), d = av * 0.2316418882f + 1.0f;
    f32x2 t; t.x = __builtin_amdgcn_rcpf(d.x); t.y = __builtin_amdgcn_rcpf(d.y);
    f32x2 q = t * 0.5307027145f + (-0.7265760135f); q = q * t + 0.7107068705f; q = q * t + (-0.142248368f); q = q * t + 0.127414796f; q = q * t;
    const f32x2 s = (v * v) * (-0.72134752044f);
    f32x2 e; e.x = __builtin_amdgcn_exp2f(s.x); e.y = __builtin_amdgcn_exp2f(s.y);
    const f32x2 m = v * (q * e), r = v - m;
    f32x2 o; o.x = v.x < 0.f ? m.x : r.x; o.y = v.y < 0.f ? m.y : r.y; return o;
}

struct EpiF32 {
    static constexpr bool PERM = false, AFTER_DRAIN = false;
    float* C; int ldc; const float* bias;
    __device__ __forceinline__ void operator()(const f32x4 (&acc)[2][2][4][2], const Unit& u, int wr, int wc, int fr, int fq) const {
        const int row0 = u.pm * BM + wr * 64 + fr, col0 = u.pn * BM + wc * 32 + 4 * fq;
        f32x4 bv[2][2];
#pragma unroll
        for (int bj = 0; bj < 2; ++bj)
#pragma unroll
            for (int n = 0; n < 2; ++n) bv[bj][n] = bias ? *(const f32x4*)(bias + col0 + bj * HALF + n * 16) : (f32x4){0.f, 0.f, 0.f, 0.f};
#pragma unroll
        for (int ai = 0; ai < 2; ++ai)
#pragma unroll
            for (int m = 0; m < 4; ++m) { float* rowp = C + (size_t)(row0 + ai * HALF + m * 16) * ldc + col0;
#pragma unroll
                for (int bj = 0; bj < 2; ++bj)
#pragma unroll
                    for (int n = 0; n < 2; ++n) *(f32x4*)(rowp + bj * HALF + n * 16) = acc[ai][bj][m][n] + bv[bj][n]; }
    }
};
template <int ACT  > struct EpiBf16 {
    static constexpr bool PERM = true, AFTER_DRAIN = false;
    bf16_t* O; int ldc; const float* bias; int split_cols; size_t split_stride;
    __device__ __forceinline__ void operator()(const f32x4 (&acc)[2][2][4][2], const Unit& u, int wr, int wc, int fr, int fq) const {
        const int row0 = u.pm * BM + wr * 64 + fr; int colt = u.pn * BM; bf16_t* base = O;
        if (split_cols) { const int t = colt / split_cols; base += (size_t)t * split_stride; colt -= t * split_cols; }
        const int col0 = colt + wc * 32 + 8 * fq, bcol0 = u.pn * BM + wc * 32 + 8 * fq;
        f32x4 bv[2][2];
#pragma unroll
        for (int bj = 0; bj < 2; ++bj)
#pragma unroll
            for (int n = 0; n < 2; ++n) bv[bj][n] = bias ? *(const f32x4*)(bias + bcol0 + bj * HALF + 4 * n) : (f32x4){0.f, 0.f, 0.f, 0.f};
#pragma unroll
        for (int ai = 0; ai < 2; ++ai)
#pragma unroll
            for (int m = 0; m < 4; ++m) { bf16_t* rowp = base + (size_t)(row0 + ai * HALF + m * 16) * ldc + col0;
#pragma unroll
                for (int bj = 0; bj < 2; ++bj) { f32x4 v0 = acc[ai][bj][m][0] + bv[bj][0], v1 = acc[ai][bj][m][1] + bv[bj][1];
                    if (ACT == 1) { f32x2 a = gelu_pk((f32x2){v0[0], v0[1]}), b = gelu_pk((f32x2){v0[2], v0[3]}), c = gelu_pk((f32x2){v1[0], v1[1]}), d = gelu_pk((f32x2){v1[2], v1[3]});
                        v0 = (f32x4){a.x, a.y, b.x, b.y}; v1 = (f32x4){c.x, c.y, d.x, d.y}; }
                    if (ACT == 2) {
#pragma unroll
                        for (int j = 0; j < 4; ++j) { v0[j] = 0.5f * v0[j] * (1.0f + erff(v0[j] * 0.70710678f)); v1[j] = 0.5f * v1[j] * (1.0f + erff(v1[j] * 0.70710678f)); } }
                    u32x4 w; w.x = cvt_pk_bf16(v0[0], v0[1]); w.y = cvt_pk_bf16(v0[2], v0[3]); w.z = cvt_pk_bf16(v1[0], v1[1]); w.w = cvt_pk_bf16(v1[2], v1[3]);
                    *(u32x4*)(rowp + bj * HALF) = w; } }
    }
};
template <class Epi, class Sched, bool STAMP = false>
__device__ __forceinline__ void gemm_phase(PG8_LAS unsigned char* lds, const Gemm g, const Sched& S, const Epi& E, unsigned long long* stamps) {
    const int tid = opq_tid(), wid = __builtin_amdgcn_readfirstlane(tid >> 6), lane = tid & 63, wr = wid >> 2, wc = wid & 3, fr = lane & 15, fq = lane >> 4;
    const int K = g.K, nt = K / BK;
    int ts_lo = 0, ts_hi = 0, nts = 0; const unsigned long long rt_entry = STAMP ? (unsigned long long)wall_clock64() : 0ull;
#define PG8_STAMP() do { if (STAMP && wid == 0 && nts < 64) { const unsigned long long _c = (unsigned long long)clock64(); \
        ts_lo = (lane == nts) ? (int)(unsigned)_c : ts_lo; ts_hi = (lane == nts) ? (int)(unsigned)(_c >> 32) : ts_hi; ++nts; } } while (0)
    PG8_STAMP();
    unsigned voffA[2], voffB[2];
#pragma unroll
    for (int i = 0; i < 2; ++i) { int R, C; stage_rc(tid * 16 + i * 8192, R, C); const int Rb = Epi::PERM ? ((R & ~31) + perm32(R & 31)) : R;
        voffA[i] = (unsigned)(R * K + C) * 2u; voffB[i] = (unsigned)(Rb * K + C) * 2u; }
    const size_t kstep = (size_t)(BK * 2);
    const size_t hstep = (size_t)HALF * K * 2;
    const size_t tstep = 2 * hstep;
    const unsigned ldsw = (unsigned)wid * 1024u;
    const int aoff = lds_byte(wr * 64 + fr, fq * 8), boff = lds_byte(wc * 32 + fr, fq * 8);
#define PG8_SA(b, h) (((b) * 2 + (h)) * HTB)
#define PG8_SB(b, h) ((4 + (b) * 2 + (h)) * HTB)
#define PG8_STAGE(bufoff, gbase, voff) do { _Pragma("unroll") for (int _i = 0; _i < 2; ++_i) \
        __builtin_amdgcn_global_load_lds((const unsigned*)((const char*)(gbase) + (voff)[_i]), (PG8_LAS unsigned*)(lds + (bufoff) + ldsw + _i * 8192), 16, 0, 0); } while (0)
#define PG8_LDA(dst, b, h) do { _Pragma("unroll") for (int m = 0; m < 4; ++m) _Pragma("unroll") for (int k = 0; k < 2; ++k) dst[m][k] = *(const PG8_LAS bf16x8*)(lds + PG8_SA(b, h) + aoff + m * 2048 + k * 1024); } while (0)
#define PG8_LDB(dst, b, h) do { _Pragma("unroll") for (int n = 0; n < 2; ++n) _Pragma("unroll") for (int k = 0; k < 2; ++k) dst[n][k] = *(const PG8_LAS bf16x8*)(lds + PG8_SB(b, h) + boff + n * 2048 + k * 1024); } while (0)
#define PG8_MMA(ai, bj, At, Bt) do { __builtin_amdgcn_s_setprio(1); _Pragma("unroll") for (int m = 0; m < 4; ++m) _Pragma("unroll") for (int n = 0; n < 2; ++n) _Pragma("unroll") for (int k = 0; k < 2; ++k) \
        acc[ai][bj][m][n] = __builtin_amdgcn_mfma_f32_16x16x32_bf16(Bt[n][k], At[m][k], acc[ai][bj][m][n], 0, 0, 0); __builtin_amdgcn_s_setprio(0); } while (0)
#define PG8_WAIT_V(n) asm volatile("s_waitcnt vmcnt(" #n ")" ::: "memory")
#define PG8_WAIT_L(n) asm volatile("s_waitcnt lgkmcnt(" #n ")" ::: "memory")
#define PG8_BAR __builtin_amdgcn_s_barrier()
#define PG8_SCHED __builtin_amdgcn_sched_barrier(0)
    Unit cur, nxt; int ui = 0;
    if (!S.next(0, cur)) return;
    f32x4 acc[2][2][4][2];
#pragma unroll
    for (int a = 0; a < 2; ++a)
#pragma unroll
        for (int b = 0; b < 2; ++b)
#pragma unroll
            for (int m = 0; m < 4; ++m)
#pragma unroll
                for (int n = 0; n < 2; ++n) acc[a][b][m][n] = (f32x4){0.f, 0.f, 0.f, 0.f};
    bf16x8 At[4][2], B0[2][2], B1[2][2];
    const char* cA = (const char*)g.A + (size_t)cur.pm * tstep; const char* cB = (const char*)g.Bt + (size_t)cur.pn * tstep;
    S.a_ready(cur);
    PG8_STAGE(PG8_SB(0, 0), cB, voffB); PG8_STAGE(PG8_SA(0, 0), cA, voffA); PG8_STAGE(PG8_SB(0, 1), cB + hstep, voffB); PG8_STAGE(PG8_SA(0, 1), cA + hstep, voffA);
    if (wr == 1) PG8_BAR;
    PG8_WAIT_V(4); PG8_BAR;
    PG8_STAGE(PG8_SB(1, 0), cB + kstep, voffB); PG8_STAGE(PG8_SA(1, 0), cA + kstep, voffA); PG8_STAGE(PG8_SB(1, 1), cB + hstep + kstep, voffB);
    PG8_WAIT_V(6); PG8_BAR;
    PG8_STAMP();
    for (;;) {
        const bool has_next = S.next(ui + 1, nxt);
        const char* nA = has_next ? (const char*)g.A + (size_t)nxt.pm * tstep : cA; const char* nB = has_next ? (const char*)g.Bt + (size_t)nxt.pn * tstep : cB;
        for (int t = 0; t < nt; t += 2) {
            const bool last = (t == nt - 2);
            const char* a1 = cA + (size_t)(t + 1) * kstep;
            const char* a2 = last ? nA : cA + (size_t)(t + 2) * kstep; const char* b2 = last ? nB : cB + (size_t)(t + 2) * kstep;
            const char* a3 = a2 + kstep; const char* b3 = b2 + kstep;
            if (last && has_next) S.a_ready(nxt);
            PG8_LDB(B0, 0, 0); PG8_SCHED; PG8_LDA(At, 0, 0); PG8_STAGE(PG8_SA(1, 1), a1 + hstep, voffA);
            PG8_WAIT_L(8); PG8_BAR; PG8_WAIT_L(0); PG8_MMA(0, 0, At, B0); PG8_BAR; PG8_SCHED;
            PG8_LDB(B1, 0, 1); PG8_STAGE(PG8_SB(0, 0), b2, voffB);
            PG8_BAR; PG8_WAIT_L(0); PG8_MMA(0, 1, At, B1); PG8_BAR;
            PG8_LDA(At, 0, 1); PG8_STAGE(PG8_SA(0, 0), a2, voffA);
            PG8_BAR; PG8_WAIT_L(0); PG8_MMA(1, 0, At, B0); PG8_BAR; PG8_SCHED;
            PG8_STAGE(PG8_SB(0, 1), b2 + hstep, voffB);
            PG8_WAIT_V(6); PG8_BAR; PG8_MMA(1, 1, At, B1); PG8_BAR;
            PG8_LDB(B0, 1, 0); PG8_SCHED; PG8_LDA(At, 1, 0); PG8_STAGE(PG8_SA(0, 1), a2 + hstep, voffA);
            PG8_WAIT_L(8); PG8_BAR; PG8_WAIT_L(0); PG8_MMA(0, 0, At, B0); PG8_BAR; PG8_SCHED;
            PG8_LDB(B1, 1, 1); PG8_STAGE(PG8_SB(1, 0), b3, voffB);
            PG8_BAR; PG8_WAIT_L(0); PG8_MMA(0, 1, At, B1); PG8_BAR;
            PG8_LDA(At, 1, 1); PG8_STAGE(PG8_SA(1, 0), a3, voffA);
            PG8_BAR; PG8_WAIT_L(0); PG8_MMA(1, 0, At, B0); PG8_BAR; PG8_SCHED;
            PG8_STAGE(PG8_SB(1, 1), b3 + hstep, voffB);
            PG8_WAIT_V(6); PG8_BAR; PG8_MMA(1, 1, At, B1); PG8_BAR;
        }
        PG8_STAMP();
        if constexpr (!Epi::AFTER_DRAIN) { E(acc, cur, wr, wc, fr, fq); S.done(cur); }
        PG8_STAMP();
        if (!has_next) break;
#pragma unroll
        for (int a = 0; a < 2; ++a)
#pragma unroll
            for (int b = 0; b < 2; ++b)
#pragma unroll
                for (int m = 0; m < 4; ++m)
#pragma unroll
                    for (int n = 0; n < 2; ++n) acc[a][b][m][n] = (f32x4){0.f, 0.f, 0.f, 0.f};
        cur = nxt; cA = nA; cB = nB; ++ui;
    }
    PG8_WAIT_V(0);
    if (wr == 0) PG8_BAR;
    PG8_BAR;
    if constexpr (Epi::AFTER_DRAIN) { E.fused(acc, cur, wr, wc, fr, fq, lds, wid, lane); S.done(cur); }
    PG8_STAMP();
    if (STAMP && wid == 0) { stamps[lane] = lane < nts ? (((unsigned long long)(unsigned)ts_hi << 32) | (unsigned)ts_lo) : 0ull;
        if (lane == 62) stamps[62] = rt_entry; if (lane == 63) stamps[63] = (unsigned long long)wall_clock64(); }
#undef PG8_STAMP
#undef PG8_SA
#undef PG8_SB
#undef PG8_STAGE
#undef PG8_LDA
#undef PG8_LDB
#undef PG8_MMA
#undef PG8_WAIT_V
#undef PG8_WAIT_L
#undef PG8_BAR
#undef PG8_SCHED
}
}
#include <cstdint>
#include <cstdlib>
#include <vector>

#define XB_TMO      128
#define XB_XCNT(j)  (256  + 64 * (j))
#define XB_XSUB(j)  (1280 + 64 * (j))
#define XB_XGEN(j)  (2304 + 64 * (j))
#define XB_TOP      3328
#define XB_TOPGEN   3392
#define XCD_BAR_WORDS 3456
#define XB_SPIN_CAP (1u << 18)
#define XLAS __attribute__((address_space(3)))

__device__ __forceinline__ unsigned xb_ld(unsigned* p)              { return __hip_atomic_load(p, __ATOMIC_RELAXED, __HIP_MEMORY_SCOPE_AGENT); }
__device__ __forceinline__ unsigned xb_add(unsigned* p, unsigned v) { return __hip_atomic_fetch_add(p, v, __ATOMIC_RELAXED, __HIP_MEMORY_SCOPE_AGENT); }
__device__ __forceinline__ unsigned xb_xcc_id() { return (unsigned)__builtin_amdgcn_s_getreg((3 << 11) | 20) & 0xFu; }
#define XB_SPIN(cond, bar) do { unsigned _sp = 0; while (cond) { __builtin_amdgcn_s_sleep(1); \
    if ((++_sp & 255u) == 0u) { if (xb_ld(&(bar)[XB_TMO])) break; if (_sp > XB_SPIN_CAP) { atomicAdd(&(bar)[XB_TMO], 1u); break; } } } } while (0)

struct XcdBarrier {
    unsigned* bar; unsigned x;
    volatile XLAS unsigned* st;
};

__device__ __forceinline__ XcdBarrier xcd_barrier_post(unsigned* bar, volatile XLAS unsigned* st) {
    XcdBarrier b; b.bar = bar; b.x = xb_xcc_id(); b.st = st;
    if (threadIdx.x == 0) (void)xb_add(&bar[XB_XCNT(b.x)], 1u);
    return b;
}
__device__ __forceinline__ void xcd_barrier_complete(unsigned* bar, unsigned x, unsigned& nloc, unsigned& nx) {
    const unsigned G = gridDim.x * gridDim.y * gridDim.z;
    unsigned sum, cnt, mine, sp = 0u;
    for (;;) {
        sum = 0u; cnt = 0u; mine = 0u;
#pragma unroll
        for (unsigned j = 0; j < 16; ++j) { const unsigned c = xb_ld(&bar[XB_XCNT(j)]); sum += c; cnt += (c > 0u) ? 1u : 0u; mine = (j == x) ? c : mine; }
        if (sum == G) break;
        __builtin_amdgcn_s_sleep(1);
        if ((++sp & 255u) == 0u) { if (xb_ld(&bar[XB_TMO])) break; if (sp > XB_SPIN_CAP) { atomicAdd(&bar[XB_TMO], 1u); break; } }
    }
    nloc = mine > 0u ? mine : 1u; nx = cnt > 0u ? cnt : 1u;
}

__device__ __forceinline__ void xcd_barrier(const XcdBarrier& b) {
    asm volatile("s_waitcnt vmcnt(0)" ::: "memory");
    __syncthreads();
    if (threadIdx.x == 0) {
        unsigned* bar = b.bar;
        __builtin_amdgcn_s_waitcnt(0);
        unsigned nloc = b.st[0], nx = b.st[1];
        if (nloc == 0u) { xcd_barrier_complete(bar, b.x, nloc, nx); b.st[0] = nloc; b.st[1] = nx; }
        const unsigned old = xb_add(&bar[XB_XSUB(b.x)], 1u);
        const unsigned gen = old / nloc;
        if (old + 1u == (gen + 1u) * nloc) {
            __builtin_amdgcn_fence(__ATOMIC_RELEASE, "agent");
            asm volatile("s_waitcnt vmcnt(0)" ::: "memory");
            const unsigned og = xb_add(&bar[XB_TOP], 1u);
            const unsigned tg = og / nx;
            if (og + 1u == (tg + 1u) * nx) xb_add(&bar[XB_TOPGEN], 1u);
            else XB_SPIN(xb_ld(&bar[XB_TOPGEN]) == tg, bar);
            __builtin_amdgcn_fence(__ATOMIC_ACQUIRE, "agent");
            xb_add(&bar[XB_XGEN(b.x)], 1u);
            asm volatile("s_waitcnt vmcnt(0)" ::: "memory");
        } else {
            XB_SPIN(xb_ld(&bar[XB_XGEN(b.x)]) == gen, bar);
            __builtin_amdgcn_fence(__ATOMIC_ACQUIRE, "agent");
            asm volatile("s_waitcnt vmcnt(0)" ::: "memory");
        }
    }
    __syncthreads();
}

#ifndef SKIP
#define SKIP 0
#endif
#define LAS PG8_LAS
typedef pg8::bf16_t bf16_t;
typedef pg8::bf16x8 bf16x8;
typedef pg8::f32x4 f32x4;
typedef pg8::u32x4 u32x4;
typedef unsigned u32x2 __attribute__((ext_vector_type(2)));
constexpr int NP = 16384, NS = 128, NR = NP + NS, MPAD = 16640, DM = 1024, DIN = 3080;
constexpr int LDS_BYTES = 131072 + 16;
constexpr size_t OYS = 16777216, OPP = 16908288, OCP = 17031168, OSP = 17104896, OPS = 18153472, OCS = 20119552, OSS = 21299200;
constexpr size_t WS_WTIN = 0;
constexpr size_t WS_WTOUT = WS_WTIN + 12582912;
constexpr size_t WS_WTPOOL = WS_WTOUT + 4194304;
constexpr size_t WS_MOD = WS_WTPOOL + 262144;
constexpr size_t WS_H = WS_MOD + 6291456;
constexpr size_t WS_P0 = WS_H + 34078720;
constexpr size_t WS_P1 = WS_P0 + 34078720;
constexpr size_t WS_P2 = WS_P1 + 34078720;
constexpr size_t WS_G = WS_P2 + 34078720;
constexpr size_t WS_BETA = WS_G + 264192;
constexpr size_t WS_GL = WS_BETA + 264192;
constexpr size_t WS_W = WS_GL + 4096;
constexpr size_t WS_QG = WS_W + 16777216;
constexpr size_t WS_KGT = WS_QG + 16777216;
constexpr size_t WS_QK = WS_KGT + 16777216;
constexpr size_t WS_U = WS_QK + 8388608;
constexpr size_t WS_WTADA = WS_U;
constexpr size_t WS_AC = WS_U + 12582912;
constexpr size_t WS_BAR = WS_U + 33554432;
constexpr size_t WS_END = WS_BAR + 16384;

struct Params {
    const float* x_prompt; const float* x_sample; const float* c_prompt; const float* c_sample;
    const float* state_pool; const float* state_conv; const float* state_ssm;
    const float* w_ada; const float* b_ada; const float* pre_norm_w; const float* post_norm_w; const float* w_in; const float* conv_w;
    const float* pool_w; const float* pool_scale; const float* a_log; const float* dt_bias; const float* o_norm_w; const float* w_out;
    float* out; unsigned char* ws; int ph_lo, ph_hi;
};

__device__ __forceinline__ float bf2f(unsigned short b) { return __uint_as_float(((unsigned)b) << 16); }
__device__ __forceinline__ unsigned pk2(float lo, float hi) { return pg8::cvt_pk_bf16(lo, hi); }
__device__ __forceinline__ unsigned short f2bf(float f) { return (unsigned short)(pk2(f, 0.f) & 0xffffu); }
__device__ __forceinline__ float silu_f(float x) { return __fdividef(x, 1.0f + __expf(-x)); }
__device__ __forceinline__ void unpack8(const u32x4 v, float* x) {
    x[0] = __uint_as_float(v.x << 16); x[1] = __uint_as_float(v.x & 0xffff0000u); x[2] = __uint_as_float(v.y << 16); x[3] = __uint_as_float(v.y & 0xffff0000u);
    x[4] = __uint_as_float(v.z << 16); x[5] = __uint_as_float(v.z & 0xffff0000u); x[6] = __uint_as_float(v.w << 16); x[7] = __uint_as_float(v.w & 0xffff0000u);
}
__device__ __forceinline__ u32x4 pack8(const float* x) { u32x4 w; w.x = pk2(x[0], x[1]); w.y = pk2(x[2], x[3]); w.z = pk2(x[4], x[5]); w.w = pk2(x[6], x[7]); return w; }
__device__ __forceinline__ float wave_sum(float v) {
#pragma unroll
    for (int o = 32; o >= 1; o >>= 1) v += __shfl_xor(v, o);
    return v;
}

__device__ __forceinline__ void transpose_tile(const float* __restrict__ src, int ld, bf16_t* __restrict__ dst, int ldd, int k0, int n0, LAS float* tile) {
    const int tid = opq_tid();
#pragma unroll
    for (int p = 0; p < 2; ++p) {
        const int kk = (tid >> 4) + 32 * p, n4 = (tid & 15) * 4;
        const float4 v = *(const float4*)(src + (size_t)(k0 + kk) * ld + n0 + n4);
        tile[kk * 65 + n4 + 0] = v.x; tile[kk * 65 + n4 + 1] = v.y; tile[kk * 65 + n4 + 2] = v.z; tile[kk * 65 + n4 + 3] = v.w;
    }
    __syncthreads();
    const int n = tid >> 3, k8 = (tid & 7) * 8;
    float x[8];
#pragma unroll
    for (int i = 0; i < 8; ++i) x[i] = tile[(k8 + i) * 65 + n];
    *(u32x4*)(dst + (size_t)(n0 + n) * ldd + k0 + k8) = pack8(x);
    __syncthreads();
}

__device__ __forceinline__ void phase_convert(const Params& p, LAS unsigned char* lds) {
    LAS float* tile = (LAS float*)lds;
    bf16_t* WtIn = (bf16_t*)(p.ws + WS_WTIN); bf16_t* WtAda = (bf16_t*)(p.ws + WS_WTADA); bf16_t* WtOut = (bf16_t*)(p.ws + WS_WTOUT); bf16_t* WtPool = (bf16_t*)(p.ws + WS_WTPOOL);
    for (int t = blockIdx.x; t < 3616; t += gridDim.x) {
        if (t < 1536) { const int l = t / 768, rem = t % 768; transpose_tile(p.w_in + (size_t)l * 1024 * DIN, DIN, WtIn + (size_t)l * 3072 * 1024, 1024, (rem / 48) * 64, (rem % 48) * 64, tile); }
        else if (t < 3072) { const int tt = t - 1536, l = tt / 768, rem = tt % 768; transpose_tile(p.w_ada + (size_t)l * 1024 * 3072, 3072, WtAda + (size_t)l * 3072 * 1024, 1024, (rem / 48) * 64, (rem % 48) * 64, tile); }
        else if (t < 3584) { const int tt = t - 3072, l = tt / 256, rem = tt % 256; transpose_tile(p.w_out + (size_t)l * 1024 * 1024, 1024, WtOut + (size_t)l * 1024 * 1024, 1024, (rem / 16) * 64, (rem % 16) * 64, tile); }
        else { const int tt = t - 3584, lg = tt / 4, rem = tt % 4; transpose_tile(p.pool_w + (size_t)lg * 16384, 128, WtPool + (size_t)lg * 16384, 128, (rem / 2) * 64, (rem % 2) * 64, tile); }
    }
    bf16_t* Ac = (bf16_t*)(p.ws + WS_AC);
    for (int i = blockIdx.x * 512 + opq_tid(); i < 65536; i += gridDim.x * 512) {
        const int row = i >> 8, c4 = (i & 255) * 4;
        float4 v = make_float4(0.f, 0.f, 0.f, 0.f);
        if (row < 8) v = *(const float4*)(p.c_prompt + row * 1024 + c4); else if (row < 136) v = *(const float4*)(p.c_sample + (row - 8) * 1024 + c4);
        uint2 w; w.x = pk2(silu_f(v.x), silu_f(v.y)); w.y = pk2(silu_f(v.z), silu_f(v.w));
        *(uint2*)(Ac + row * 1024 + c4) = w;
    }
}

__device__ __forceinline__ void phase_rows(const Params& p, int lF, int lA, LAS unsigned char* lds) {
    const int tid = opq_tid(), wid = tid >> 6, lane = tid & 63;
    LAS float* W8t = (LAS float*)lds;
    const float* mod = (const float*)(p.ws + WS_MOD);
    const float* Y = (const float*)(p.ws + WS_P0);
    bf16_t* H = (bf16_t*)(p.ws + WS_H);
    float* Gd = (float*)(p.ws + WS_G); float* Bd = (float*)(p.ws + WS_BETA);
    if (lA >= 0) {
        for (int i = tid; i < 8192; i += 512) { const int k = i >> 3, j = i & 7; W8t[j * 1024 + k] = p.w_in[(size_t)lA * 1024 * DIN + (size_t)k * DIN + 3072 + j]; }
        __syncthreads();
    }
    for (int row = blockIdx.x * 8 + wid; row < NR; row += gridDim.x * 8) {
        const int mrow = row < NP ? (row >> 11) : (8 + row - NP);
        const float* xorig = row < NP ? p.x_prompt + (size_t)row * 1024 : p.x_sample + (size_t)(row - NP) * 1024;
        float* xout = p.out + (size_t)row * 1024;
        float4 xv[4];
        if (lF >= 0) {
            const float* yrow = Y + (size_t)row * 1024; const float* mF = mod + (size_t)mrow * 6144 + lF * 3072 + 2048;
            const float* xsrc = (lF == 0) ? xorig : xout;
            float4 yv[4]; float ss = 0.f;
#pragma unroll
            for (int i = 0; i < 4; ++i) { yv[i] = *(const float4*)(yrow + lane * 4 + 256 * i); ss += yv[i].x * yv[i].x + yv[i].y * yv[i].y + yv[i].z * yv[i].z + yv[i].w * yv[i].w; }
            ss = wave_sum(ss);
            const float rstd = rsqrtf(ss * (1.0f / 1024.0f) + 1e-6f);
#pragma unroll
            for (int i = 0; i < 4; ++i) {
                const int c = lane * 4 + 256 * i;
                const float4 gt = *(const float4*)(mF + c), pw = *(const float4*)(p.post_norm_w + lF * 1024 + c), xi = *(const float4*)(xsrc + c);
                xv[i].x = xi.x + gt.x * (yv[i].x * rstd * pw.x); xv[i].y = xi.y + gt.y * (yv[i].y * rstd * pw.y);
                xv[i].z = xi.z + gt.z * (yv[i].z * rstd * pw.z); xv[i].w = xi.w + gt.w * (yv[i].w * rstd * pw.w);
                *(float4*)(xout + c) = xv[i];
            }
        } else {
#pragma unroll
            for (int i = 0; i < 4; ++i) xv[i] = *(const float4*)(xorig + lane * 4 + 256 * i);
        }
        if (lA >= 0) {
            float ss = 0.f;
#pragma unroll
            for (int i = 0; i < 4; ++i) ss += xv[i].x * xv[i].x + xv[i].y * xv[i].y + xv[i].z * xv[i].z + xv[i].w * xv[i].w;
            ss = wave_sum(ss);
            const float rstd = rsqrtf(ss * (1.0f / 1024.0f) + 1e-6f);
            const float* mA = mod + (size_t)mrow * 6144 + lA * 3072;
            float d[8];
#pragma unroll
            for (int j = 0; j < 8; ++j) d[j] = 0.f;
#pragma unroll
            for (int i = 0; i < 4; ++i) {
                const int c = lane * 4 + 256 * i;
                const float4 sh = *(const float4*)(mA + c), sc = *(const float4*)(mA + 1024 + c), pw = *(const float4*)(p.pre_norm_w + lA * 1024 + c);
                float4 hv;
                hv.x = xv[i].x * rstd * pw.x * (1.0f + sc.x) + sh.x; hv.y = xv[i].y * rstd * pw.y * (1.0f + sc.y) + sh.y;
                hv.z = xv[i].z * rstd * pw.z * (1.0f + sc.z) + sh.z; hv.w = xv[i].w * rstd * pw.w * (1.0f + sc.w) + sh.w;
                uint2 w; w.x = pk2(hv.x, hv.y); w.y = pk2(hv.z, hv.w);
                *(uint2*)(H + (size_t)row * 1024 + c) = w;
#pragma unroll
                for (int j = 0; j < 8; ++j) { const f32x4 wv = *(const LAS f32x4*)(W8t + j * 1024 + c); d[j] += hv.x * wv[0] + hv.y * wv[1] + hv.z * wv[2] + hv.w * wv[3]; }
            }
#pragma unroll
            for (int j = 0; j < 8; ++j) d[j] = wave_sum(d[j]);
            if (lane < 4) {
                const float br = lane == 0 ? d[0] : lane == 1 ? d[1] : lane == 2 ? d[2] : d[3];
                const float ar = lane == 0 ? d[4] : lane == 1 ? d[5] : lane == 2 ? d[6] : d[7];
                const float xs = ar + p.dt_bias[lA * 4 + lane];
                const float sp = fmaxf(xs, 0.f) + log1pf(__expf(-fabsf(xs)));
                Bd[row * 4 + lane] = 1.0f / (1.0f + __expf(-br));
                Gd[row * 4 + lane] = -__expf(p.a_log[lA * 4 + lane]) * sp;
            }
        }
    }
}

__device__ __forceinline__ void conv8(const bf16_t* __restrict__ colp, int tok, const float* __restrict__ cw, float* out, float* xcur) {
    float acc[8];
#pragma unroll
    for (int i = 0; i < 8; ++i) acc[i] = 0.f;
#pragma unroll
    for (int j = 0; j < 4; ++j) {
        if (tok - 3 + j >= 0) {
            const u32x4 v = *(const u32x4*)(colp + (long)(j - 3) * 1024);
            float x[8]; unpack8(v, x);
            const float4 w0 = *(const float4*)(cw + j * 1536), w1 = *(const float4*)(cw + j * 1536 + 4);
            acc[0] += x[0] * w0.x; acc[1] += x[1] * w0.y; acc[2] += x[2] * w0.z; acc[3] += x[3] * w0.w;
            acc[4] += x[4] * w1.x; acc[5] += x[5] * w1.y; acc[6] += x[6] * w1.z; acc[7] += x[7] * w1.w;
            if (j == 3) {
#pragma unroll
                for (int i = 0; i < 8; ++i) xcur[i] = x[i];
            }
        }
    }
#pragma unroll
    for (int i = 0; i < 8; ++i) out[i] = silu_f(acc[i]);
}

__device__ __forceinline__ void chunk_item(const Params& p, int l, int idx, LAS unsigned char* lds) {
    const int tid = opq_tid(), wid = tid >> 6, lane = tid & 63;
    const int b = idx >> 7, h = (idx >> 5) & 3, n = idx & 31, R0 = b * 2048 + n * 64;
    LAS bf16_t* KB = (LAS bf16_t*)lds; LAS bf16_t* QB = (LAS bf16_t*)(lds + 17408);
    LAS float* AT = (LAS float*)(lds + 34816); LAS float* RHS = (LAS float*)(lds + 51200);
    LAS float* GC = (LAS float*)(lds + 116736); LAS float* BT = GC + 64; LAS float* EG = GC + 128;
    const float* Gd = (const float*)(p.ws + WS_G); const float* Bd = (const float*)(p.ws + WS_BETA);
    const bf16_t* P1 = (const bf16_t*)(p.ws + WS_P1); const bf16_t* P2 = (const bf16_t*)(p.ws + WS_P2);
    bf16_t* Wd = (bf16_t*)(p.ws + WS_W) + (size_t)idx * 8192; bf16_t* QGd = (bf16_t*)(p.ws + WS_QG) + (size_t)idx * 8192;
    bf16_t* KGTd = (bf16_t*)(p.ws + WS_KGT) + (size_t)idx * 8192; bf16_t* QKd = (bf16_t*)(p.ws + WS_QK) + (size_t)idx * 4096;
    float* Ud = (float*)(p.ws + WS_U) + (size_t)idx * 8192; float* GLd = (float*)(p.ws + WS_GL);
    if (tid < 64) {
        float v = Gd[(R0 + tid) * 4 + h];
#pragma unroll
        for (int o = 1; o < 64; o <<= 1) { const float t = __shfl_up(v, o); if (lane >= o) v += t; }
        GC[tid] = v; BT[tid] = Bd[(R0 + tid) * 4 + h]; const float e = __expf(v); EG[tid] = e;
        if (tid == 63) GLd[idx] = e;
    }
    __syncthreads();
    {
        const int t = tid >> 3, c0 = (tid & 7) * 16, tok = n * 64 + t;
        const size_t row = (size_t)(R0 + t);
        const float bt = BT[t], eg = EG[t];
        const float* cwl = p.conv_w + (size_t)l * 4 * 1536;
        float s[16], xc[16];
        conv8(P1 + row * 1024 + h * 128 + c0, tok, cwl + h * 128 + c0, s, xc); conv8(P1 + row * 1024 + h * 128 + c0 + 8, tok, cwl + h * 128 + c0 + 8, s + 8, xc + 8);
        if (n == 31 && t >= 61) { float* o = p.out + OCP + ((size_t)(l * 8 + b) * 3 + (t - 61)) * 1536 + h * 128 + c0;
#pragma unroll
            for (int i = 0; i < 16; ++i) o[i] = xc[i]; }
        float ss = 0.f;
#pragma unroll
        for (int i = 0; i < 16; ++i) ss += s[i] * s[i];
        ss += __shfl_xor(ss, 1); ss += __shfl_xor(ss, 2); ss += __shfl_xor(ss, 4);
        float rs = rsqrtf(ss + 1e-6f) * 0.08838834764831845f;
        float qn[16];
#pragma unroll
        for (int i = 0; i < 16; ++i) qn[i] = s[i] * rs;
        *(LAS u32x4*)(QB + t * 136 + c0) = pack8(qn); *(LAS u32x4*)(QB + t * 136 + c0 + 8) = pack8(qn + 8);
#pragma unroll
        for (int i = 0; i < 16; ++i) qn[i] *= eg;
        *(u32x4*)(QGd + t * 128 + c0) = pack8(qn); *(u32x4*)(QGd + t * 128 + c0 + 8) = pack8(qn + 8);
        conv8(P1 + row * 1024 + 512 + h * 128 + c0, tok, cwl + 512 + h * 128 + c0, s, xc); conv8(P1 + row * 1024 + 512 + h * 128 + c0 + 8, tok, cwl + 512 + h * 128 + c0 + 8, s + 8, xc + 8);
        if (n == 31 && t >= 61) { float* o = p.out + OCP + ((size_t)(l * 8 + b) * 3 + (t - 61)) * 1536 + 512 + h * 128 + c0;
#pragma unroll
            for (int i = 0; i < 16; ++i) o[i] = xc[i]; }
        ss = 0.f;
#pragma unroll
        for (int i = 0; i < 16; ++i) ss += s[i] * s[i];
        ss += __shfl_xor(ss, 1); ss += __shfl_xor(ss, 2); ss += __shfl_xor(ss, 4);
        rs = rsqrtf(ss + 1e-6f);
#pragma unroll
        for (int i = 0; i < 16; ++i) s[i] *= rs;
        *(LAS u32x4*)(KB + t * 136 + c0) = pack8(s); *(LAS u32x4*)(KB + t * 136 + c0 + 8) = pack8(s + 8);
        const float be = bt * eg;
#pragma unroll
        for (int i = 0; i < 16; i += 4) *(LAS f32x4*)(RHS + t * 256 + 128 + c0 + i) = (f32x4){s[i] * be, s[i + 1] * be, s[i + 2] * be, s[i + 3] * be};
        conv8(P2 + row * 1024 + h * 128 + c0, tok, cwl + 1024 + h * 128 + c0, s, xc); conv8(P2 + row * 1024 + h * 128 + c0 + 8, tok, cwl + 1024 + h * 128 + c0 + 8, s + 8, xc + 8);
        if (n == 31 && t >= 61) { float* o = p.out + OCP + ((size_t)(l * 8 + b) * 3 + (t - 61)) * 1536 + 1024 + h * 128 + c0;
#pragma unroll
            for (int i = 0; i < 16; ++i) o[i] = xc[i]; }
#pragma unroll
        for (int i = 0; i < 16; i += 4) *(LAS f32x4*)(RHS + t * 256 + c0 + i) = (f32x4){s[i] * bt, s[i + 1] * bt, s[i + 2] * bt, s[i + 3] * bt};
    }
    __syncthreads();
    {
        const int lr = lane & 15, lq = lane >> 4;
#pragma unroll 1
        for (int jj = 0; jj < 4; ++jj) {
            const int job = wid * 4 + jj, which = job >> 4, tile = job & 15, mi = tile >> 2, nj = tile & 3;
            LAS bf16_t* As = which ? QB : KB;
            f32x4 acc = {0.f, 0.f, 0.f, 0.f};
#pragma unroll
            for (int s = 0; s < 4; ++s) {
                const bf16x8 a = *(const LAS bf16x8*)(As + (16 * mi + lr) * 136 + 32 * s + 8 * lq);
                const bf16x8 bb = *(const LAS bf16x8*)(KB + (16 * nj + lr) * 136 + 32 * s + 8 * lq);
                acc = __builtin_amdgcn_mfma_f32_16x16x32_bf16(a, bb, acc, 0, 0, 0);
            }
            const int j = 16 * nj + lr, i0 = 16 * mi + 4 * lq;
            const float gj = GC[j];
            if (!which) {
                f32x4 o;
#pragma unroll
                for (int r = 0; r < 4; ++r) { const int i = i0 + r; o[r] = (i > j) ? BT[i] * acc[r] * __expf(GC[i] - gj) : 0.f; }
                *(LAS f32x4*)(AT + j * 64 + i0) = o;
            } else {
#pragma unroll
                for (int r = 0; r < 4; ++r) { const int i = i0 + r; const float v = (i >= j) ? acc[r] * __expf(GC[i] - gj) : 0.f; QKd[i * 64 + j] = f2bf(v); }
            }
        }
    }
    __syncthreads();
    if (tid < 256) {
        const int c = tid;
        float r[64];
#pragma unroll
        for (int i = 0; i < 64; ++i) r[i] = RHS[i * 256 + c];
#pragma unroll
        for (int j = 0; j < 63; ++j) {
            const float xj = r[j];
#pragma unroll
            for (int i4 = ((j + 1) & ~3); i4 < 64; i4 += 4) {
                const f32x4 a = *(const LAS f32x4*)(AT + j * 64 + i4);
                r[i4 + 0] -= a[0] * xj; r[i4 + 1] -= a[1] * xj; r[i4 + 2] -= a[2] * xj; r[i4 + 3] -= a[3] * xj;
            }
        }
        if (c < 128) {
#pragma unroll
            for (int i = 0; i < 64; ++i) Ud[i * 128 + c] = r[i];
        } else {
#pragma unroll
            for (int i = 0; i < 64; ++i) Wd[i * 128 + (c - 128)] = f2bf(r[i]);
        }
    } else {
        const int d = (tid - 256) >> 1, th = tid & 1;
        const float gcl = GC[63];
        float x[32];
#pragma unroll
        for (int i = 0; i < 32; ++i) { const int t = 32 * th + i; x[i] = bf2f(KB[t * 136 + d]) * __expf(gcl - GC[t]); }
#pragma unroll
        for (int q = 0; q < 4; ++q) *(u32x4*)(KGTd + d * 64 + 32 * th + 8 * q) = pack8(x + 8 * q);
    }
    __syncthreads();
}

__device__ __forceinline__ void pool_item(const Params& p, int l, int pidx, LAS unsigned char* lds) {
    const int tid = opq_tid(), wid = tid >> 6, lane = tid & 63;
    const bool sample = pidx >= 512;
    const int g = sample ? (pidx - 512) : (pidx & 3), T = pidx >> 2, w = 2 << g;
    const int rowbase = sample ? NP : T * 128, b = rowbase >> 11, t0 = rowbase & 2047;
    LAS bf16_t* UT = (LAS bf16_t*)lds; LAS bf16_t* PB = (LAS bf16_t*)(lds + 38912); LAS bf16_t* WB = (LAS bf16_t*)(lds + 73728);
    const bf16_t* P0 = (const bf16_t*)(p.ws + WS_P0);
    const bf16_t* WtPool = (const bf16_t*)(p.ws + WS_WTPOOL) + (size_t)(l * 4 + g) * 16384;
    bf16_t* YM = (bf16_t*)(p.ws + WS_H);
#pragma unroll
    for (int q = 0; q < 4; ++q) { const int piece = tid + 512 * q, d = piece >> 4, k8 = (piece & 15) * 8; *(LAS u32x4*)(WB + d * 136 + k8) = *(const u32x4*)(WtPool + d * 128 + k8); }
    if (!sample) {
        for (int piece = tid; piece < 143 * 16; piece += 512) {
            const int rr = piece >> 4, c8 = (piece & 15) * 8, tok = t0 - 15 + rr;
            u32x4 v = {0u, 0u, 0u, 0u};
            if (tok >= 0) v = *(const u32x4*)(P0 + (size_t)(b * 2048 + tok) * 1024 + g * 128 + c8);
            *(LAS u32x4*)(UT + rr * 136 + c8) = v;
        }
    } else {
        for (int piece = tid; piece < 128 * 16; piece += 512) {
            const int rr = piece >> 4, c8 = (piece & 15) * 8;
            *(LAS u32x4*)(UT + rr * 136 + c8) = *(const u32x4*)(P0 + (size_t)(NP + rr) * 1024 + g * 128 + c8);
        }
    }
    __syncthreads();
    {
        const int c = tid & 127, q = tid >> 7, i0 = 32 * q;
        if (!sample) {
            float s = 0.f;
            for (int j = 1; j < w; ++j) s += bf2f(UT[(i0 + 15 - j) * 136 + c]);
            for (int i = i0; i < i0 + 32; ++i) {
                const float cur = bf2f(UT[(i + 15) * 136 + c]);
                s += cur;
                const int tk = t0 + i + 1; const float cnt = (float)(tk < w ? tk : w);
                PB[i * 136 + c] = f2bf(s / cnt - cur);
                s -= bf2f(UT[(i + 15 - (w - 1)) * 136 + c]);
                if (t0 == 1920 && i >= 113) p.out[OPP + ((size_t)(l * 8 + b) * 15 + (i - 113)) * 512 + g * 128 + c] = cur;
            }
        } else {
            for (int i = i0; i < i0 + 32; ++i) {
                const float cur = bf2f(UT[i * 136 + c]);
                const float* sp = p.state_pool + ((size_t)(l * 128 + i) * 15) * 512 + g * 128 + c;
                float* op = p.out + OPS + ((size_t)(l * 128 + i) * 15) * 512 + g * 128 + c;
                float s = cur;
                if (w == 16) s += sp[0];
                for (int j = 0; j < 14; ++j) { const float v = sp[(size_t)(j + 1) * 512]; op[(size_t)j * 512] = v; if (14 - (j + 1) <= w - 2) s += v; }
                op[(size_t)14 * 512] = cur;
                PB[i * 136 + c] = f2bf(s / (float)w - cur);
            }
        }
    }
    __syncthreads();
    {
        const int lr = lane & 15, lq = lane >> 4;
        bf16x8 a[4];
#pragma unroll
        for (int s = 0; s < 4; ++s) a[s] = *(const LAS bf16x8*)(PB + (16 * wid + lr) * 136 + 32 * s + 8 * lq);
#pragma unroll 2
        for (int nt = 0; nt < 8; ++nt) {
            f32x4 acc = {0.f, 0.f, 0.f, 0.f};
#pragma unroll
            for (int s = 0; s < 4; ++s) { const bf16x8 bb = *(const LAS bf16x8*)(WB + (16 * nt + lr) * 136 + 32 * s + 8 * lq); acc = __builtin_amdgcn_mfma_f32_16x16x32_bf16(a[s], bb, acc, 0, 0, 0); }
            const int d = g * 128 + 16 * nt + lr;
            const float ps = p.pool_scale[l * 512 + d];
#pragma unroll
            for (int r = 0; r < 4; ++r) {
                const size_t row = (size_t)(rowbase + 16 * wid + 4 * lq + r);
                const float za = bf2f(P0[row * 1024 + 512 + d]);
                YM[row * 1024 + d] = f2bf(acc[r] * ps * silu_f(za));
            }
        }
    }
    __syncthreads();
}

__device__ __forceinline__ void sample_item(const Params& p, int l, int b, LAS unsigned char* lds) {
    const int tid = opq_tid(), wid = tid >> 6, lane = tid & 63;
    const int hd = tid >> 7, e = tid & 127;
    const size_t r = (size_t)(NP + b);
    LAS float* SQ = (LAS float*)lds; LAS float* SK = SQ + 512; LAS float* SV = SQ + 1024; LAS float* SO = SQ + 1536;
    LAS float* RED = SQ + 2048; LAS float* RED2 = SQ + 2560; LAS float* RW = SQ + 3072;
    const bf16_t* P1 = (const bf16_t*)(p.ws + WS_P1); const bf16_t* P2 = (const bf16_t*)(p.ws + WS_P2);
    const float* Gd = (const float*)(p.ws + WS_G); const float* Bd = (const float*)(p.ws + WS_BETA);
    bf16_t* YM = (bf16_t*)(p.ws + WS_H);
    const float* sc = p.state_conv + (size_t)(l * 128 + b) * 3 * 1536; const float* cw = p.conv_w + (size_t)l * 4 * 1536;
    float* oc = p.out + OCS + (size_t)(l * 128 + b) * 3 * 1536;
    float xin[3], cv[3];
    xin[0] = bf2f(P1[r * 1024 + tid]); xin[1] = bf2f(P1[r * 1024 + 512 + tid]); xin[2] = bf2f(P2[r * 1024 + tid]);
#pragma unroll
    for (int k = 0; k < 3; ++k) {
        const int ch = tid + 512 * k;
        const float b0 = sc[ch], b1 = sc[1536 + ch], b2 = sc[3072 + ch];
        cv[k] = silu_f(b0 * cw[ch] + b1 * cw[1536 + ch] + b2 * cw[3072 + ch] + xin[k] * cw[4608 + ch]);
        oc[ch] = b1; oc[1536 + ch] = b2; oc[3072 + ch] = xin[k];
    }
    const float sq = wave_sum(cv[0] * cv[0]), sk = wave_sum(cv[1] * cv[1]);
    if (lane == 0) { RW[wid] = sq; RW[8 + wid] = sk; }
    __syncthreads();
    {
        const float ssq = RW[2 * hd] + RW[2 * hd + 1], ssk = RW[8 + 2 * hd] + RW[8 + 2 * hd + 1];
        SQ[tid] = cv[0] * rsqrtf(ssq + 1e-6f) * 0.08838834764831845f; SK[tid] = cv[1] * rsqrtf(ssk + 1e-6f); SV[tid] = cv[2];
    }
    __syncthreads();
#pragma unroll 1
    for (int hh = 0; hh < 4; ++hh) {
        const int part = hd;
        const float eg = __expf(Gd[r * 4 + hh]), bt = Bd[r * 4 + hh];
        const float* Sin = p.state_ssm + ((size_t)((l * 128 + b) * 4 + hh) * 128) * 128;
        float* Sout = p.out + OSS + ((size_t)((l * 128 + b) * 4 + hh) * 128) * 128;
        float kvp = 0.f;
#pragma unroll 8
        for (int dd = 0; dd < 32; ++dd) { const int d = part * 32 + dd; kvp += SK[hh * 128 + d] * Sin[d * 128 + e]; }
        RED[part * 128 + e] = kvp * eg;
        __syncthreads();
        const float kv = RED[e] + RED[128 + e] + RED[256 + e] + RED[384 + e];
        const float delta = (SV[hh * 128 + e] - kv) * bt;
        float op = 0.f;
#pragma unroll 8
        for (int dd = 0; dd < 32; ++dd) { const int d = part * 32 + dd; const float sv = Sin[d * 128 + e] * eg + SK[hh * 128 + d] * delta; Sout[d * 128 + e] = sv; op += SQ[hh * 128 + d] * sv; }
        RED2[part * 128 + e] = op;
        __syncthreads();
        if (part == 0) SO[hh * 128 + e] = RED2[e] + RED2[128 + e] + RED2[256 + e] + RED2[384 + e];
    }
    __syncthreads();
    const float o = SO[tid];
    const float so = wave_sum(o * o);
    if (lane == 0) RW[16 + wid] = so;
    __syncthreads();
    {
        const float rstd = rsqrtf((RW[16 + 2 * hd] + RW[16 + 2 * hd + 1]) * (1.0f / 128.0f) + 1e-6f);
        const float zb = bf2f(P2[r * 1024 + 512 + tid]);
        YM[r * 1024 + 512 + tid] = f2bf(o * rstd * p.o_norm_w[l * 128 + e] * silu_f(zb));
    }
    __syncthreads();
}

__device__ __forceinline__ void phase_post(const Params& p, int l, LAS unsigned char* lds) {
    for (int idx = blockIdx.x; idx < 1024 + 516 + 128; idx += gridDim.x) {
        if (idx < 1024) { if (!(SKIP & 128)) chunk_item(p, l, idx, lds); }
        else if (idx < 1540) { if (!(SKIP & 256)) pool_item(p, l, idx - 1024, lds); }
        else { if (!(SKIP & 512)) sample_item(p, l, idx - 1540, lds); }
    }
}

struct ScanOps { bf16x8 wA[4], qA[4], qkA[2], kgA[2]; float u[4]; float gl; };
__device__ __forceinline__ void scan_load(ScanOps& o, const Params& p, int ci, int m, int n, int wid, int lr, int lq, int slice) {
    const bf16_t* Wd = (const bf16_t*)(p.ws + WS_W) + (size_t)ci * 8192; const bf16_t* QGd = (const bf16_t*)(p.ws + WS_QG) + (size_t)ci * 8192;
    const bf16_t* KGTd = (const bf16_t*)(p.ws + WS_KGT) + (size_t)ci * 8192; const bf16_t* QKd = (const bf16_t*)(p.ws + WS_QK) + (size_t)ci * 4096;
    const float* Ud = (const float*)(p.ws + WS_U) + (size_t)ci * 8192;
#pragma unroll
    for (int s = 0; s < 4; ++s) { o.wA[s] = *(const bf16x8*)(Wd + (16 * m + lr) * 128 + 32 * s + 8 * lq); o.qA[s] = *(const bf16x8*)(QGd + (16 * m + lr) * 128 + 32 * s + 8 * lq); }
#pragma unroll
    for (int s = 0; s < 2; ++s) { o.qkA[s] = *(const bf16x8*)(QKd + (16 * m + lr) * 64 + 32 * s + 8 * lq); o.kgA[s] = *(const bf16x8*)(KGTd + (16 * wid + lr) * 64 + 32 * s + 8 * lq); }
#pragma unroll
    for (int r = 0; r < 4; ++r) o.u[r] = Ud[(16 * m + 4 * lq + r) * 128 + 32 * slice + 16 * n + lr];
    o.gl = ((const float*)(p.ws + WS_GL))[ci];
}

__device__ __forceinline__ void scan_item(const Params& p, int l, int bh, int slice, LAS unsigned char* lds) {
    const int tid = opq_tid(), wid = tid >> 6, lane = tid & 63, lr = lane & 15, lq = lane >> 4, m = wid & 3, n = wid >> 2;
    const int b = bh >> 2, h = bh & 3;
    LAS bf16_t* ST = (LAS bf16_t*)lds;
    LAS bf16_t* VT = (LAS bf16_t*)(lds + 8704);
    float* Od = (float*)(p.ws + WS_P0);
    for (int i = tid; i < 32 * 136 / 2; i += 512) ((LAS unsigned*)ST)[i] = 0u;
    f32x4 Sacc[2] = {{0.f, 0.f, 0.f, 0.f}, {0.f, 0.f, 0.f, 0.f}};
    ScanOps cur; scan_load(cur, p, bh * 32, m, n, wid, lr, lq, slice);
    __syncthreads();
#pragma unroll 1
    for (int nc = 0; nc < 32; ++nc) {
        ScanOps nxt; scan_load(nxt, p, bh * 32 + (nc < 31 ? nc + 1 : nc), m, n, wid, lr, lq, slice);
        f32x4 P = {0.f, 0.f, 0.f, 0.f}, Q = {0.f, 0.f, 0.f, 0.f};
#pragma unroll
        for (int s = 0; s < 4; ++s) {
            const bf16x8 sb = *(const LAS bf16x8*)(ST + (16 * n + lr) * 136 + 32 * s + 8 * lq);
            P = __builtin_amdgcn_mfma_f32_16x16x32_bf16(cur.wA[s], sb, P, 0, 0, 0);
            Q = __builtin_amdgcn_mfma_f32_16x16x32_bf16(cur.qA[s], sb, Q, 0, 0, 0);
        }
        {
            u32x2 w; w.x = pk2(cur.u[0] - P[0], cur.u[1] - P[1]); w.y = pk2(cur.u[2] - P[2], cur.u[3] - P[3]);
            *(LAS u32x2*)(VT + (16 * n + lr) * 72 + 16 * m + 4 * lq) = w;
        }
        __syncthreads();
        bf16x8 vb[2][2];
#pragma unroll
        for (int nn = 0; nn < 2; ++nn)
#pragma unroll
            for (int s = 0; s < 2; ++s) vb[nn][s] = *(const LAS bf16x8*)(VT + (16 * nn + lr) * 72 + 32 * s + 8 * lq);
        Q = __builtin_amdgcn_mfma_f32_16x16x32_bf16(cur.qkA[0], n ? vb[1][0] : vb[0][0], Q, 0, 0, 0);
        Q = __builtin_amdgcn_mfma_f32_16x16x32_bf16(cur.qkA[1], n ? vb[1][1] : vb[0][1], Q, 0, 0, 0);
        {
            const size_t R0 = (size_t)b * 2048 + nc * 64;
#pragma unroll
            for (int r = 0; r < 4; ++r) Od[(R0 + 16 * m + 4 * lq + r) * 512 + h * 128 + 32 * slice + 16 * n + lr] = Q[r];
        }
#pragma unroll
        for (int nn = 0; nn < 2; ++nn) {
            Sacc[nn] = Sacc[nn] * cur.gl;
            Sacc[nn] = __builtin_amdgcn_mfma_f32_16x16x32_bf16(cur.kgA[0], vb[nn][0], Sacc[nn], 0, 0, 0);
            Sacc[nn] = __builtin_amdgcn_mfma_f32_16x16x32_bf16(cur.kgA[1], vb[nn][1], Sacc[nn], 0, 0, 0);
            u32x2 w; w.x = pk2(Sacc[nn][0], Sacc[nn][1]); w.y = pk2(Sacc[nn][2], Sacc[nn][3]);
            *(LAS u32x2*)(ST + (16 * nn + lr) * 136 + 16 * wid + 4 * lq) = w;
        }
        __syncthreads();
        cur = nxt;
    }
    float* So = p.out + OSP + ((size_t)((l * 8 + b) * 4 + h) * 128) * 128;
#pragma unroll
    for (int nn = 0; nn < 2; ++nn)
#pragma unroll
        for (int r = 0; r < 4; ++r) So[(16 * wid + 4 * lq + r) * 128 + 32 * slice + 16 * nn + lr] = Sacc[nn][r];
}

__device__ __forceinline__ void phase_scan(const Params& p, int l, LAS unsigned char* lds) {
    for (int blk = blockIdx.x; blk < 128; blk += gridDim.x) {
        const int bh = (blk & 7) + 8 * (blk >> 5), slice = (blk >> 3) & 3;
        scan_item(p, l, bh, slice, lds);
        __syncthreads();
    }
}

__device__ __forceinline__ void phase_onorm(const Params& p, int l) {
    const int tid = opq_tid(), wid = tid >> 6, lane = tid & 63;
    const float* Od = (const float*)(p.ws + WS_P0); const bf16_t* P2 = (const bf16_t*)(p.ws + WS_P2); bf16_t* YM = (bf16_t*)(p.ws + WS_H);
    const int c = lane * 8;
    const float4 w0 = *(const float4*)(p.o_norm_w + l * 128 + (c & 127)), w1 = *(const float4*)(p.o_norm_w + l * 128 + (c & 127) + 4);
    for (int row = blockIdx.x * 8 + wid; row < NP; row += gridDim.x * 8) {
        const float4 a = *(const float4*)(Od + (size_t)row * 512 + c), bq = *(const float4*)(Od + (size_t)row * 512 + c + 4);
        float ss = a.x * a.x + a.y * a.y + a.z * a.z + a.w * a.w + bq.x * bq.x + bq.y * bq.y + bq.z * bq.z + bq.w * bq.w;
        ss += __shfl_xor(ss, 1); ss += __shfl_xor(ss, 2); ss += __shfl_xor(ss, 4); ss += __shfl_xor(ss, 8);
        const float rstd = rsqrtf(ss * (1.0f / 128.0f) + 1e-6f);
        float z[8]; unpack8(*(const u32x4*)(P2 + (size_t)row * 1024 + 512 + c), z);
        float y[8];
        y[0] = a.x * rstd * w0.x * silu_f(z[0]); y[1] = a.y * rstd * w0.y * silu_f(z[1]); y[2] = a.z * rstd * w0.z * silu_f(z[2]); y[3] = a.w * rstd * w0.w * silu_f(z[3]);
        y[4] = bq.x * rstd * w1.x * silu_f(z[4]); y[5] = bq.y * rstd * w1.y * silu_f(z[5]); y[6] = bq.z * rstd * w1.z * silu_f(z[6]); y[7] = bq.w * rstd * w1.w * silu_f(z[7]);
        *(u32x4*)(YM + (size_t)row * 1024 + 512 + c) = pack8(y);
    }
}

__global__ void __launch_bounds__(512, 2) mk_fwd(Params p) {
    extern __shared__ __attribute__((aligned(16))) unsigned char shm[];
    LAS unsigned char* lds = (LAS unsigned char*)shm;
    cg::grid_group grid = cg::this_grid();
    volatile XLAS unsigned* xst = (volatile XLAS unsigned*)(lds + 131072);
    if (threadIdx.x == 0) { xst[0] = 0u; xst[1] = 0u; }
    __syncthreads();
    const XcdBarrier xb = xcd_barrier_post((unsigned*)(p.ws + WS_BAR), xst);
    if (p.ph_lo < 0) grid.sync();
    for (int ph = p.ph_lo; ph < p.ph_hi; ++ph) {
        if (ph == 0) { if (!(SKIP & 1)) phase_convert(p, lds); }
        else if (ph == 2) { if (!(SKIP & 2)) phase_rows(p, -1, 0, lds); }
        else {
            const int l = ph >= 3 ? (ph - 3) / 6 : 0, k = ph >= 3 ? (ph - 3) % 6 : -1;
            if (ph == 1 || k == 4) { if (!(SKIP & 4)) {
                pg8::Gemm g; pg8::EpiF32 E;
                if (ph == 1) { g.A = (const bf16_t*)(p.ws + WS_AC); g.Bt = (const bf16_t*)(p.ws + WS_WTADA); g.M = 256; g.N = 6144; g.K = 1024; E.C = (float*)(p.ws + WS_MOD); E.ldc = 6144; E.bias = p.b_ada; }
                else { g.A = (const bf16_t*)(p.ws + WS_H); g.Bt = (const bf16_t*)(p.ws + WS_WTOUT) + (size_t)l * 1024 * 1024; g.M = MPAD; g.N = 1024; g.K = 1024; E.C = (float*)(p.ws + WS_P0); E.ldc = 1024; E.bias = nullptr; }
                pg8::StaticOrder S; S.init(g.M, g.N, (int)gridDim.x, (int)blockIdx.x);
                pg8::gemm_phase<pg8::EpiF32, pg8::StaticOrder, false>(lds, g, S, E, nullptr); }
            } else if (k == 0) { if (!(SKIP & 8)) {
                pg8::Gemm g; g.A = (const bf16_t*)(p.ws + WS_H); g.Bt = (const bf16_t*)(p.ws + WS_WTIN) + (size_t)l * 3072 * 1024; g.M = MPAD; g.N = 3072; g.K = 1024;
                pg8::EpiBf16<0> E; E.O = (bf16_t*)(p.ws + WS_P0); E.ldc = 1024; E.bias = nullptr; E.split_cols = 1024; E.split_stride = (size_t)MPAD * 1024;
                pg8::StaticOrder S; S.init(g.M, g.N, (int)gridDim.x, (int)blockIdx.x);
                pg8::gemm_phase<pg8::EpiBf16<0>, pg8::StaticOrder, false>(lds, g, S, E, nullptr); }
            } else if (k == 1) { if (!(SKIP & 16)) phase_post(p, l, lds); }
            else if (k == 2) { if (!(SKIP & 32)) phase_scan(p, l, lds); }
            else if (k == 3) { if (!(SKIP & 64)) phase_onorm(p, l); }
            else if (k == 5) { if (!(SKIP & 2)) phase_rows(p, l, l + 1 < 2 ? l + 1 : -1, lds); }
        }
#ifdef PROBE_KIND
        {
            const int l2 = ph >= 3 ? (ph - 3) / 6 : 0, k2 = ph >= 3 ? (ph - 3) % 6 : -1;
            for (int rep = 0; rep < PROBE_N; ++rep) {
                if (PROBE_KIND == 6 && ph == 2) xcd_barrier(xb);
                if (PROBE_KIND == 1 && k2 == 1) phase_post(p, l2, lds);
                if (PROBE_KIND == 2 && k2 == 2) phase_scan(p, l2, lds);
                if (PROBE_KIND == 3 && k2 == 3) phase_onorm(p, l2);
                if (PROBE_KIND == 5 && ph == 2) phase_rows(p, -1, 0, lds);
            }
        }
#endif
        if (ph + 1 < p.ph_hi) xcd_barrier(xb);
    }
}

extern "C" void kernel_launch(void* const* d_in, const int* in_sizes, int n_in, void* d_out, int out_size, void* d_ws, size_t ws_size, hipStream_t stream) {
    static int grid = 0;
    if (grid == 0) {
        if (n_in != 19 || ws_size < WS_END) { fprintf(stderr, "kernel_launch: unexpected n_in %d or ws_size %zu (< %zu)\n", n_in, ws_size, (size_t)WS_END); grid = -1; return; }
        int dev = 0, cus = 0, per_cu = 0;
        hipGetDevice(&dev); hipDeviceGetAttribute(&cus, hipDeviceAttributeMultiprocessorCount, dev);
        if (hipFuncSetAttribute((const void*)mk_fwd, hipFuncAttributeMaxDynamicSharedMemorySize, LDS_BYTES) != hipSuccess) { fprintf(stderr, "kernel_launch: hipFuncSetAttribute failed\n"); }
        if (hipOccupancyMaxActiveBlocksPerMultiprocessor(&per_cu, (const void*)mk_fwd, 512, LDS_BYTES) != hipSuccess || per_cu < 1) per_cu = 1;
        (void)hipGetLastError();
        grid = cus * 1;
        if (grid <= 0) grid = 256;
    }
    if (grid < 0) return;
    if (hipMemsetAsync((char*)d_ws + WS_BAR, 0, 16384, stream) != hipSuccess) { fprintf(stderr, "kernel_launch: memset failed\n"); return; }
    Params p{};
    const float** f = (const float**)&p;
    for (int i = 0; i < 19; ++i) f[i] = (const float*)d_in[i];
    p.out = (float*)d_out; p.ws = (unsigned char*)d_ws; p.ph_lo = 0; p.ph_hi = 15;
    void* args[] = {&p};
    hipError_t e = hipLaunchCooperativeKernel((const void*)mk_fwd, dim3(grid), dim3(512), args, LDS_BYTES, stream);
    if (e != hipSuccess) fprintf(stderr, "cooperative launch failed: %s (grid %d)\n", hipGetErrorString(e), grid);
}
```

```cpp
#include <hip/hip_runtime.h>
#include <hip/hip_cooperative_groups.h>
#include <cstdio>
namespace cg = cooperative_groups;
__device__ __forceinline__ int opq_tid() { int t = (int)threadIdx.x; asm volatile("" : "+v"(t)); return t; }
namespace pg8 {
#define PG8_LAS __attribute__((address_space(3)))
typedef unsigned short bf16_t;
typedef short bf16x8 __attribute__((ext_vector_type(8)));
typedef float f32x4 __attribute__((ext_vector_type(4)));
typedef unsigned u32x4 __attribute__((ext_vector_type(4)));
constexpr int BM = 256, BK = 64, HALF = 128, HTB = HALF * BK * 2  , STAGE_BYTES = 8 * HTB, NXCD = 8, WGM = 8;

__host__ __device__ __forceinline__ int lds_byte(int r, int c) { const int st = (r >> 4) * 2 + (c >> 5), rr = r & 15, cc = c & 31, ob = rr * 64 + cc * 2; return st * 1024 + (ob ^ (((ob >> 9) & 1) << 5)); }
__host__ __device__ __forceinline__ void stage_rc(int b, int& R, int& C) { const int st = b / 1024, sb = b % 1024, swz = sb ^ (((sb >> 9) & 1) << 5); R = (st >> 1) * 16 + swz / 64; C = (st & 1) * 32 + (swz % 64) / 2; }
__host__ __device__ __forceinline__ int perm32(int rho) { const int n = rho >> 4, i = rho & 15; return 8 * (i >> 2) + 4 * n + (i & 3); }

struct Unit { int pm, pn; };
struct Gemm { const bf16_t* A; const bf16_t* Bt; int M, N, K; };
struct StaticOrder {
    int nM, nN, nwg, G, c;
    __host__ __device__ void init(int M, int N, int G_, int c_) { nM = M / BM; nN = N / BM; nwg = nM * nN; G = G_; c = c_; }
    __host__ __device__ bool next(int i, Unit& u) const {
        const long L = (long)i * G + c; if (L >= nwg) return false;
        int wgid = (int)L; { const int q = nwg / NXCD, r = nwg % NXCD, xcd = wgid % NXCD, off = wgid / NXCD; wgid = (xcd < r ? xcd * (q + 1) : r * (q + 1) + (xcd - r) * q) + off; }
        const int nig = WGM * nN, gid = wgid / nig, fm = gid * WGM, gsz = (nM - fm) < WGM ? (nM - fm) : WGM;
        u.pm = fm + ((wgid % nig) % gsz); u.pn = (wgid % nig) / gsz; return true;
    }
    __device__ __forceinline__ void a_ready(const Unit&) const {}
    __device__ __forceinline__ void done(const Unit&) const {}
};
__device__ __forceinline__ unsigned cvt_pk_bf16(float lo, float hi) { unsigned r; asm volatile("v_cvt_pk_bf16_f32 %0, %1, %2" : "=v"(r) : "v"(lo), "v"(hi)); return r; }
typedef float f32x2 __attribute__((ext_vector_type(2)));
__device__ __forceinline__ f32x2 gelu_pk(f32x2 v) {
    const f32x2 av = __builtin_elementwise_abs(v), d = av * 0.2316418882f + 1.0f;
    f32x2 t; t.x = __builtin_amdgcn_rcpf(d.x); t.y = __builtin_amdgcn_rcpf(d.y);
    f32x2 q = t * 0.5307027145f + (-0.7265760135f); q = q * t + 0.7107068705f; q = q * t + (-0.142248368f); q = q * t + 0.127414796f; q = q * t;
    const f32x2 s = (v * v) * (-0.72134752044f);
    f32x2 e; e.x = __builtin_amdgcn_exp2f(s.x); e.y = __builtin_amdgcn_exp2f(s.y);
    const f32x2 m = v * (q * e), r = v - m;
    f32x2 o; o.x = v.x < 0.f ? m.x : r.x; o.y = v.y < 0.f ? m.y : r.y; return o;
}

struct EpiF32 {
    static constexpr bool PERM = false, AFTER_DRAIN = false;
    float* C; int ldc; const float* bias;
    __device__ __forceinline__ void operator()(const f32x4 (&acc)[2][2][4][2], const Unit& u, int wr, int wc, int fr, int fq) const {
        const int row0 = u.pm * BM + wr * 64 + fr, col0 = u.pn * BM + wc * 32 + 4 * fq;
        f32x4 bv[2][2];
#pragma unroll
        for (int bj = 0; bj < 2; ++bj)
#pragma unroll
            for (int n = 0; n < 2; ++n) bv[bj][n] = bias ? *(const f32x4*)(bias + col0 + bj * HALF + n * 16) : (f32x4){0.f, 0.f, 0.f, 0.f};
#pragma unroll
        for (int ai = 0; ai < 2; ++ai)
#pragma unroll
            for (int m = 0; m < 4; ++m) { float* rowp = C + (size_t)(row0 + ai * HALF + m * 16) * ldc + col0;
#pragma unroll
                for (int bj = 0; bj < 2; ++bj)
#pragma unroll
                    for (int n = 0; n < 2; ++n) *(f32x4*)(rowp + bj * HALF + n * 16) = acc[ai][bj][m][n] + bv[bj][n]; }
    }
};
template <int ACT  > struct EpiBf16 {
    static constexpr bool PERM = true, AFTER_DRAIN = false;
    bf16_t* O; int ldc; const float* bias; int split_cols; size_t split_stride;
    __device__ __forceinline__ void operator()(const f32x4 (&acc)[2][2][4][2], const Unit& u, int wr, int wc, int fr, int fq) const {
        const int row0 = u.pm * BM + wr * 64 + fr; int colt = u.pn * BM; bf16_t* base = O;
        if (split_cols) { const int t = colt / split_cols; base += (size_t)t * split_stride; colt -= t * split_cols; }
        const int col0 = colt + wc * 32 + 8 * fq, bcol0 = u.pn * BM + wc * 32 + 8 * fq;
        f32x4 bv[2][2];
#pragma unroll
        for (int bj = 0; bj < 2; ++bj)
#pragma unroll
            for (int n = 0; n < 2; ++n) bv[bj][n] = bias ? *(const f32x4*)(bias + bcol0 + bj * HALF + 4 * n) : (f32x4){0.f, 0.f, 0.f, 0.f};
#pragma unroll
        for (int ai = 0; ai < 2; ++ai)
#pragma unroll
            for (int m = 0; m < 4; ++m) { bf16_t* rowp = base + (size_t)(row0 + ai * HALF + m * 16) * ldc + col0;
#pragma unroll
                for (int bj = 0; bj < 2; ++bj) { f32x4 v0 = acc[ai][bj][m][0] + bv[bj][0], v1 = acc[ai][bj][m][1] + bv[bj][1];
                    if (ACT == 1) { f32x2 a = gelu_pk((f32x2){v0[0], v0[1]}), b = gelu_pk((f32x2){v0[2], v0[3]}), c = gelu_pk((f32x2){v1[0], v1[1]}), d = gelu_pk((f32x2){v1[2], v1[3]});
                        v0 = (f32x4){a.x, a.y, b.x, b.y}; v1 = (f32x4){c.x, c.y, d.x, d.y}; }
                    if (ACT == 2) {
#pragma unroll
                        for (int j = 0; j < 4; ++j) { v0[j] = 0.5f * v0[j] * (1.0f + erff(v0[j] * 0.70710678f)); v1[j] = 0.5f * v1[j] * (1.0f + erff(v1[j] * 0.70710678f)); } }
                    u32x4 w; w.x = cvt_pk_bf16(v0[0], v0[1]); w.y = cvt_pk_bf16(v0[2], v0[3]); w.z = cvt_pk_bf16(v1[0], v1[1]); w.w = cvt_pk_bf16(v1[2], v1[3]);
                    *(u32x4*)(rowp + bj * HALF) = w; } }
    }
};
template <class Epi, class Sched, bool STAMP = false>
__device__ __forceinline__ void gemm_phase(PG8_LAS unsigned char* lds, const Gemm g, const Sched& S, const Epi& E, unsigned long long* stamps) {
    const int tid = opq_tid(), wid = __builtin_amdgcn_readfirstlane(tid >> 6), lane = tid & 63, wr = wid >> 2, wc = wid & 3, fr = lane & 15, fq = lane >> 4;
    const int K = g.K, nt = K / BK;
    int ts_lo = 0, ts_hi = 0, nts = 0; const unsigned long long rt_entry = STAMP ? (unsigned long long)wall_clock64() : 0ull;
#define PG8_STAMP() do { if (STAMP && wid == 0 && nts < 64) { const unsigned long long _c = (unsigned long long)clock64(); \
        ts_lo = (lane == nts) ? (int)(unsigned)_c : ts_lo; ts_hi = (lane == nts) ? (int)(unsigned)(_c >> 32) : ts_hi; ++nts; } } while (0)
    PG8_STAMP();
    unsigned voffA[2], voffB[2];
#pragma unroll
    for (int i = 0; i < 2; ++i) { int R, C; stage_rc(tid * 16 + i * 8192, R, C); const int Rb = Epi::PERM ? ((R & ~31) + perm32(R & 31)) : R;
        voffA[i] = (unsigned)(R * K + C) * 2u; voffB[i] = (unsigned)(Rb * K + C) * 2u; }
    const size_t kstep = (size_t)(BK * 2);
    const size_t hstep = (size_t)HALF * K * 2;
    const size_t tstep = 2 * hstep;
    const unsigned ldsw = (unsigned)wid * 1024u;
    const int aoff = lds_byte(wr * 64 + fr, fq * 8), boff = lds_byte(wc * 32 + fr, fq * 8);
#define PG8_SA(b, h) (((b) * 2 + (h)) * HTB)
#define PG8_SB(b, h) ((4 + (b) * 2 + (h)) * HTB)
#define PG8_STAGE(bufoff, gbase, voff) do { _Pragma("unroll") for (int _i = 0; _i < 2; ++_i) \
        __builtin_amdgcn_global_load_lds((const unsigned*)((const char*)(gbase) + (voff)[_i]), (PG8_LAS unsigned*)(lds + (bufoff) + ldsw + _i * 8192), 16, 0, 0); } while (0)
#define PG8_LDA(dst, b, h) do { _Pragma("unroll") for (int m = 0; m < 4; ++m) _Pragma("unroll") for (int k = 0; k < 2; ++k) dst[m][k] = *(const PG8_LAS bf16x8*)(lds + PG8_SA(b, h) + aoff + m * 2048 + k * 1024); } while (0)
#define PG8_LDB(dst, b, h) do { _Pragma("unroll") for (int n = 0; n < 2; ++n) _Pragma("unroll") for (int k = 0; k < 2; ++k) dst[n][k] = *(const PG8_LAS bf16x8*)(lds + PG8_SB(b, h) + boff + n * 2048 + k * 1024); } while (0)
#define PG8_MMA(ai, bj, At, Bt) do { __builtin_amdgcn_s_setprio(1); _Pragma("unroll") for (int m = 0; m < 4; ++m) _Pragma("unroll") for (int n = 0; n < 2; ++n) _Pragma("unroll") for (int k = 0; k < 2; ++k) \
        acc[ai][bj][m][n] = __builtin_amdgcn_mfma_f32_16x16x32_bf16(Bt[n][k], At[m][k], acc[ai][bj][m][n], 0, 0, 0); __builtin_amdgcn_s_setprio(0); } while (0)
#define PG8_WAIT_V(n) asm volatile("s_waitcnt vmcnt(" #n ")" ::: "memory")
#define PG8_WAIT_L(n) asm volatile("s_waitcnt lgkmcnt(" #n ")" ::: "memory")
#define PG8_BAR __builtin_amdgcn_s_barrier()
#define PG8_SCHED __builtin_amdgcn_sched_barrier(0)
    Unit cur, nxt; int ui = 0;
    if (!S.next(0, cur)) return;
    f32x4 acc[2][2][4][2];
#pragma unroll
    for (int a = 0; a < 2; ++a)
#pragma unroll
        for (int b = 0; b < 2; ++b)
#pragma unroll
            for (int m = 0; m < 4; ++m)
#pragma unroll
                for (int n = 0; n < 2; ++n) acc[a][b][m][n] = (f32x4){0.f, 0.f, 0.f, 0.f};
    bf16x8 At[4][2], B0[2][2], B1[2][2];
    const char* cA = (const char*)g.A + (size_t)cur.pm * tstep; const char* cB = (const char*)g.Bt + (size_t)cur.pn * tstep;
    S.a_ready(cur);
    PG8_STAGE(PG8_SB(0, 0), cB, voffB); PG8_STAGE(PG8_SA(0, 0), cA, voffA); PG8_STAGE(PG8_SB(0, 1), cB + hstep, voffB); PG8_STAGE(PG8_SA(0, 1), cA + hstep, voffA);
    if (wr == 1) PG8_BAR;
    PG8_WAIT_V(4); PG8_BAR;
    PG8_STAGE(PG8_SB(1, 0), cB + kstep, voffB); PG8_STAGE(PG8_SA(1, 0), cA + kstep, voffA); PG8_STAGE(PG8_SB(1, 1), cB + hstep + kstep, voffB);
    PG8_WAIT_V(6); PG8_BAR;
    PG8_STAMP();
    for (;;) {
        const bool has_next = S.next(ui + 1, nxt);
        const char* nA = has_next ? (const char*)g.A + (size_t)nxt.pm * tstep : cA; const char* nB = has_next ? (const char*)g.Bt + (size_t)nxt.pn * tstep : cB;
        for (int t = 0; t < nt; t += 2) {
            const bool last = (t == nt - 2);
            const char* a1 = cA + (size_t)(t + 1) * kstep;
            const char* a2 = last ? nA : cA + (size_t)(t + 2) * kstep; const char* b2 = last ? nB : cB + (size_t)(t + 2) * kstep;
            const char* a3 = a2 + kstep; const char* b3 = b2 + kstep;
            if (last && has_next) S.a_ready(nxt);
            PG8_LDB(B0, 0, 0); PG8_SCHED; PG8_LDA(At, 0, 0); PG8_STAGE(PG8_SA(1, 1), a1 + hstep, voffA);
            PG8_WAIT_L(8); PG8_BAR; PG8_WAIT_L(0); PG8_MMA(0, 0, At, B0); PG8_BAR; PG8_SCHED;
            PG8_LDB(B1, 0, 1); PG8_STAGE(PG8_SB(0, 0), b2, voffB);
            PG8_BAR; PG8_WAIT_L(0); PG8_MMA(0, 1, At, B1); PG8_BAR;
            PG8_LDA(At, 0, 1); PG8_STAGE(PG8_SA(0, 0), a2, voffA);
            PG8_BAR; PG8_WAIT_L(0); PG8_MMA(1, 0, At, B0); PG8_BAR; PG8_SCHED;
            PG8_STAGE(PG8_SB(0, 1), b2 + hstep, voffB);
            PG8_WAIT_V(6); PG8_BAR; PG8_MMA(1, 1, At, B1); PG8_BAR;
            PG8_LDB(B0, 1, 0); PG8_SCHED; PG8_LDA(At, 1, 0); PG8_STAGE(PG8_SA(0, 1), a2 + hstep, voffA);
            PG8_WAIT_L(8); PG8_BAR; PG8_WAIT_L(0); PG8_MMA(0, 0, At, B0); PG8_BAR; PG8_SCHED;
            PG8_LDB(B1, 1, 1); PG8_STAGE(PG8_SB(1, 0), b3, voffB);
            PG8_BAR; PG8_WAIT_L(0); PG8_MMA(0, 1, At, B1); PG8_BAR;
            PG8_LDA(At, 1, 1); PG8_STAGE(PG8_SA(1, 0), a3, voffA);
            PG8_BAR; PG8_WAIT_L(0); PG8_MMA(1, 0, At, B0); PG8_BAR; PG8_SCHED;
            PG8_STAGE(PG8_SB(1, 1), b3 + hstep, voffB);
            PG8_WAIT_V(6); PG8_BAR; PG8_MMA(1, 1, At, B1); PG8_BAR;
        }
        PG8_STAMP();
        if constexpr (!Epi::AFTER_DRAIN) { E(acc, cur, wr, wc, fr, fq); S.done(cur); }
        PG8_STAMP();
        if (!has_next) break;
#pragma unroll
        for (int a = 0; a < 2; ++a)
#pragma unroll
            for (int b = 0; b < 2; ++b)
#pragma unroll
                for (int m = 0; m < 4; ++m)
#pragma unroll
                    for (int n = 0; n < 2; ++n) acc[a][b][m][n] = (f32x4){0.f, 0.f, 0.f, 0.f};
        cur = nxt; cA = nA; cB = nB; ++ui;
    }
    PG8_WAIT_V(0);
    if (wr == 0) PG8_BAR;
    PG8_BAR;
    if constexpr (Epi::AFTER_DRAIN) { E.fused(acc, cur, wr, wc, fr, fq, lds, wid, lane); S.done(cur); }
    PG8_STAMP();
    if (STAMP && wid == 0) { stamps[lane] = lane < nts ? (((unsigned long long)(unsigned)ts_hi << 32) | (unsigned)ts_lo) : 0ull;
        if (lane == 62) stamps[62] = rt_entry; if (lane == 63) stamps[63] = (unsigned long long)wall_clock64(); }
#undef PG8_STAMP
#undef PG8_SA
#undef PG8_SB
#undef PG8_STAGE
#undef PG8_LDA
#undef PG8_LDB
#undef PG8_MMA
#undef PG8_WAIT_V
#undef PG8_WAIT_L
#undef PG8_BAR
#undef PG8_SCHED
}
}
#include <cstdint>
#include <cstdlib>
#include <vector>

#define XB_TMO      128
#define XB_XCNT(j)  (256  + 64 * (j))
#define XB_XSUB(j)  (1280 + 64 * (j))
#define XB_XGEN(j)  (2304 + 64 * (j))
#define XB_TOP      3328
#define XB_TOPGEN   3392
#define XCD_BAR_WORDS 3456
#define XB_SPIN_CAP (1u << 18)
#define XLAS __attribute__((address_space(3)))

__device__ __forceinline__ unsigned xb_ld(unsigned* p)              { return __hip_atomic_load(p, __ATOMIC_RELAXED, __HIP_MEMORY_SCOPE_AGENT); }
__device__ __forceinline__ unsigned xb_add(unsigned* p, unsigned v) { return __hip_atomic_fetch_add(p, v, __ATOMIC_RELAXED, __HIP_MEMORY_SCOPE_AGENT); }
__device__ __forceinline__ unsigned xb_xcc_id() { return (unsigned)__builtin_amdgcn_s_getreg((3 << 11) | 20) & 0xFu; }
#define XB_SPIN(cond, bar) do { unsigned _sp = 0; while (cond) { __builtin_amdgcn_s_sleep(1); \
    if ((++_sp & 255u) == 0u) { if (xb_ld(&(bar)[XB_TMO])) break; if (_sp > XB_SPIN_CAP) { atomicAdd(&(bar)[XB_TMO], 1u); break; } } } } while (0)

struct XcdBarrier {
    unsigned* bar; unsigned x;
    volatile XLAS unsigned* st;
};

__device__ __forceinline__ XcdBarrier xcd_barrier_post(unsigned* bar, volatile XLAS unsigned* st) {
    XcdBarrier b; b.bar = bar; b.x = xb_xcc_id(); b.st = st;
    if (threadIdx.x == 0) (void)xb_add(&bar[XB_XCNT(b.x)], 1u);
    return b;
}
__device__ __forceinline__ void xcd_barrier_complete(unsigned* bar, unsigned x, unsigned& nloc, unsigned& nx) {
    const unsigned G = gridDim.x * gridDim.y * gridDim.z;
    unsigned sum, cnt, mine, sp = 0u;
    for (;;) {
        sum = 0u; cnt = 0u; mine = 0u;
#pragma unroll
        for (unsigned j = 0; j < 16; ++j) { const unsigned c = xb_ld(&bar[XB_XCNT(j)]); sum += c; cnt += (c > 0u) ? 1u : 0u; mine = (j == x) ? c : mine; }
        if (sum == G) break;
        __builtin_amdgcn_s_sleep(1);
        if ((++sp & 255u) == 0u) { if (xb_ld(&bar[XB_TMO])) break; if (sp > XB_SPIN_CAP) { atomicAdd(&bar[XB_TMO], 1u); break; } }
    }
    nloc = mine > 0u ? mine : 1u; nx = cnt > 0u ? cnt : 1u;
}

__device__ __forceinline__ void xcd_barrier(const XcdBarrier& b) {
    asm volatile("s_waitcnt vmcnt(0)" ::: "memory");
    __syncthreads();
    if (threadIdx.x == 0) {
        unsigned* bar = b.bar;
        __builtin_amdgcn_s_waitcnt(0);
        unsigned nloc = b.st[0], nx = b.st[1];
        if (nloc == 0u) { xcd_barrier_complete(bar, b.x, nloc, nx); b.st[0] = nloc; b.st[1] = nx; }
        const unsigned old = xb_add(&bar[XB_XSUB(b.x)], 1u);
        const unsigned gen = old / nloc;
        if (old + 1u == (gen + 1u) * nloc) {
            __builtin_amdgcn_fence(__ATOMIC_RELEASE, "agent");
            asm volatile("s_waitcnt vmcnt(0)" ::: "memory");
            const unsigned og = xb_add(&bar[XB_TOP], 1u);
            const unsigned tg = og / nx;
            if (og + 1u == (tg + 1u) * nx) xb_add(&bar[XB_TOPGEN], 1u);
            else XB_SPIN(xb_ld(&bar[XB_TOPGEN]) == tg, bar);
            __builtin_amdgcn_fence(__ATOMIC_ACQUIRE, "agent");
            xb_add(&bar[XB_XGEN(b.x)], 1u);
            asm volatile("s_waitcnt vmcnt(0)" ::: "memory");
        } else {
            XB_SPIN(xb_ld(&bar[XB_XGEN(b.x)]) == gen, bar);
            __builtin_amdgcn_fence(__ATOMIC_ACQUIRE, "agent");
            asm volatile("s_waitcnt vmcnt(0)" ::: "memory");
        }
    }
    __syncthreads();
}

#ifndef SKIP
#define SKIP 0
#endif
#define LAS PG8_LAS
typedef pg8::bf16_t bf16_t;
typedef pg8::bf16x8 bf16x8;
typedef pg8::f32x4 f32x4;
typedef pg8::u32x4 u32x4;
typedef unsigned u32x2 __attribute__((ext_vector_type(2)));
constexpr int NP = 16384, NS = 128, NR = NP + NS, MPAD = 16640, DM = 1024, DIN = 3080;
constexpr int LDS_BYTES = 131072 + 16;
constexpr size_t OYS = 16777216, OPP = 16908288, OCP = 17031168, OSP = 17104896, OPS = 18153472, OCS = 20119552, OSS = 21299200;
constexpr size_t WS_WTIN = 0;
constexpr size_t WS_WTOUT = WS_WTIN + 12582912;
constexpr size_t WS_WTPOOL = WS_WTOUT + 4194304;
constexpr size_t WS_MOD = WS_WTPOOL + 262144;
constexpr size_t WS_H = WS_MOD + 6291456;
constexpr size_t WS_P0 = WS_H + 34078720;
constexpr size_t WS_P1 = WS_P0 + 34078720;
constexpr size_t WS_P2 = WS_P1 + 34078720;
constexpr size_t WS_G = WS_P2 + 34078720;
constexpr size_t WS_BETA = WS_G + 264192;
constexpr size_t WS_GL = WS_BETA + 264192;
constexpr size_t WS_W = WS_GL + 4096;
constexpr size_t WS_QG = WS_W + 16777216;
constexpr size_t WS_KGT = WS_QG + 16777216;
constexpr size_t WS_QK = WS_KGT + 16777216;
constexpr size_t WS_U = WS_QK + 8388608;
constexpr size_t WS_WTADA = WS_U;
constexpr size_t WS_AC = WS_U + 12582912;
constexpr size_t WS_BAR = WS_U + 33554432;
constexpr size_t WS_END = WS_BAR + 16384;

struct Params {
    const float* x_prompt; const float* x_sample; const float* c_prompt; const float* c_sample;
    const float* state_pool; const float* state_conv; const float* state_ssm;
    const float* w_ada; const float* b_ada; const float* pre_norm_w; const float* post_norm_w; const float* w_in; const float* conv_w;
    const float* pool_w; const float* pool_scale; const float* a_log; const float* dt_bias; const float* o_norm_w; const float* w_out;
    float* out; unsigned char* ws; int ph_lo, ph_hi;
};

__device__ __forceinline__ float bf2f(unsigned short b) { return __uint_as_float(((unsigned)b) << 16); }
__device__ __forceinline__ unsigned pk2(float lo, float hi) { return pg8::cvt_pk_bf16(lo, hi); }
__device__ __forceinline__ unsigned short f2bf(float f) { return (unsigned short)(pk2(f, 0.f) & 0xffffu); }
__device__ __forceinline__ float silu_f(float x) { return __fdividef(x, 1.0f + __expf(-x)); }
__device__ __forceinline__ void unpack8(const u32x4 v, float* x) {
    x[0] = __uint_as_float(v.x << 16); x[1] = __uint_as_float(v.x & 0xffff0000u); x[2] = __uint_as_float(v.y << 16); x[3] = __uint_as_float(v.y & 0xffff0000u);
    x[4] = __uint_as_float(v.z << 16); x[5] = __uint_as_float(v.z & 0xffff0000u); x[6] = __uint_as_float(v.w << 16); x[7] = __uint_as_float(v.w & 0xffff0000u);
}
__device__ __forceinline__ u32x4 pack8(const float* x) { u32x4 w; w.x = pk2(x[0], x[1]); w.y = pk2(x[2], x[3]); w.z = pk2(x[4], x[5]); w.w = pk2(x[6], x[7]); return w; }
__device__ __forceinline__ float wave_sum(float v) {
#pragma unroll
    for (int o = 32; o >= 1; o >>= 1) v += __shfl_xor(v, o);
    return v;
}

__device__ __forceinline__ void transpose_tile(const float* __restrict__ src, int ld, bf16_t* __restrict__ dst, int ldd, int k0, int n0, LAS float* tile) {
    const int tid = opq_tid();
#pragma unroll
    for (int p = 0; p < 2; ++p) {
        const int kk = (tid >> 4) + 32 * p, n4 = (tid & 15) * 4;
        const float4 v = *(const float4*)(src + (size_t)(k0 + kk) * ld + n0 + n4);
        tile[kk * 65 + n4 + 0] = v.x; tile[kk * 65 + n4 + 1] = v.y; tile[kk * 65 + n4 + 2] = v.z; tile[kk * 65 + n4 + 3] = v.w;
    }
    __syncthreads();
    const int n = tid >> 3, k8 = (tid & 7) * 8;
    float x[8];
#pragma unroll
    for (int i = 0; i < 8; ++i) x[i] = tile[(k8 + i) * 65 + n];
    *(u32x4*)(dst + (size_t)(n0 + n) * ldd + k0 + k8) = pack8(x);
    __syncthreads();
}

__device__ __forceinline__ void phase_convert(const Params& p, LAS unsigned char* lds) {
    LAS float* tile = (LAS float*)lds;
    bf16_t* WtIn = (bf16_t*)(p.ws + WS_WTIN); bf16_t* WtAda = (bf16_t*)(p.ws + WS_WTADA); bf16_t* WtOut = (bf16_t*)(p.ws + WS_WTOUT); bf16_t* WtPool = (bf16_t*)(p.ws + WS_WTPOOL);
    for (int t = blockIdx.x; t < 3616; t += gridDim.x) {
        if (t < 1536) { const int l = t / 768, rem = t % 768; transpose_tile(p.w_in + (size_t)l * 1024 * DIN, DIN, WtIn + (size_t)l * 3072 * 1024, 1024, (rem / 48) * 64, (rem % 48) * 64, tile); }
        else if (t < 3072) { const int tt = t - 1536, l = tt / 768, rem = tt % 768; transpose_tile(p.w_ada + (size_t)l * 1024 * 3072, 3072, WtAda + (size_t)l * 3072 * 1024, 1024, (rem / 48) * 64, (rem % 48) * 64, tile); }
        else if (t < 3584) { const int tt = t - 3072, l = tt / 256, rem = tt % 256; transpose_tile(p.w_out + (size_t)l * 1024 * 1024, 1024, WtOut + (size_t)l * 1024 * 1024, 1024, (rem / 16) * 64, (rem % 16) * 64, tile); }
        else { const int tt = t - 3584, lg = tt / 4, rem = tt % 4; transpose_tile(p.pool_w + (size_t)lg * 16384, 128, WtPool + (size_t)lg * 16384, 128, (rem / 2) * 64, (rem % 2) * 64, tile); }
    }
    bf16_t* Ac = (bf16_t*)(p.ws + WS_AC);
    for (int i = blockIdx.x * 512 + opq_tid(); i < 65536; i += gridDim.x * 512) {
        const int row = i >> 8, c4 = (i & 255) * 4;
        float4 v = make_float4(0.f, 0.f, 0.f, 0.f);
        if (row < 8) v = *(const float4*)(p.c_prompt + row * 1024 + c4); else if (row < 136) v = *(const float4*)(p.c_sample + (row - 8) * 1024 + c4);
        uint2 w; w.x = pk2(silu_f(v.x), silu_f(v.y)); w.y = pk2(silu_f(v.z), silu_f(v.w));
        *(uint2*)(Ac + row * 1024 + c4) = w;
    }
}

__device__ __forceinline__ void phase_rows(const Params& p, int lF, int lA, LAS unsigned char* lds) {
    const int tid = opq_tid(), wid = tid >> 6, lane = tid & 63;
    LAS float* W8t = (LAS float*)lds;
    const float* mod = (const float*)(p.ws + WS_MOD);
    const float* Y = (const float*)(p.ws + WS_P0);
    bf16_t* H = (bf16_t*)(p.ws + WS_H);
    float* Gd = (float*)(p.ws + WS_G); float* Bd = (float*)(p.ws + WS_BETA);
    if (lA >= 0) {
        for (int i = tid; i < 8192; i += 512) { const int k = i >> 3, j = i & 7; W8t[j * 1024 + k] = p.w_in[(size_t)lA * 1024 * DIN + (size_t)k * DIN + 3072 + j]; }
        __syncthreads();
    }
    for (int row = blockIdx.x * 8 + wid; row < NR; row += gridDim.x * 8) {
        const int mrow = row < NP ? (row >> 11) : (8 + row - NP);
        const float* xorig = row < NP ? p.x_prompt + (size_t)row * 1024 : p.x_sample + (size_t)(row - NP) * 1024;
        float* xout = p.out + (size_t)row * 1024;
        float4 xv[4];
        if (lF >= 0) {
            const float* yrow = Y + (size_t)row * 1024; const float* mF = mod + (size_t)mrow * 6144 + lF * 3072 + 2048;
            const float* xsrc = (lF == 0) ? xorig : xout;
            float4 yv[4]; float ss = 0.f;
#pragma unroll
            for (int i = 0; i < 4; ++i) { yv[i] = *(const float4*)(yrow + lane * 4 + 256 * i); ss += yv[i].x * yv[i].x + yv[i].y * yv[i].y + yv[i].z * yv[i].z + yv[i].w * yv[i].w; }
            ss = wave_sum(ss);
            const float rstd = rsqrtf(ss * (1.0f / 1024.0f) + 1e-6f);
#pragma unroll
            for (int i = 0; i < 4; ++i) {
                const int c = lane * 4 + 256 * i;
                const float4 gt = *(const float4*)(mF + c), pw = *(const float4*)(p.post_norm_w + lF * 1024 + c), xi = *(const float4*)(xsrc + c);
                xv[i].x = xi.x + gt.x * (yv[i].x * rstd * pw.x); xv[i].y = xi.y + gt.y * (yv[i].y * rstd * pw.y);
                xv[i].z = xi.z + gt.z * (yv[i].z * rstd * pw.z); xv[i].w = xi.w + gt.w * (yv[i].w * rstd * pw.w);
                *(float4*)(xout + c) = xv[i];
            }
        } else {
#pragma unroll
            for (int i = 0; i < 4; ++i) xv[i] = *(const float4*)(xorig + lane * 4 + 256 * i);
        }
        if (lA >= 0) {
            float ss = 0.f;
#pragma unroll
            for (int i = 0; i < 4; ++i) ss += xv[i].x * xv[i].x + xv[i].y * xv[i].y + xv[i].z * xv[i].z + xv[i].w * xv[i].w;
            ss = wave_sum(ss);
            const float rstd = rsqrtf(ss * (1.0f / 1024.0f) + 1e-6f);
            const float* mA = mod + (size_t)mrow * 6144 + lA * 3072;
            float d[8];
#pragma unroll
            for (int j = 0; j < 8; ++j) d[j] = 0.f;
#pragma unroll
            for (int i = 0; i < 4; ++i) {
                const int c = lane * 4 + 256 * i;
                const float4 sh = *(const float4*)(mA + c), sc = *(const float4*)(mA + 1024 + c), pw = *(const float4*)(p.pre_norm_w + lA * 1024 + c);
                float4 hv;
                hv.x = xv[i].x * rstd * pw.x * (1.0f + sc.x) + sh.x; hv.y = xv[i].y * rstd * pw.y * (1.0f + sc.y) + sh.y;
                hv.z = xv[i].z * rstd * pw.z * (1.0f + sc.z) + sh.z; hv.w = xv[i].w * rstd * pw.w * (1.0f + sc.w) + sh.w;
                uint2 w; w.x = pk2(hv.x, hv.y); w.y = pk2(hv.z, hv.w);
                *(uint2*)(H + (size_t)row * 1024 + c) = w;
#pragma unroll
                for (int j = 0; j < 8; ++j) { const f32x4 wv = *(const LAS f32x4*)(W8t + j * 1024 + c); d[j] += hv.x * wv[0] + hv.y * wv[1] + hv.z * wv[2] + hv.w * wv[3]; }
            }
#pragma unroll
            for (int j = 0; j < 8; ++j) d[j] = wave_sum(d[j]);
            if (lane < 4) {
                const float br = lane == 0 ? d[0] : lane == 1 ? d[1] : lane == 2 ? d[2] : d[3];
                const float ar = lane == 0 ? d[4] : lane == 1 ? d[5] : lane == 2 ? d[6] : d[7];
                const float xs = ar + p.dt_bias[lA * 4 + lane];
                const float sp = fmaxf(xs, 0.f) + log1pf(__expf(-fabsf(xs)));
                Bd[row * 4 + lane] = 1.0f / (1.0f + __expf(-br));
                Gd[row * 4 + lane] = -__expf(p.a_log[lA * 4 + lane]) * sp;
            }
        }
    }
}

__device__ __forceinline__ void conv16(const u32x4 (&xr)[4][2], int tok, const float* __restrict__ cw, float* out, float* xcur) {
    float acc[16];
#pragma unroll
    for (int i = 0; i < 16; ++i) acc[i] = 0.f;
#pragma unroll
    for (int j = 0; j < 4; ++j) {
        const bool valid = (tok - 3 + j) >= 0;
        float x[16]; unpack8(xr[j][0], x); unpack8(xr[j][1], x + 8);
#pragma unroll
        for (int q = 0; q < 4; ++q) {
            const float4 w = *(const float4*)(cw + j * 1536 + 4 * q);
            const float x0 = valid ? x[4 * q] : 0.f, x1 = valid ? x[4 * q + 1] : 0.f, x2 = valid ? x[4 * q + 2] : 0.f, x3 = valid ? x[4 * q + 3] : 0.f;
            acc[4 * q] += x0 * w.x; acc[4 * q + 1] += x1 * w.y; acc[4 * q + 2] += x2 * w.z; acc[4 * q + 3] += x3 * w.w;
        }
        if (j == 3) {
#pragma unroll
            for (int i = 0; i < 16; ++i) xcur[i] = x[i];
        }
    }
#pragma unroll
    for (int i = 0; i < 16; ++i) out[i] = silu_f(acc[i]);
}

__device__ __forceinline__ void chunk_item(const Params& p, int l, int idx, LAS unsigned char* lds) {
    const int tid = opq_tid(), wid = tid >> 6, lane = tid & 63;
    const int b = idx >> 7, h = (idx >> 5) & 3, n = idx & 31, R0 = b * 2048 + n * 64;
    LAS bf16_t* KB = (LAS bf16_t*)lds; LAS bf16_t* QB = (LAS bf16_t*)(lds + 17408);
    LAS float* AT = (LAS float*)(lds + 34816); LAS float* RHS = (LAS float*)(lds + 51200);
    LAS float* GC = (LAS float*)(lds + 116736); LAS float* BT = GC + 64; LAS float* EG = GC + 128;
    const float* Gd = (const float*)(p.ws + WS_G); const float* Bd = (const float*)(p.ws + WS_BETA);
    const bf16_t* P1 = (const bf16_t*)(p.ws + WS_P1); const bf16_t* P2 = (const bf16_t*)(p.ws + WS_P2);
    bf16_t* Wd = (bf16_t*)(p.ws + WS_W) + (size_t)idx * 8192; bf16_t* QGd = (bf16_t*)(p.ws + WS_QG) + (size_t)idx * 8192;
    bf16_t* KGTd = (bf16_t*)(p.ws + WS_KGT) + (size_t)idx * 8192; bf16_t* QKd = (bf16_t*)(p.ws + WS_QK) + (size_t)idx * 4096;
    float* Ud = (float*)(p.ws + WS_U) + (size_t)idx * 8192; float* GLd = (float*)(p.ws + WS_GL);
    const int et = tid >> 3, ec0 = (tid & 7) * 16, etok = n * 64 + et;
    u32x4 xr[3][4][2];
#pragma unroll
    for (int a = 0; a < 3; ++a) {
        const bf16_t* base = (a == 0 ? P1 + h * 128 : a == 1 ? P1 + 512 + h * 128 : P2 + h * 128) + ec0;
#pragma unroll
        for (int j = 0; j < 4; ++j) {
            const int tj = etok - 3 + j, tjc = tj < 0 ? 0 : tj;
            const bf16_t* ptr = base + (size_t)(b * 2048 + tjc) * 1024;
            xr[a][j][0] = *(const u32x4*)ptr; xr[a][j][1] = *(const u32x4*)(ptr + 8);
        }
    }
    if (tid < 64) {
        float v = Gd[(R0 + tid) * 4 + h];
#pragma unroll
        for (int o = 1; o < 64; o <<= 1) { const float t = __shfl_up(v, o); if (lane >= o) v += t; }
        GC[tid] = v; BT[tid] = Bd[(R0 + tid) * 4 + h]; const float e = __expf(v); EG[tid] = e;
        if (tid == 63) GLd[idx] = e;
    }
    __syncthreads();
    {
        const int t = et, c0 = ec0, tok = etok;
        const float bt = BT[t], eg = EG[t];
        const float* cwl = p.conv_w + (size_t)l * 4 * 1536;
        float s[16], xc[16];
        conv16(xr[0], tok, cwl + h * 128 + c0, s, xc);
        if (n == 31 && t >= 61) { float* o = p.out + OCP + ((size_t)(l * 8 + b) * 3 + (t - 61)) * 1536 + h * 128 + c0;
#pragma unroll
            for (int i = 0; i < 16; ++i) o[i] = xc[i]; }
        float ss = 0.f;
#pragma unroll
        for (int i = 0; i < 16; ++i) ss += s[i] * s[i];
        ss += __shfl_xor(ss, 1); ss += __shfl_xor(ss, 2); ss += __shfl_xor(ss, 4);
        float rs = rsqrtf(ss + 1e-6f) * 0.08838834764831845f;
        float qn[16];
#pragma unroll
        for (int i = 0; i < 16; ++i) qn[i] = s[i] * rs;
        *(LAS u32x4*)(QB + t * 136 + c0) = pack8(qn); *(LAS u32x4*)(QB + t * 136 + c0 + 8) = pack8(qn + 8);
#pragma unroll
        for (int i = 0; i < 16; ++i) qn[i] *= eg;
        *(u32x4*)(QGd + t * 128 + c0) = pack8(qn); *(u32x4*)(QGd + t * 128 + c0 + 8) = pack8(qn + 8);
        conv16(xr[1], tok, cwl + 512 + h * 128 + c0, s, xc);
        if (n == 31 && t >= 61) { float* o = p.out + OCP + ((size_t)(l * 8 + b) * 3 + (t - 61)) * 1536 + 512 + h * 128 + c0;
#pragma unroll
            for (int i = 0; i < 16; ++i) o[i] = xc[i]; }
        ss = 0.f;
#pragma unroll
        for (int i = 0; i < 16; ++i) ss += s[i] * s[i];
        ss += __shfl_xor(ss, 1); ss += __shfl_xor(ss, 2); ss += __shfl_xor(ss, 4);
        rs = rsqrtf(ss + 1e-6f);
#pragma unroll
        for (int i = 0; i < 16; ++i) s[i] *= rs;
        *(LAS u32x4*)(KB + t * 136 + c0) = pack8(s); *(LAS u32x4*)(KB + t * 136 + c0 + 8) = pack8(s + 8);
        const float be = bt * eg;
#pragma unroll
        for (int i = 0; i < 16; i += 4) *(LAS f32x4*)(RHS + t * 256 + 128 + c0 + i) = (f32x4){s[i] * be, s[i + 1] * be, s[i + 2] * be, s[i + 3] * be};
        conv16(xr[2], tok, cwl + 1024 + h * 128 + c0, s, xc);
        if (n == 31 && t >= 61) { float* o = p.out + OCP + ((size_t)(l * 8 + b) * 3 + (t - 61)) * 1536 + 1024 + h * 128 + c0;
#pragma unroll
            for (int i = 0; i < 16; ++i) o[i] = xc[i]; }
#pragma unroll
        for (int i = 0; i < 16; i += 4) *(LAS f32x4*)(RHS + t * 256 + c0 + i) = (f32x4){s[i] * bt, s[i + 1] * bt, s[i + 2] * bt, s[i + 3] * bt};
    }
    __syncthreads();
    {
        const int lr = lane & 15, lq = lane >> 4;
#pragma unroll 1
        for (int jj = 0; jj < 4; ++jj) {
            const int job = wid * 4 + jj, which = job >> 4, tile = job & 15, mi = tile >> 2, nj = tile & 3;
            LAS bf16_t* As = which ? QB : KB;
            f32x4 acc = {0.f, 0.f, 0.f, 0.f};
#pragma unroll
            for (int s = 0; s < 4; ++s) {
                const bf16x8 a = *(const LAS bf16x8*)(As + (16 * mi + lr) * 136 + 32 * s + 8 * lq);
                const bf16x8 bb = *(const LAS bf16x8*)(KB + (16 * nj + lr) * 136 + 32 * s + 8 * lq);
                acc = __builtin_amdgcn_mfma_f32_16x16x32_bf16(a, bb, acc, 0, 0, 0);
            }
            const int j = 16 * nj + lr, i0 = 16 * mi + 4 * lq;
            const float gj = GC[j];
            if (!which) {
                f32x4 o;
#pragma unroll
                for (int r = 0; r < 4; ++r) { const int i = i0 + r; o[r] = (i > j) ? BT[i] * acc[r] * __expf(GC[i] - gj) : 0.f; }
                *(LAS f32x4*)(AT + j * 64 + i0) = o;
            } else {
#pragma unroll
                for (int r = 0; r < 4; ++r) { const int i = i0 + r; const float v = (i >= j) ? acc[r] * __expf(GC[i] - gj) : 0.f; QKd[i * 64 + j] = f2bf(v); }
            }
        }
    }
    __syncthreads();
    if (tid < 256) {
        const int c = tid;
        float r[64];
#pragma unroll
        for (int i = 0; i < 64; ++i) r[i] = RHS[i * 256 + c];
#pragma unroll
        for (int j = 0; j < 63; ++j) {
            const float xj = r[j];
#pragma unroll
            for (int i4 = ((j + 1) & ~3); i4 < 64; i4 += 4) {
                const f32x4 a = *(const LAS f32x4*)(AT + j * 64 + i4);
                r[i4 + 0] -= a[0] * xj; r[i4 + 1] -= a[1] * xj; r[i4 + 2] -= a[2] * xj; r[i4 + 3] -= a[3] * xj;
            }
        }
        if (c < 128) {
#pragma unroll
            for (int i = 0; i < 64; ++i) Ud[i * 128 + c] = r[i];
        } else {
#pragma unroll
            for (int i = 0; i < 64; ++i) Wd[i * 128 + (c - 128)] = f2bf(r[i]);
        }
    } else {
        const int d = (tid - 256) >> 1, th = tid & 1;
        const float gcl = GC[63];
        float x[32];
#pragma unroll
        for (int i = 0; i < 32; ++i) { const int t = 32 * th + i; x[i] = bf2f(KB[t * 136 + d]) * __expf(gcl - GC[t]); }
#pragma unroll
        for (int q = 0; q < 4; ++q) *(u32x4*)(KGTd + d * 64 + 32 * th + 8 * q) = pack8(x + 8 * q);
    }
    __syncthreads();
}

__device__ __forceinline__ void pool_item(const Params& p, int l, int pidx, LAS unsigned char* lds) {
    const int tid = opq_tid(), wid = tid >> 6, lane = tid & 63;
    const int g = pidx & 3, T = pidx >> 2, w = 2 << g;
    const int rowbase = T * 128, b = rowbase >> 11, t0 = rowbase & 2047;
    LAS bf16_t* UT = (LAS bf16_t*)lds; LAS bf16_t* PB = (LAS bf16_t*)(lds + 38912); LAS bf16_t* WB = (LAS bf16_t*)(lds + 73728);
    const bf16_t* P0 = (const bf16_t*)(p.ws + WS_P0);
    const bf16_t* WtPool = (const bf16_t*)(p.ws + WS_WTPOOL) + (size_t)(l * 4 + g) * 16384;
    bf16_t* YM = (bf16_t*)(p.ws + WS_H);
#pragma unroll
    for (int q = 0; q < 4; ++q) { const int piece = tid + 512 * q, d = piece >> 4, k8 = (piece & 15) * 8; *(LAS u32x4*)(WB + d * 136 + k8) = *(const u32x4*)(WtPool + d * 128 + k8); }
#pragma unroll
    for (int q = 0; q < 5; ++q) {
        const int piece = tid + 512 * q;
        if (piece < 143 * 16) {
            const int rr = piece >> 4, c8 = (piece & 15) * 8, tok = t0 - 15 + rr;
            u32x4 v = *(const u32x4*)(P0 + (size_t)(b * 2048 + (tok < 0 ? 0 : tok)) * 1024 + g * 128 + c8);
            if (tok < 0) v = (u32x4){0u, 0u, 0u, 0u};
            *(LAS u32x4*)(UT + rr * 136 + c8) = v;
        }
    }
    __syncthreads();
    {
        const int c = tid & 127, q = tid >> 7, i0 = 32 * q;
        float s = 0.f;
        for (int j = 1; j < w; ++j) s += bf2f(UT[(i0 + 15 - j) * 136 + c]);
#pragma unroll 4
        for (int i = i0; i < i0 + 32; ++i) {
            const float cur = bf2f(UT[(i + 15) * 136 + c]);
            s += cur;
            const int tk = t0 + i + 1; const float cnt = (float)(tk < w ? tk : w);
            PB[i * 136 + c] = f2bf(__fdividef(s, cnt) - cur);
            s -= bf2f(UT[(i + 15 - (w - 1)) * 136 + c]);
            if (t0 == 1920 && i >= 113) p.out[OPP + ((size_t)(l * 8 + b) * 15 + (i - 113)) * 512 + g * 128 + c] = cur;
        }
    }
    __syncthreads();
    {
        const int lr = lane & 15, lq = lane >> 4;
        bf16x8 a[4];
#pragma unroll
        for (int s = 0; s < 4; ++s) a[s] = *(const LAS bf16x8*)(PB + (16 * wid + lr) * 136 + 32 * s + 8 * lq);
        const size_t prow = (size_t)(rowbase + 16 * wid + lr);
        u32x2 zr[8];
#pragma unroll
        for (int nt = 0; nt < 8; ++nt) zr[nt] = *(const u32x2*)(P0 + prow * 1024 + 512 + g * 128 + 16 * nt + 4 * lq);
#pragma unroll
        for (int nt = 0; nt < 8; ++nt) {
            f32x4 acc = {0.f, 0.f, 0.f, 0.f};
#pragma unroll
            for (int s = 0; s < 4; ++s) { const bf16x8 bb = *(const LAS bf16x8*)(WB + (16 * nt + lr) * 136 + 32 * s + 8 * lq); acc = __builtin_amdgcn_mfma_f32_16x16x32_bf16(bb, a[s], acc, 0, 0, 0); }
            const int d = g * 128 + 16 * nt + 4 * lq;
            const float4 ps = *(const float4*)(p.pool_scale + l * 512 + d);
            const float z0 = __uint_as_float(zr[nt].x << 16), z1 = __uint_as_float(zr[nt].x & 0xffff0000u), z2 = __uint_as_float(zr[nt].y << 16), z3 = __uint_as_float(zr[nt].y & 0xffff0000u);
            u32x2 w2; w2.x = pk2(acc[0] * ps.x * silu_f(z0), acc[1] * ps.y * silu_f(z1)); w2.y = pk2(acc[2] * ps.z * silu_f(z2), acc[3] * ps.w * silu_f(z3));
            *(u32x2*)(YM + prow * 1024 + d) = w2;
        }
    }
    __syncthreads();
}

__device__ __forceinline__ void sample_pool_item(const Params& p, int l, int sidx, LAS unsigned char* lds) {
    const int tid = opq_tid(), wid = tid >> 6, lane = tid & 63;
    const int g = sidx & 3, tq = sidx >> 2, w = 2 << g;
    LAS bf16_t* PB = (LAS bf16_t*)(lds + 38912); LAS bf16_t* WB = (LAS bf16_t*)(lds + 73728);
    const bf16_t* P0 = (const bf16_t*)(p.ws + WS_P0);
    const bf16_t* WtPool = (const bf16_t*)(p.ws + WS_WTPOOL) + (size_t)(l * 4 + g) * 16384;
    bf16_t* YM = (bf16_t*)(p.ws + WS_H);
#pragma unroll
    for (int q = 0; q < 4; ++q) { const int piece = tid + 512 * q, d = piece >> 4, k8 = (piece & 15) * 8; *(LAS u32x4*)(WB + d * 136 + k8) = *(const u32x4*)(WtPool + d * 128 + k8); }
    {
        const int c = tid & 127, q = tid >> 7;
#pragma unroll 2
        for (int ii = 0; ii < 8; ++ii) {
            const int il = 8 * q + ii, i = 32 * tq + il;
            const float cur = bf2f(P0[(size_t)(NP + i) * 1024 + g * 128 + c]);
            const float* sp = p.state_pool + ((size_t)(l * 128 + i) * 15) * 512 + g * 128 + c;
            float* op = p.out + OPS + ((size_t)(l * 128 + i) * 15) * 512 + g * 128 + c;
            float v[15];
#pragma unroll
            for (int j = 0; j < 15; ++j) v[j] = sp[(size_t)j * 512];
            float s = cur;
#pragma unroll
            for (int j = 0; j < 15; ++j) { if (14 - j <= w - 2) s += v[j]; if (j >= 1) op[(size_t)(j - 1) * 512] = v[j]; }
            op[(size_t)14 * 512] = cur;
            PB[il * 136 + c] = f2bf(__fdividef(s, (float)w) - cur);
        }
    }
    __syncthreads();
    if (wid < 2) {
        const int lr = lane & 15, lq = lane >> 4;
        bf16x8 a[4];
#pragma unroll
        for (int s = 0; s < 4; ++s) a[s] = *(const LAS bf16x8*)(PB + (16 * wid + lr) * 136 + 32 * s + 8 * lq);
        const size_t prow = (size_t)(NP + 32 * tq + 16 * wid + lr);
        u32x2 zr[8];
#pragma unroll
        for (int nt = 0; nt < 8; ++nt) zr[nt] = *(const u32x2*)(P0 + prow * 1024 + 512 + g * 128 + 16 * nt + 4 * lq);
#pragma unroll
        for (int nt = 0; nt < 8; ++nt) {
            f32x4 acc = {0.f, 0.f, 0.f, 0.f};
#pragma unroll
            for (int s = 0; s < 4; ++s) { const bf16x8 bb = *(const LAS bf16x8*)(WB + (16 * nt + lr) * 136 + 32 * s + 8 * lq); acc = __builtin_amdgcn_mfma_f32_16x16x32_bf16(bb, a[s], acc, 0, 0, 0); }
            const int d = g * 128 + 16 * nt + 4 * lq;
            const float4 ps = *(const float4*)(p.pool_scale + l * 512 + d);
            const float z0 = __uint_as_float(zr[nt].x << 16), z1 = __uint_as_float(zr[nt].x & 0xffff0000u), z2 = __uint_as_float(zr[nt].y << 16), z3 = __uint_as_float(zr[nt].y & 0xffff0000u);
            u32x2 w2; w2.x = pk2(acc[0] * ps.x * silu_f(z0), acc[1] * ps.y * silu_f(z1)); w2.y = pk2(acc[2] * ps.z * silu_f(z2), acc[3] * ps.w * silu_f(z3));
            *(u32x2*)(YM + prow * 1024 + d) = w2;
        }
    }
    __syncthreads();
}

__device__ __forceinline__ void sample_item(const Params& p, int l, int b, LAS unsigned char* lds) {
    const int tid = opq_tid(), wid = tid >> 6, lane = tid & 63;
    const int hd = tid >> 7, e = tid & 127;
    const size_t r = (size_t)(NP + b);
    LAS float* SQ = (LAS float*)lds; LAS float* SK = SQ + 512; LAS float* SV = SQ + 1024; LAS float* SO = SQ + 1536;
    LAS float* RED = SQ + 2048; LAS float* RED2 = SQ + 2560; LAS float* RW = SQ + 3072;
    const bf16_t* P1 = (const bf16_t*)(p.ws + WS_P1); const bf16_t* P2 = (const bf16_t*)(p.ws + WS_P2);
    const float* Gd = (const float*)(p.ws + WS_G); const float* Bd = (const float*)(p.ws + WS_BETA);
    bf16_t* YM = (bf16_t*)(p.ws + WS_H);
    const float* sc = p.state_conv + (size_t)(l * 128 + b) * 3 * 1536; const float* cw = p.conv_w + (size_t)l * 4 * 1536;
    float* oc = p.out + OCS + (size_t)(l * 128 + b) * 3 * 1536;
    const int part = hd;
    float sreg[32];
    {
        const float* Sin0 = p.state_ssm + ((size_t)((l * 128 + b) * 4 + 0) * 128) * 128;
#pragma unroll
        for (int dd = 0; dd < 32; ++dd) sreg[dd] = Sin0[(part * 32 + dd) * 128 + e];
    }
    float xin[3], cv[3];
    xin[0] = bf2f(P1[r * 1024 + tid]); xin[1] = bf2f(P1[r * 1024 + 512 + tid]); xin[2] = bf2f(P2[r * 1024 + tid]);
#pragma unroll
    for (int k = 0; k < 3; ++k) {
        const int ch = tid + 512 * k;
        const float b0 = sc[ch], b1 = sc[1536 + ch], b2 = sc[3072 + ch];
        cv[k] = silu_f(b0 * cw[ch] + b1 * cw[1536 + ch] + b2 * cw[3072 + ch] + xin[k] * cw[4608 + ch]);
        oc[ch] = b1; oc[1536 + ch] = b2; oc[3072 + ch] = xin[k];
    }
    const float sq = wave_sum(cv[0] * cv[0]), sk = wave_sum(cv[1] * cv[1]);
    if (lane == 0) { RW[wid] = sq; RW[8 + wid] = sk; }
    __syncthreads();
    {
        const float ssq = RW[2 * hd] + RW[2 * hd + 1], ssk = RW[8 + 2 * hd] + RW[8 + 2 * hd + 1];
        SQ[tid] = cv[0] * rsqrtf(ssq + 1e-6f) * 0.08838834764831845f; SK[tid] = cv[1] * rsqrtf(ssk + 1e-6f); SV[tid] = cv[2];
    }
    __syncthreads();
#pragma unroll 1
    for (int hh = 0; hh < 4; ++hh) {
        const float eg = __expf(Gd[r * 4 + hh]), bt = Bd[r * 4 + hh];
        float* Sout = p.out + OSS + ((size_t)((l * 128 + b) * 4 + hh) * 128) * 128;
        float kvp = 0.f;
#pragma unroll
        for (int dd = 0; dd < 32; ++dd) { sreg[dd] *= eg; kvp += SK[hh * 128 + part * 32 + dd] * sreg[dd]; }
        RED[part * 128 + e] = kvp;
        __syncthreads();
        const float kv = RED[e] + RED[128 + e] + RED[256 + e] + RED[384 + e];
        const float delta = (SV[hh * 128 + e] - kv) * bt;
        float op = 0.f;
#pragma unroll
        for (int dd = 0; dd < 32; ++dd) { const int d = part * 32 + dd; const float sv = sreg[dd] + SK[hh * 128 + d] * delta; Sout[d * 128 + e] = sv; op += SQ[hh * 128 + d] * sv; }
        if (hh < 3) {
            const float* Sin = p.state_ssm + ((size_t)((l * 128 + b) * 4 + hh + 1) * 128) * 128;
#pragma unroll
            for (int dd = 0; dd < 32; ++dd) sreg[dd] = Sin[(part * 32 + dd) * 128 + e];
        }
        RED2[part * 128 + e] = op;
        __syncthreads();
        if (part == 0) SO[hh * 128 + e] = RED2[e] + RED2[128 + e] + RED2[256 + e] + RED2[384 + e];
    }
    __syncthreads();
    const float o = SO[tid];
    const float so = wave_sum(o * o);
    if (lane == 0) RW[16 + wid] = so;
    __syncthreads();
    {
        const float rstd = rsqrtf((RW[16 + 2 * hd] + RW[16 + 2 * hd + 1]) * (1.0f / 128.0f) + 1e-6f);
        const float zb = bf2f(P2[r * 1024 + 512 + tid]);
        YM[r * 1024 + 512 + tid] = f2bf(o * rstd * p.o_norm_w[l * 128 + e] * silu_f(zb));
    }
    __syncthreads();
}

__device__ __forceinline__ void phase_post(const Params& p, int l, LAS unsigned char* lds) {
    for (int idx = blockIdx.x; idx < 1024 + 512 + 128 + 16; idx += gridDim.x) {
        if (idx < 1024) chunk_item(p, l, idx, lds);
        else if (idx < 1536) pool_item(p, l, idx - 1024, lds);
        else if (idx < 1664) sample_item(p, l, idx - 1536, lds);
        else sample_pool_item(p, l, idx - 1664, lds);
    }
}

struct ScanOps { bf16x8 wA[4], qA[4], qkA[2], kgA[2]; float u[4]; float gl; };
__device__ __forceinline__ void scan_load(ScanOps& o, const Params& p, int ci, int m, int n, int wid, int lr, int lq, int slice) {
    const bf16_t* Wd = (const bf16_t*)(p.ws + WS_W) + (size_t)ci * 8192; const bf16_t* QGd = (const bf16_t*)(p.ws + WS_QG) + (size_t)ci * 8192;
    const bf16_t* KGTd = (const bf16_t*)(p.ws + WS_KGT) + (size_t)ci * 8192; const bf16_t* QKd = (const bf16_t*)(p.ws + WS_QK) + (size_t)ci * 4096;
    const float* Ud = (const float*)(p.ws + WS_U) + (size_t)ci * 8192;
#pragma unroll
    for (int s = 0; s < 4; ++s) { o.wA[s] = *(const bf16x8*)(Wd + (16 * m + lr) * 128 + 32 * s + 8 * lq); o.qA[s] = *(const bf16x8*)(QGd + (16 * m + lr) * 128 + 32 * s + 8 * lq); }
#pragma unroll
    for (int s = 0; s < 2; ++s) { o.qkA[s] = *(const bf16x8*)(QKd + (16 * m + lr) * 64 + 32 * s + 8 * lq); o.kgA[s] = *(const bf16x8*)(KGTd + (16 * wid + lr) * 64 + 32 * s + 8 * lq); }
#pragma unroll
    for (int r = 0; r < 4; ++r) o.u[r] = Ud[(16 * m + 4 * lq + r) * 128 + 32 * slice + 16 * n + lr];
    o.gl = ((const float*)(p.ws + WS_GL))[ci];
}

__device__ __forceinline__ void scan_item(const Params& p, int l, int bh, int slice, LAS unsigned char* lds) {
    const int tid = opq_tid(), wid = tid >> 6, lane = tid & 63, lr = lane & 15, lq = lane >> 4, m = wid & 3, n = wid >> 2;
    const int b = bh >> 2, h = bh & 3;
    LAS bf16_t* ST = (LAS bf16_t*)lds;
    LAS bf16_t* VT = (LAS bf16_t*)(lds + 8704);
    float* Od = (float*)(p.ws + WS_P0);
    for (int i = tid; i < 32 * 136 / 2; i += 512) ((LAS unsigned*)ST)[i] = 0u;
    f32x4 Sacc[2] = {{0.f, 0.f, 0.f, 0.f}, {0.f, 0.f, 0.f, 0.f}};
    ScanOps cur; scan_load(cur, p, bh * 32, m, n, wid, lr, lq, slice);
    __syncthreads();
#pragma unroll 1
    for (int nc = 0; nc < 32; ++nc) {
        ScanOps nxt; scan_load(nxt, p, bh * 32 + (nc < 31 ? nc + 1 : nc), m, n, wid, lr, lq, slice);
        f32x4 P = {0.f, 0.f, 0.f, 0.f}, Q = {0.f, 0.f, 0.f, 0.f};
#pragma unroll
        for (int s = 0; s < 4; ++s) {
            const bf16x8 sb = *(const LAS bf16x8*)(ST + (16 * n + lr) * 136 + 32 * s + 8 * lq);
            P = __builtin_amdgcn_mfma_f32_16x16x32_bf16(cur.wA[s], sb, P, 0, 0, 0);
            Q = __builtin_amdgcn_mfma_f32_16x16x32_bf16(cur.qA[s], sb, Q, 0, 0, 0);
        }
        {
            u32x2 w; w.x = pk2(cur.u[0] - P[0], cur.u[1] - P[1]); w.y = pk2(cur.u[2] - P[2], cur.u[3] - P[3]);
            *(LAS u32x2*)(VT + (16 * n + lr) * 72 + 16 * m + 4 * lq) = w;
        }
        __syncthreads();
        bf16x8 vb[2][2];
#pragma unroll
        for (int nn = 0; nn < 2; ++nn)
#pragma unroll
            for (int s = 0; s < 2; ++s) vb[nn][s] = *(const LAS bf16x8*)(VT + (16 * nn + lr) * 72 + 32 * s + 8 * lq);
        Q = __builtin_amdgcn_mfma_f32_16x16x32_bf16(cur.qkA[0], n ? vb[1][0] : vb[0][0], Q, 0, 0, 0);
        Q = __builtin_amdgcn_mfma_f32_16x16x32_bf16(cur.qkA[1], n ? vb[1][1] : vb[0][1], Q, 0, 0, 0);
        {
            const size_t R0 = (size_t)b * 2048 + nc * 64;
#pragma unroll
            for (int r = 0; r < 4; ++r) Od[(R0 + 16 * m + 4 * lq + r) * 512 + h * 128 + 32 * slice + 16 * n + lr] = Q[r];
        }
#pragma unroll
        for (int nn = 0; nn < 2; ++nn) {
            Sacc[nn] = Sacc[nn] * cur.gl;
            Sacc[nn] = __builtin_amdgcn_mfma_f32_16x16x32_bf16(cur.kgA[0], vb[nn][0], Sacc[nn], 0, 0, 0);
            Sacc[nn] = __builtin_amdgcn_mfma_f32_16x16x32_bf16(cur.kgA[1], vb[nn][1], Sacc[nn], 0, 0, 0);
            u32x2 w; w.x = pk2(Sacc[nn][0], Sacc[nn][1]); w.y = pk2(Sacc[nn][2], Sacc[nn][3]);
            *(LAS u32x2*)(ST + (16 * nn + lr) * 136 + 16 * wid + 4 * lq) = w;
        }
        __syncthreads();
        cur = nxt;
    }
    float* So = p.out + OSP + ((size_t)((l * 8 + b) * 4 + h) * 128) * 128;
#pragma unroll
    for (int nn = 0; nn < 2; ++nn)
#pragma unroll
        for (int r = 0; r < 4; ++r) So[(16 * wid + 4 * lq + r) * 128 + 32 * slice + 16 * nn + lr] = Sacc[nn][r];
}

__device__ __forceinline__ void phase_scan(const Params& p, int l, LAS unsigned char* lds) {
    for (int blk = blockIdx.x; blk < 128; blk += gridDim.x) {
        const int bh = (blk & 7) + 8 * (blk >> 5), slice = (blk >> 3) & 3;
        scan_item(p, l, bh, slice, lds);
        __syncthreads();
    }
}

__device__ __forceinline__ void phase_onorm(const Params& p, int l) {
    const int tid = opq_tid(), wid = tid >> 6, lane = tid & 63;
    const float* Od = (const float*)(p.ws + WS_P0); const bf16_t* P2 = (const bf16_t*)(p.ws + WS_P2); bf16_t* YM = (bf16_t*)(p.ws + WS_H);
    const int c = lane * 8;
    const float4 w0 = *(const float4*)(p.o_norm_w + l * 128 + (c & 127)), w1 = *(const float4*)(p.o_norm_w + l * 128 + (c & 127) + 4);
    for (int row = blockIdx.x * 8 + wid; row < NP; row += gridDim.x * 8) {
        const float4 a = *(const float4*)(Od + (size_t)row * 512 + c), bq = *(const float4*)(Od + (size_t)row * 512 + c + 4);
        float ss = a.x * a.x + a.y * a.y + a.z * a.z + a.w * a.w + bq.x * bq.x + bq.y * bq.y + bq.z * bq.z + bq.w * bq.w;
        ss += __shfl_xor(ss, 1); ss += __shfl_xor(ss, 2); ss += __shfl_xor(ss, 4); ss += __shfl_xor(ss, 8);
        const float rstd = rsqrtf(ss * (1.0f / 128.0f) + 1e-6f);
        float z[8]; unpack8(*(const u32x4*)(P2 + (size_t)row * 1024 + 512 + c), z);
        float y[8];
        y[0] = a.x * rstd * w0.x * silu_f(z[0]); y[1] = a.y * rstd * w0.y * silu_f(z[1]); y[2] = a.z * rstd * w0.z * silu_f(z[2]); y[3] = a.w * rstd * w0.w * silu_f(z[3]);
        y[4] = bq.x * rstd * w1.x * silu_f(z[4]); y[5] = bq.y * rstd * w1.y * silu_f(z[5]); y[6] = bq.z * rstd * w1.z * silu_f(z[6]); y[7] = bq.w * rstd * w1.w * silu_f(z[7]);
        *(u32x4*)(YM + (size_t)row * 1024 + 512 + c) = pack8(y);
    }
}

__global__ void __launch_bounds__(512, 2) mk_fwd(Params p) {
    extern __shared__ __attribute__((aligned(16))) unsigned char shm[];
    LAS unsigned char* lds = (LAS unsigned char*)shm;
    cg::grid_group grid = cg::this_grid();
    volatile XLAS unsigned* xst = (volatile XLAS unsigned*)(lds + 131072);
    if (threadIdx.x == 0) { xst[0] = 0u; xst[1] = 0u; }
    __syncthreads();
    const XcdBarrier xb = xcd_barrier_post((unsigned*)(p.ws + WS_BAR), xst);
    if (p.ph_lo < 0) grid.sync();
    for (int ph = p.ph_lo; ph < p.ph_hi; ++ph) {
        if (ph == 0) { if (!(SKIP & 1)) phase_convert(p, lds); }
        else if (ph == 2) { if (!(SKIP & 2)) phase_rows(p, -1, 0, lds); }
        else {
            const int l = ph >= 3 ? (ph - 3) / 6 : 0, k = ph >= 3 ? (ph - 3) % 6 : -1;
            if (ph == 1 || k == 4) { if (!(SKIP & 4)) {
                pg8::Gemm g; pg8::EpiF32 E;
                if (ph == 1) { g.A = (const bf16_t*)(p.ws + WS_AC); g.Bt = (const bf16_t*)(p.ws + WS_WTADA); g.M = 256; g.N = 6144; g.K = 1024; E.C = (float*)(p.ws + WS_MOD); E.ldc = 6144; E.bias = p.b_ada; }
                else { g.A = (const bf16_t*)(p.ws + WS_H); g.Bt = (const bf16_t*)(p.ws + WS_WTOUT) + (size_t)l * 1024 * 1024; g.M = MPAD; g.N = 1024; g.K = 1024; E.C = (float*)(p.ws + WS_P0); E.ldc = 1024; E.bias = nullptr; }
                pg8::StaticOrder S; S.init(g.M, g.N, (int)gridDim.x, (int)blockIdx.x);
                pg8::gemm_phase<pg8::EpiF32, pg8::StaticOrder, false>(lds, g, S, E, nullptr); }
            } else if (k == 0) { if (!(SKIP & 8)) {
                pg8::Gemm g; g.A = (const bf16_t*)(p.ws + WS_H); g.Bt = (const bf16_t*)(p.ws + WS_WTIN) + (size_t)l * 3072 * 1024; g.M = MPAD; g.N = 3072; g.K = 1024;
                pg8::EpiBf16<0> E; E.O = (bf16_t*)(p.ws + WS_P0); E.ldc = 1024; E.bias = nullptr; E.split_cols = 1024; E.split_stride = (size_t)MPAD * 1024;
                pg8::StaticOrder S; S.init(g.M, g.N, (int)gridDim.x, (int)blockIdx.x);
                pg8::gemm_phase<pg8::EpiBf16<0>, pg8::StaticOrder, false>(lds, g, S, E, nullptr); }
            } else if (k == 1) { if (!(SKIP & 16)) phase_post(p, l, lds); }
            else if (k == 2) { if (!(SKIP & 32)) phase_scan(p, l, lds); }
            else if (k == 3) { if (!(SKIP & 64)) phase_onorm(p, l); }
            else if (k == 5) { if (!(SKIP & 2)) phase_rows(p, l, l + 1 < 2 ? l + 1 : -1, lds); }
        }
#ifdef PROBE_KIND
        {
            const int l2 = ph >= 3 ? (ph - 3) / 6 : 0, k2 = ph >= 3 ? (ph - 3) % 6 : -1;
            for (int rep = 0; rep < PROBE_N; ++rep) {
                if (PROBE_KIND == 6 && ph == 2) xcd_barrier(xb);
                if (PROBE_KIND == 1 && k2 == 1) phase_post(p, l2, lds);
                if (PROBE_KIND == 2 && k2 == 2) phase_scan(p, l2, lds);
                if (PROBE_KIND == 3 && k2 == 3) phase_onorm(p, l2);
                if (PROBE_KIND == 5 && ph == 2) phase_rows(p, -1, 0, lds);
            }
        }
#endif
        if (ph + 1 < p.ph_hi) xcd_barrier(xb);
    }
}

extern "C" void kernel_launch(void* const* d_in, const int* in_sizes, int n_in, void* d_out, int out_size, void* d_ws, size_t ws_size, hipStream_t stream) {
    static int grid = 0;
    if (grid == 0) {
        if (n_in != 19 || ws_size < WS_END) { fprintf(stderr, "kernel_launch: unexpected n_in %d or ws_size %zu (< %zu)\n", n_in, ws_size, (size_t)WS_END); grid = -1; return; }
        int dev = 0, cus = 0, per_cu = 0;
        hipGetDevice(&dev); hipDeviceGetAttribute(&cus, hipDeviceAttributeMultiprocessorCount, dev);
        if (hipFuncSetAttribute((const void*)mk_fwd, hipFuncAttributeMaxDynamicSharedMemorySize, LDS_BYTES) != hipSuccess) { fprintf(stderr, "kernel_launch: hipFuncSetAttribute failed\n"); }
        if (hipOccupancyMaxActiveBlocksPerMultiprocessor(&per_cu, (const void*)mk_fwd, 512, LDS_BYTES) != hipSuccess || per_cu < 1) per_cu = 1;
        (void)hipGetLastError();
        grid = cus * 1;
        if (grid <= 0) grid = 256;
    }
    if (grid < 0) return;
    if (hipMemsetAsync((char*)d_ws + WS_BAR, 0, 16384, stream) != hipSuccess) { fprintf(stderr, "kernel_launch: memset failed\n"); return; }
    Params p{};
    const float** f = (const float**)&p;
    for (int i = 0; i < 19; ++i) f[i] = (const float*)d_in[i];
    p.out = (float*)d_out; p.ws = (unsigned char*)d_ws; p.ph_lo = 0; p.ph_hi = 15;
    void* args[] = {&p};
    hipError_t e = hipLaunchCooperativeKernel((const void*)mk_fwd, dim3(grid), dim3(512), args, LDS_BYTES, stream);
    if (e != hipSuccess) fprintf(stderr, "cooperative launch failed: %s (grid %d)\n", hipGetErrorString(e), grid);
}
```

```cpp
#include <hip/hip_runtime.h>
#include <hip/hip_cooperative_groups.h>
#include <cstdio>
namespace cg = cooperative_groups;
__device__ __forceinline__ int opq_tid() { int t = (int)threadIdx.x; asm volatile("" : "+v"(t)); return t; }
namespace pg8 {
#define PG8_LAS __attribute__((address_space(3)))
typedef unsigned short bf16_t;
typedef short bf16x8 __attribute__((ext_vector_type(8)));
typedef float f32x4 __attribute__((ext_vector_type(4)));
typedef unsigned u32x4 __attribute__((ext_vector_type(4)));
constexpr int BM = 256, BK = 64, HALF = 128, HTB = HALF * BK * 2  , STAGE_BYTES = 8 * HTB, NXCD = 8, WGM = 8;

__host__ __device__ __forceinline__ int lds_byte(int r, int c) { const int st = (r >> 4) * 2 + (c >> 5), rr = r & 15, cc = c & 31, ob = rr * 64 + cc * 2; return st * 1024 + (ob ^ (((ob >> 9) & 1) << 5)); }
__host__ __device__ __forceinline__ void stage_rc(int b, int& R, int& C) { const int st = b / 1024, sb = b % 1024, swz = sb ^ (((sb >> 9) & 1) << 5); R = (st >> 1) * 16 + swz / 64; C = (st & 1) * 32 + (swz % 64) / 2; }
__host__ __device__ __forceinline__ int perm32(int rho) { const int n = rho >> 4, i = rho & 15; return 8 * (i >> 2) + 4 * n + (i & 3); }

struct Unit { int pm, pn; };
struct Gemm { const bf16_t* A; const bf16_t* Bt; int M, N, K; };
struct StaticOrder {
    int nM, nN, nwg, G, c;
    __host__ __device__ void init(int M, int N, int G_, int c_) { nM = M / BM; nN = N / BM; nwg = nM * nN; G = G_; c = c_; }
    __host__ __device__ bool next(int i, Unit& u) const {
        const long L = (long)i * G + c; if (L >= nwg) return false;
        int wgid = (int)L; { const int q = nwg / NXCD, r = nwg % NXCD, xcd = wgid % NXCD, off = wgid / NXCD; wgid = (xcd < r ? xcd * (q + 1) : r * (q + 1) + (xcd - r) * q) + off; }
        const int nig = WGM * nN, gid = wgid / nig, fm = gid * WGM, gsz = (nM - fm) < WGM ? (nM - fm) : WGM;
        u.pm = fm + ((wgid % nig) % gsz); u.pn = (wgid % nig) / gsz; return true;
    }
    __device__ __forceinline__ void a_ready(const Unit&) const {}
    __device__ __forceinline__ void done(const Unit&) const {}
};
__device__ __forceinline__ unsigned cvt_pk_bf16(float lo, float hi) { unsigned r; asm volatile("v_cvt_pk_bf16_f32 %0, %1, %2" : "=v"(r) : "v"(lo), "v"(hi)); return r; }
typedef float f32x2 __attribute__((ext_vector_type(2)));
__device__ __forceinline__ f32x2 gelu_pk(f32x2 v) {
    const f32x2 av = __builtin_elementwise_abs(v), d = av * 0.2316418882f + 1.0f;
    f32x2 t; t.x = __builtin_amdgcn_rcpf(d.x); t.y = __builtin_amdgcn_rcpf(d.y);
    f32x2 q = t * 0.5307027145f + (-0.7265760135f); q = q * t + 0.7107068705f; q = q * t + (-0.142248368f); q = q * t + 0.127414796f; q = q * t;
    const f32x2 s = (v * v) * (-0.72134752044f);
    f32x2 e; e.x = __builtin_amdgcn_exp2f(s.x); e.y = __builtin_amdgcn_exp2f(s.y);
    const f32x2 m = v * (q * e), r = v - m;
    f32x2 o; o.x = v.x < 0.f ? m.x : r.x; o.y = v.y < 0.f ? m.y : r.y; return o;
}

struct EpiF32 {
    static constexpr bool PERM = false, AFTER_DRAIN = false;
    float* C; int ldc; const float* bias;
    __device__ __forceinline__ void operator()(const f32x4 (&acc)[2][2][4][2], const Unit& u, int wr, int wc, int fr, int fq) const {
        const int row0 = u.pm * BM + wr * 64 + fr, col0 = u.pn * BM + wc * 32 + 4 * fq;
        f32x4 bv[2][2];
#pragma unroll
        for (int bj = 0; bj < 2; ++bj)
#pragma unroll
            for (int n = 0; n < 2; ++n) bv[bj][n] = bias ? *(const f32x4*)(bias + col0 + bj * HALF + n * 16) : (f32x4){0.f, 0.f, 0.f, 0.f};
#pragma unroll
        for (int ai = 0; ai < 2; ++ai)
#pragma unroll
            for (int m = 0; m < 4; ++m) { float* rowp = C + (size_t)(row0 + ai * HALF + m * 16) * ldc + col0;
#pragma unroll
                for (int bj = 0; bj < 2; ++bj)
#pragma unroll
                    for (int n = 0; n < 2; ++n) *(f32x4*)(rowp + bj * HALF + n * 16) = acc[ai][bj][m][n] + bv[bj][n]; }
    }
};
template <int ACT  > struct EpiBf16 {
    static constexpr bool PERM = true, AFTER_DRAIN = false;
    bf16_t* O; int ldc; const float* bias; int split_cols; size_t split_stride;
    __device__ __forceinline__ void operator()(const f32x4 (&acc)[2][2][4][2], const Unit& u, int wr, int wc, int fr, int fq) const {
        const int row0 = u.pm * BM + wr * 64 + fr; int colt = u.pn * BM; bf16_t* base = O;
        if (split_cols) { const int t = colt / split_cols; base += (size_t)t * split_stride; colt -= t * split_cols; }
        const int col0 = colt + wc * 32 + 8 * fq, bcol0 = u.pn * BM + wc * 32 + 8 * fq;
        f32x4 bv[2][2];
#pragma unroll
        for (int bj = 0; bj < 2; ++bj)
#pragma unroll
            for (int n = 0; n < 2; ++n) bv[bj][n] = bias ? *(const f32x4*)(bias + bcol0 + bj * HALF + 4 * n) : (f32x4){0.f, 0.f, 0.f, 0.f};
#pragma unroll
        for (int ai = 0; ai < 2; ++ai)
#pragma unroll
            for (int m = 0; m < 4; ++m) { bf16_t* rowp = base + (size_t)(row0 + ai * HALF + m * 16) * ldc + col0;
#pragma unroll
                for (int bj = 0; bj < 2; ++bj) { f32x4 v0 = acc[ai][bj][m][0] + bv[bj][0], v1 = acc[ai][bj][m][1] + bv[bj][1];
                    if (ACT == 1) { f32x2 a = gelu_pk((f32x2){v0[0], v0[1]}), b = gelu_pk((f32x2){v0[2], v0[3]}), c = gelu_pk((f32x2){v1[0], v1[1]}), d = gelu_pk((f32x2){v1[2], v1[3]});
                        v0 = (f32x4){a.x, a.y, b.x, b.y}; v1 = (f32x4){c.x, c.y, d.x, d.y}; }
                    if (ACT == 2) {
#pragma unroll
                        for (int j = 0; j < 4; ++j) { v0[j] = 0.5f * v0[j] * (1.0f + erff(v0[j] * 0.70710678f)); v1[j] = 0.5f * v1[j] * (1.0f + erff(v1[j] * 0.70710678f)); } }
                    u32x4 w; w.x = cvt_pk_bf16(v0[0], v0[1]); w.y = cvt_pk_bf16(v0[2], v0[3]); w.z = cvt_pk_bf16(v1[0], v1[1]); w.w = cvt_pk_bf16(v1[2], v1[3]);
                    *(u32x4*)(rowp + bj * HALF) = w; } }
    }
};
template <class Epi, class Sched, bool STAMP = false>
__device__ __forceinline__ void gemm_phase(PG8_LAS unsigned char* lds, const Gemm g, const Sched& S, const Epi& E, unsigned long long* stamps) {
    const int tid = opq_tid(), wid = __builtin_amdgcn_readfirstlane(tid >> 6), lane = tid & 63, wr = wid >> 2, wc = wid & 3, fr = lane & 15, fq = lane >> 4;
    const int K = g.K, nt = K / BK;
    int ts_lo = 0, ts_hi = 0, nts = 0; const unsigned long long rt_entry = STAMP ? (unsigned long long)wall_clock64() : 0ull;
#define PG8_STAMP() do { if (STAMP && wid == 0 && nts < 64) { const unsigned long long _c = (unsigned long long)clock64(); \
        ts_lo = (lane == nts) ? (int)(unsigned)_c : ts_lo; ts_hi = (lane == nts) ? (int)(unsigned)(_c >> 32) : ts_hi; ++nts; } } while (0)
    PG8_STAMP();
    unsigned voffA[2], voffB[2];
#pragma unroll
    for (int i = 0; i < 2; ++i) { int R, C; stage_rc(tid * 16 + i * 8192, R, C); const int Rb = Epi::PERM ? ((R & ~31) + perm32(R & 31)) : R;
        voffA[i] = (unsigned)(R * K + C) * 2u; voffB[i] = (unsigned)(Rb * K + C) * 2u; }
    const size_t kstep = (size_t)(BK * 2);
    const size_t hstep = (size_t)HALF * K * 2;
    const size_t tstep = 2 * hstep;
    const unsigned ldsw = (unsigned)wid * 1024u;
    const int aoff = lds_byte(wr * 64 + fr, fq * 8), boff = lds_byte(wc * 32 + fr, fq * 8);
#define PG8_SA(b, h) (((b) * 2 + (h)) * HTB)
#define PG8_SB(b, h) ((4 + (b) * 2 + (h)) * HTB)
#define PG8_STAGE(bufoff, gbase, voff) do { _Pragma("unroll") for (int _i = 0; _i < 2; ++_i) \
        __builtin_amdgcn_global_load_lds((const unsigned*)((const char*)(gbase) + (voff)[_i]), (PG8_LAS unsigned*)(lds + (bufoff) + ldsw + _i * 8192), 16, 0, 0); } while (0)
#define PG8_LDA(dst, b, h) do { _Pragma("unroll") for (int m = 0; m < 4; ++m) _Pragma("unroll") for (int k = 0; k < 2; ++k) dst[m][k] = *(const PG8_LAS bf16x8*)(lds + PG8_SA(b, h) + aoff + m * 2048 + k * 1024); } while (0)
#define PG8_LDB(dst, b, h) do { _Pragma("unroll") for (int n = 0; n < 2; ++n) _Pragma("unroll") for (int k = 0; k < 2; ++k) dst[n][k] = *(const PG8_LAS bf16x8*)(lds + PG8_SB(b, h) + boff + n * 2048 + k * 1024); } while (0)
#define PG8_MMA(ai, bj, At, Bt) do { __builtin_amdgcn_s_setprio(1); _Pragma("unroll") for (int m = 0; m < 4; ++m) _Pragma("unroll") for (int n = 0; n < 2; ++n) _Pragma("unroll") for (int k = 0; k < 2; ++k) \
        acc[ai][bj][m][n] = __builtin_amdgcn_mfma_f32_16x16x32_bf16(Bt[n][k], At[m][k], acc[ai][bj][m][n], 0, 0, 0); __builtin_amdgcn_s_setprio(0); } while (0)
#define PG8_WAIT_V(n) asm volatile("s_waitcnt vmcnt(" #n ")" ::: "memory")
#define PG8_WAIT_L(n) asm volatile("s_waitcnt lgkmcnt(" #n ")" ::: "memory")
#define PG8_BAR __builtin_amdgcn_s_barrier()
#define PG8_SCHED __builtin_amdgcn_sched_barrier(0)
    Unit cur, nxt; int ui = 0;
    if (!S.next(0, cur)) return;
    f32x4 acc[2][2][4][2];
#pragma unroll
    for (int a = 0; a < 2; ++a)
#pragma unroll
        for (int b = 0; b < 2; ++b)
#pragma unroll
            for (int m = 0; m < 4; ++m)
#pragma unroll
                for (int n = 0; n < 2; ++n) acc[a][b][m][n] = (f32x4){0.f, 0.f, 0.f, 0.f};
    bf16x8 At[4][2], B0[2][2], B1[2][2];
    const char* cA = (const char*)g.A + (size_t)cur.pm * tstep; const char* cB = (const char*)g.Bt + (size_t)cur.pn * tstep;
    S.a_ready(cur);
    PG8_STAGE(PG8_SB(0, 0), cB, voffB); PG8_STAGE(PG8_SA(0, 0), cA, voffA); PG8_STAGE(PG8_SB(0, 1), cB + hstep, voffB); PG8_STAGE(PG8_SA(0, 1), cA + hstep, voffA);
    if (wr == 1) PG8_BAR;
    PG8_WAIT_V(4); PG8_BAR;
    PG8_STAGE(PG8_SB(1, 0), cB + kstep, voffB); PG8_STAGE(PG8_SA(1, 0), cA + kstep, voffA); PG8_STAGE(PG8_SB(1, 1), cB + hstep + kstep, voffB);
    PG8_WAIT_V(6); PG8_BAR;
    PG8_STAMP();
    for (;;) {
        const bool has_next = S.next(ui + 1, nxt);
        const char* nA = has_next ? (const char*)g.A + (size_t)nxt.pm * tstep : cA; const char* nB = has_next ? (const char*)g.Bt + (size_t)nxt.pn * tstep : cB;
        for (int t = 0; t < nt; t += 2) {
            const bool last = (t == nt - 2);
            const char* a1 = cA + (size_t)(t + 1) * kstep;
            const char* a2 = last ? nA : cA + (size_t)(t + 2) * kstep; const char* b2 = last ? nB : cB + (size_t)(t + 2) * kstep;
            const char* a3 = a2 + kstep; const char* b3 = b2 + kstep;
            if (last && has_next) S.a_ready(nxt);
            PG8_LDB(B0, 0, 0); PG8_SCHED; PG8_LDA(At, 0, 0); PG8_STAGE(PG8_SA(1, 1), a1 + hstep, voffA);
            PG8_WAIT_L(8); PG8_BAR; PG8_WAIT_L(0); PG8_MMA(0, 0, At, B0); PG8_BAR; PG8_SCHED;
            PG8_LDB(B1, 0, 1); PG8_STAGE(PG8_SB(0, 0), b2, voffB);
            PG8_BAR; PG8_WAIT_L(0); PG8_MMA(0, 1, At, B1); PG8_BAR;
            PG8_LDA(At, 0, 1); PG8_STAGE(PG8_SA(0, 0), a2, voffA);
            PG8_BAR; PG8_WAIT_L(0); PG8_MMA(1, 0, At, B0); PG8_BAR; PG8_SCHED;
            PG8_STAGE(PG8_SB(0, 1), b2 + hstep, voffB);
            PG8_WAIT_V(6); PG8_BAR; PG8_MMA(1, 1, At, B1); PG8_BAR;
            PG8_LDB(B0, 1, 0); PG8_SCHED; PG8_LDA(At, 1, 0); PG8_STAGE(PG8_SA(0, 1), a2 + hstep, voffA);
            PG8_WAIT_L(8); PG8_BAR; PG8_WAIT_L(0); PG8_MMA(0, 0, At, B0); PG8_BAR; PG8_SCHED;
            PG8_LDB(B1, 1, 1); PG8_STAGE(PG8_SB(1, 0), b3, voffB);
            PG8_BAR; PG8_WAIT_L(0); PG8_MMA(0, 1, At, B1); PG8_BAR;
            PG8_LDA(At, 1, 1); PG8_STAGE(PG8_SA(1, 0), a3, voffA);
            PG8_BAR; PG8_WAIT_L(0); PG8_MMA(1, 0, At, B0); PG8_BAR; PG8_SCHED;
            PG8_STAGE(PG8_SB(1, 1), b3 + hstep, voffB);
            PG8_WAIT_V(6); PG8_BAR; PG8_MMA(1, 1, At, B1); PG8_BAR;
        }
        PG8_STAMP();
        if constexpr (!Epi::AFTER_DRAIN) { E(acc, cur, wr, wc, fr, fq); S.done(cur); }
        PG8_STAMP();
        if (!has_next) break;
#pragma unroll
        for (int a = 0; a < 2; ++a)
#pragma unroll
            for (int b = 0; b < 2; ++b)
#pragma unroll
                for (int m = 0; m < 4; ++m)
#pragma unroll
                    for (int n = 0; n < 2; ++n) acc[a][b][m][n] = (f32x4){0.f, 0.f, 0.f, 0.f};
        cur = nxt; cA = nA; cB = nB; ++ui;
    }
    PG8_WAIT_V(0);
    if (wr == 0) PG8_BAR;
    PG8_BAR;
    if constexpr (Epi::AFTER_DRAIN) { E.fused(acc, cur, wr, wc, fr, fq, lds, wid, lane); S.done(cur); }
    PG8_STAMP();
    if (STAMP && wid == 0) { stamps[lane] = lane < nts ? (((unsigned long long)(unsigned)ts_hi << 32) | (unsigned)ts_lo) : 0ull;
        if (lane == 62) stamps[62] = rt_entry; if (lane == 63) stamps[63] = (unsigned long long)wall_clock64(); }
#undef PG8_STAMP
#undef PG8_SA
#undef PG8_SB
#undef PG8_STAGE
#undef PG8_LDA
#undef PG8_LDB
#undef PG8_MMA
#undef PG8_WAIT_V
#undef PG8_WAIT_L
#undef PG8_BAR
#undef PG8_SCHED
}
}
#include <cstdint>
#include <cstdlib>
#include <vector>

#define XB_TMO      128
#define XB_XCNT(j)  (256  + 64 * (j))
#define XB_XSUB(j)  (1280 + 64 * (j))
#define XB_XGEN(j)  (2304 + 64 * (j))
#define XB_TOP      3328
#define XB_TOPGEN   3392
#define XCD_BAR_WORDS 3456
#define XB_SPIN_CAP (1u << 18)
#define XLAS __attribute__((address_space(3)))

__device__ __forceinline__ unsigned xb_ld(unsigned* p)              { return __hip_atomic_load(p, __ATOMIC_RELAXED, __HIP_MEMORY_SCOPE_AGENT); }
__device__ __forceinline__ unsigned xb_add(unsigned* p, unsigned v) { return __hip_atomic_fetch_add(p, v, __ATOMIC_RELAXED, __HIP_MEMORY_SCOPE_AGENT); }
__device__ __forceinline__ unsigned xb_xcc_id() { return (unsigned)__builtin_amdgcn_s_getreg((3 << 11) | 20) & 0xFu; }
#define XB_SPIN(cond, bar) do { unsigned _sp = 0; while (cond) { __builtin_amdgcn_s_sleep(1); \
    if ((++_sp & 255u) == 0u) { if (xb_ld(&(bar)[XB_TMO])) break; if (_sp > XB_SPIN_CAP) { atomicAdd(&(bar)[XB_TMO], 1u); break; } } } } while (0)

struct XcdBarrier {
    unsigned* bar; unsigned x;
    volatile XLAS unsigned* st;
};

__device__ __forceinline__ XcdBarrier xcd_barrier_post(unsigned* bar, volatile XLAS unsigned* st) {
    XcdBarrier b; b.bar = bar; b.x = xb_xcc_id(); b.st = st;
    if (threadIdx.x == 0) (void)xb_add(&bar[XB_XCNT(b.x)], 1u);
    return b;
}
__device__ __forceinline__ void xcd_barrier_complete(unsigned* bar, unsigned x, unsigned& nloc, unsigned& nx) {
    const unsigned G = gridDim.x * gridDim.y * gridDim.z;
    unsigned sum, cnt, mine, sp = 0u;
    for (;;) {
        sum = 0u; cnt = 0u; mine = 0u;
#pragma unroll
        for (unsigned j = 0; j < 16; ++j) { const unsigned c = xb_ld(&bar[XB_XCNT(j)]); sum += c; cnt += (c > 0u) ? 1u : 0u; mine = (j == x) ? c : mine; }
        if (sum == G) break;
        __builtin_amdgcn_s_sleep(1);
        if ((++sp & 255u) == 0u) { if (xb_ld(&bar[XB_TMO])) break; if (sp > XB_SPIN_CAP) { atomicAdd(&bar[XB_TMO], 1u); break; } }
    }
    nloc = mine > 0u ? mine : 1u; nx = cnt > 0u ? cnt : 1u;
}

__device__ __forceinline__ void xcd_barrier(const XcdBarrier& b) {
    asm volatile("s_waitcnt vmcnt(0)" ::: "memory");
    __syncthreads();
    if (threadIdx.x == 0) {
        unsigned* bar = b.bar;
        __builtin_amdgcn_s_waitcnt(0);
        unsigned nloc = b.st[0], nx = b.st[1];
        if (nloc == 0u) { xcd_barrier_complete(bar, b.x, nloc, nx); b.st[0] = nloc; b.st[1] = nx; }
        const unsigned old = xb_add(&bar[XB_XSUB(b.x)], 1u);
        const unsigned gen = old / nloc;
        if (old + 1u == (gen + 1u) * nloc) {
            __builtin_amdgcn_fence(__ATOMIC_RELEASE, "agent");
            asm volatile("s_waitcnt vmcnt(0)" ::: "memory");
            const unsigned og = xb_add(&bar[XB_TOP], 1u);
            const unsigned tg = og / nx;
            if (og + 1u == (tg + 1u) * nx) xb_add(&bar[XB_TOPGEN], 1u);
            else XB_SPIN(xb_ld(&bar[XB_TOPGEN]) == tg, bar);
            __builtin_amdgcn_fence(__ATOMIC_ACQUIRE, "agent");
            xb_add(&bar[XB_XGEN(b.x)], 1u);
            asm volatile("s_waitcnt vmcnt(0)" ::: "memory");
        } else {
            XB_SPIN(xb_ld(&bar[XB_XGEN(b.x)]) == gen, bar);
            __builtin_amdgcn_fence(__ATOMIC_ACQUIRE, "agent");
            asm volatile("s_waitcnt vmcnt(0)" ::: "memory");
        }
    }
    __syncthreads();
}

#ifndef SKIP
#define SKIP 0
#endif
#define LAS PG8_LAS
typedef pg8::bf16_t bf16_t;
typedef pg8::bf16x8 bf16x8;
typedef pg8::f32x4 f32x4;
typedef pg8::u32x4 u32x4;
typedef unsigned u32x2 __attribute__((ext_vector_type(2)));
constexpr int NP = 16384, NS = 128, NR = NP + NS, MPAD = 16640, DM = 1024, DIN = 3080;
constexpr int LDS_BYTES = 131072 + 16;
constexpr size_t OYS = 16777216, OPP = 16908288, OCP = 17031168, OSP = 17104896, OPS = 18153472, OCS = 20119552, OSS = 21299200;
constexpr size_t WS_WTIN = 0;
constexpr size_t WS_WTOUT = WS_WTIN + 12582912;
constexpr size_t WS_WTPOOL = WS_WTOUT + 4194304;
constexpr size_t WS_MOD = WS_WTPOOL + 262144;
constexpr size_t WS_H = WS_MOD + 6291456;
constexpr size_t WS_P0 = WS_H + 34078720;
constexpr size_t WS_P1 = WS_P0 + 34078720;
constexpr size_t WS_P2 = WS_P1 + 34078720;
constexpr size_t WS_G = WS_P2 + 34078720;
constexpr size_t WS_BETA = WS_G + 264192;
constexpr size_t WS_GL = WS_BETA + 264192;
constexpr size_t WS_W = WS_GL + 4096;
constexpr size_t WS_QG = WS_W + 16777216;
constexpr size_t WS_KGT = WS_QG + 16777216;
constexpr size_t WS_QK = WS_KGT + 16777216;
constexpr size_t WS_U = WS_QK + 8388608;
constexpr size_t WS_WTADA = WS_U;
constexpr size_t WS_AC = WS_U + 12582912;
constexpr size_t WS_BAR = WS_U + 33554432;
constexpr size_t WS_END = WS_BAR + 16384;

struct Params {
    const float* x_prompt; const float* x_sample; const float* c_prompt; const float* c_sample;
    const float* state_pool; const float* state_conv; const float* state_ssm;
    const float* w_ada; const float* b_ada; const float* pre_norm_w; const float* post_norm_w; const float* w_in; const float* conv_w;
    const float* pool_w; const float* pool_scale; const float* a_log; const float* dt_bias; const float* o_norm_w; const float* w_out;
    float* out; unsigned char* ws; int ph_lo, ph_hi;
};

__device__ __forceinline__ float bf2f(unsigned short b) { return __uint_as_float(((unsigned)b) << 16); }
typedef __bf16 bf16x2_t __attribute__((ext_vector_type(2)));
typedef float f32x2_t __attribute__((ext_vector_type(2)));
__device__ __forceinline__ unsigned pk2(float lo, float hi) { f32x2_t v = {lo, hi}; bf16x2_t r = __builtin_convertvector(v, bf16x2_t); unsigned u; __builtin_memcpy(&u, &r, 4); return u; }
__device__ __forceinline__ unsigned short f2bf(float f) { return (unsigned short)(pk2(f, 0.f) & 0xffffu); }
__device__ __forceinline__ float silu_f(float x) { return __fdividef(x, 1.0f + __expf(-x)); }
__device__ __forceinline__ void unpack8(const u32x4 v, float* x) {
    x[0] = __uint_as_float(v.x << 16); x[1] = __uint_as_float(v.x & 0xffff0000u); x[2] = __uint_as_float(v.y << 16); x[3] = __uint_as_float(v.y & 0xffff0000u);
    x[4] = __uint_as_float(v.z << 16); x[5] = __uint_as_float(v.z & 0xffff0000u); x[6] = __uint_as_float(v.w << 16); x[7] = __uint_as_float(v.w & 0xffff0000u);
}
__device__ __forceinline__ u32x4 pack8(const float* x) { u32x4 w; w.x = pk2(x[0], x[1]); w.y = pk2(x[2], x[3]); w.z = pk2(x[4], x[5]); w.w = pk2(x[6], x[7]); return w; }
__device__ __forceinline__ float wave_sum(float v) {
#pragma unroll
    for (int o = 32; o >= 1; o >>= 1) v += __shfl_xor(v, o);
    return v;
}

__device__ __forceinline__ void transpose_tile(const float* __restrict__ src, int ld, bf16_t* __restrict__ dst, int ldd, int k0, int n0, LAS float* tile) {
    const int tid = opq_tid();
#pragma unroll
    for (int p = 0; p < 2; ++p) {
        const int kk = (tid >> 4) + 32 * p, n4 = (tid & 15) * 4;
        const float4 v = *(const float4*)(src + (size_t)(k0 + kk) * ld + n0 + n4);
        tile[kk * 65 + n4 + 0] = v.x; tile[kk * 65 + n4 + 1] = v.y; tile[kk * 65 + n4 + 2] = v.z; tile[kk * 65 + n4 + 3] = v.w;
    }
    __syncthreads();
    const int n = tid >> 3, k8 = (tid & 7) * 8;
    float x[8];
#pragma unroll
    for (int i = 0; i < 8; ++i) x[i] = tile[(k8 + i) * 65 + n];
    *(u32x4*)(dst + (size_t)(n0 + n) * ldd + k0 + k8) = pack8(x);
    __syncthreads();
}

__device__ __forceinline__ void phase_convert(const Params& p, LAS unsigned char* lds) {
    LAS float* tile = (LAS float*)lds;
    bf16_t* WtIn = (bf16_t*)(p.ws + WS_WTIN); bf16_t* WtAda = (bf16_t*)(p.ws + WS_WTADA); bf16_t* WtOut = (bf16_t*)(p.ws + WS_WTOUT); bf16_t* WtPool = (bf16_t*)(p.ws + WS_WTPOOL);
    for (int t = blockIdx.x; t < 3616; t += gridDim.x) {
        if (t < 1536) { const int l = t / 768, rem = t % 768; transpose_tile(p.w_in + (size_t)l * 1024 * DIN, DIN, WtIn + (size_t)l * 3072 * 1024, 1024, (rem / 48) * 64, (rem % 48) * 64, tile); }
        else if (t < 3072) { const int tt = t - 1536, l = tt / 768, rem = tt % 768; transpose_tile(p.w_ada + (size_t)l * 1024 * 3072, 3072, WtAda + (size_t)l * 3072 * 1024, 1024, (rem / 48) * 64, (rem % 48) * 64, tile); }
        else if (t < 3584) { const int tt = t - 3072, l = tt / 256, rem = tt % 256; transpose_tile(p.w_out + (size_t)l * 1024 * 1024, 1024, WtOut + (size_t)l * 1024 * 1024, 1024, (rem / 16) * 64, (rem % 16) * 64, tile); }
        else { const int tt = t - 3584, lg = tt / 4, rem = tt % 4; transpose_tile(p.pool_w + (size_t)lg * 16384, 128, WtPool + (size_t)lg * 16384, 128, (rem / 2) * 64, (rem % 2) * 64, tile); }
    }
    bf16_t* Ac = (bf16_t*)(p.ws + WS_AC);
    for (int i = blockIdx.x * 512 + opq_tid(); i < 65536; i += gridDim.x * 512) {
        const int row = i >> 8, c4 = (i & 255) * 4;
        float4 v = make_float4(0.f, 0.f, 0.f, 0.f);
        if (row < 8) v = *(const float4*)(p.c_prompt + row * 1024 + c4); else if (row < 136) v = *(const float4*)(p.c_sample + (row - 8) * 1024 + c4);
        uint2 w; w.x = pk2(silu_f(v.x), silu_f(v.y)); w.y = pk2(silu_f(v.z), silu_f(v.w));
        *(uint2*)(Ac + row * 1024 + c4) = w;
    }
}

__device__ __forceinline__ void phase_rows(const Params& p, int lF, int lA, LAS unsigned char* lds) {
    const int tid = opq_tid(), wid = tid >> 6, lane = tid & 63;
    LAS float* W8t = (LAS float*)lds;
    const float* mod = (const float*)(p.ws + WS_MOD);
    const float* Y = (const float*)(p.ws + WS_P0);
    bf16_t* H = (bf16_t*)(p.ws + WS_H);
    float* Gd = (float*)(p.ws + WS_G); float* Bd = (float*)(p.ws + WS_BETA);
    if (lA >= 0) {
        for (int i = tid; i < 8192; i += 512) { const int k = i >> 3, j = i & 7; W8t[j * 1024 + k] = p.w_in[(size_t)lA * 1024 * DIN + (size_t)k * DIN + 3072 + j]; }
        __syncthreads();
    }
    for (int row = blockIdx.x * 8 + wid; row < NR; row += gridDim.x * 8) {
        const int mrow = row < NP ? (row >> 11) : (8 + row - NP);
        const float* xorig = row < NP ? p.x_prompt + (size_t)row * 1024 : p.x_sample + (size_t)(row - NP) * 1024;
        float* xout = p.out + (size_t)row * 1024;
        float4 xv[4];
        if (lF >= 0) {
            const float* yrow = Y + (size_t)row * 1024; const float* mF = mod + (size_t)mrow * 6144 + lF * 3072 + 2048;
            const float* xsrc = (lF == 0) ? xorig : xout;
            float4 yv[4]; float ss = 0.f;
#pragma unroll
            for (int i = 0; i < 4; ++i) { yv[i] = *(const float4*)(yrow + lane * 4 + 256 * i); ss += yv[i].x * yv[i].x + yv[i].y * yv[i].y + yv[i].z * yv[i].z + yv[i].w * yv[i].w; }
            ss = wave_sum(ss);
            const float rstd = rsqrtf(ss * (1.0f / 1024.0f) + 1e-6f);
#pragma unroll
            for (int i = 0; i < 4; ++i) {
                const int c = lane * 4 + 256 * i;
                const float4 gt = *(const float4*)(mF + c), pw = *(const float4*)(p.post_norm_w + lF * 1024 + c), xi = *(const float4*)(xsrc + c);
                xv[i].x = xi.x + gt.x * (yv[i].x * rstd * pw.x); xv[i].y = xi.y + gt.y * (yv[i].y * rstd * pw.y);
                xv[i].z = xi.z + gt.z * (yv[i].z * rstd * pw.z); xv[i].w = xi.w + gt.w * (yv[i].w * rstd * pw.w);
                *(float4*)(xout + c) = xv[i];
            }
        } else {
#pragma unroll
            for (int i = 0; i < 4; ++i) xv[i] = *(const float4*)(xorig + lane * 4 + 256 * i);
        }
        if (lA >= 0) {
            float ss = 0.f;
#pragma unroll
            for (int i = 0; i < 4; ++i) ss += xv[i].x * xv[i].x + xv[i].y * xv[i].y + xv[i].z * xv[i].z + xv[i].w * xv[i].w;
            ss = wave_sum(ss);
            const float rstd = rsqrtf(ss * (1.0f / 1024.0f) + 1e-6f);
            const float* mA = mod + (size_t)mrow * 6144 + lA * 3072;
            float d[8];
#pragma unroll
            for (int j = 0; j < 8; ++j) d[j] = 0.f;
#pragma unroll
            for (int i = 0; i < 4; ++i) {
                const int c = lane * 4 + 256 * i;
                const float4 sh = *(const float4*)(mA + c), sc = *(const float4*)(mA + 1024 + c), pw = *(const float4*)(p.pre_norm_w + lA * 1024 + c);
                float4 hv;
                hv.x = xv[i].x * rstd * pw.x * (1.0f + sc.x) + sh.x; hv.y = xv[i].y * rstd * pw.y * (1.0f + sc.y) + sh.y;
                hv.z = xv[i].z * rstd * pw.z * (1.0f + sc.z) + sh.z; hv.w = xv[i].w * rstd * pw.w * (1.0f + sc.w) + sh.w;
                uint2 w; w.x = pk2(hv.x, hv.y); w.y = pk2(hv.z, hv.w);
                *(uint2*)(H + (size_t)row * 1024 + c) = w;
#pragma unroll
                for (int j = 0; j < 8; ++j) { const f32x4 wv = *(const LAS f32x4*)(W8t + j * 1024 + c); d[j] += hv.x * wv[0] + hv.y * wv[1] + hv.z * wv[2] + hv.w * wv[3]; }
            }
#pragma unroll
            for (int j = 0; j < 8; ++j) d[j] = wave_sum(d[j]);
            if (lane < 4) {
                const float br = lane == 0 ? d[0] : lane == 1 ? d[1] : lane == 2 ? d[2] : d[3];
                const float ar = lane == 0 ? d[4] : lane == 1 ? d[5] : lane == 2 ? d[6] : d[7];
                const float xs = ar + p.dt_bias[lA * 4 + lane];
                const float sp = fmaxf(xs, 0.f) + log1pf(__expf(-fabsf(xs)));
                Bd[row * 4 + lane] = 1.0f / (1.0f + __expf(-br));
                Gd[row * 4 + lane] = -__expf(p.a_log[lA * 4 + lane]) * sp;
            }
        }
    }
}

__device__ __forceinline__ void conv16(const u32x4 (&xr)[4][2], int tok, const float* __restrict__ cw, float* out, float* xcur) {
    float acc[16];
#pragma unroll
    for (int i = 0; i < 16; ++i) acc[i] = 0.f;
#pragma unroll
    for (int j = 0; j < 4; ++j) {
        const bool valid = (tok - 3 + j) >= 0;
        float x[16]; unpack8(xr[j][0], x); unpack8(xr[j][1], x + 8);
#pragma unroll
        for (int q = 0; q < 4; ++q) {
            const float4 w = *(const float4*)(cw + j * 1536 + 4 * q);
            const float x0 = valid ? x[4 * q] : 0.f, x1 = valid ? x[4 * q + 1] : 0.f, x2 = valid ? x[4 * q + 2] : 0.f, x3 = valid ? x[4 * q + 3] : 0.f;
            acc[4 * q] += x0 * w.x; acc[4 * q + 1] += x1 * w.y; acc[4 * q + 2] += x2 * w.z; acc[4 * q + 3] += x3 * w.w;
        }
        if (j == 3) {
#pragma unroll
            for (int i = 0; i < 16; ++i) xcur[i] = x[i];
        }
    }
#pragma unroll
    for (int i = 0; i < 16; ++i) out[i] = silu_f(acc[i]);
}

__device__ __forceinline__ void chunk_item(const Params& p, int l, int idx, LAS unsigned char* lds) {
    const int tid = opq_tid(), wid = tid >> 6, lane = tid & 63;
    const int b = idx >> 7, h = (idx >> 5) & 3, n = idx & 31, R0 = b * 2048 + n * 64;
    LAS bf16_t* KB = (LAS bf16_t*)lds; LAS bf16_t* QB = (LAS bf16_t*)(lds + 17408);
    LAS float* AT = (LAS float*)(lds + 34816); LAS float* RHS = (LAS float*)(lds + 51200);
    LAS float* GC = (LAS float*)(lds + 116736); LAS float* BT = GC + 64; LAS float* EG = GC + 128;
    const float* Gd = (const float*)(p.ws + WS_G); const float* Bd = (const float*)(p.ws + WS_BETA);
    const bf16_t* P1 = (const bf16_t*)(p.ws + WS_P1); const bf16_t* P2 = (const bf16_t*)(p.ws + WS_P2);
    bf16_t* Wd = (bf16_t*)(p.ws + WS_W) + (size_t)idx * 8192; bf16_t* QGd = (bf16_t*)(p.ws + WS_QG) + (size_t)idx * 8192;
    bf16_t* KGTd = (bf16_t*)(p.ws + WS_KGT) + (size_t)idx * 8192; bf16_t* QKd = (bf16_t*)(p.ws + WS_QK) + (size_t)idx * 4096;
    float* Ud = (float*)(p.ws + WS_U) + (size_t)idx * 8192; float* GLd = (float*)(p.ws + WS_GL);
    const int et = tid >> 3, ec0 = (tid & 7) * 16, etok = n * 64 + et;
    u32x4 xr[3][4][2];
#pragma unroll
    for (int a = 0; a < 3; ++a) {
        const bf16_t* base = (a == 0 ? P1 + h * 128 : a == 1 ? P1 + 512 + h * 128 : P2 + h * 128) + ec0;
#pragma unroll
        for (int j = 0; j < 4; ++j) {
            const int tj = etok - 3 + j, tjc = tj < 0 ? 0 : tj;
            const bf16_t* ptr = base + (size_t)(b * 2048 + tjc) * 1024;
            xr[a][j][0] = *(const u32x4*)ptr; xr[a][j][1] = *(const u32x4*)(ptr + 8);
        }
    }
    if (tid < 64) {
        float v = Gd[(R0 + tid) * 4 + h];
#pragma unroll
        for (int o = 1; o < 64; o <<= 1) { const float t = __shfl_up(v, o); if (lane >= o) v += t; }
        GC[tid] = v; BT[tid] = Bd[(R0 + tid) * 4 + h]; const float e = __expf(v); EG[tid] = e;
        if (tid == 63) GLd[idx] = e;
    }
    __syncthreads();
    {
        const int t = et, c0 = ec0, tok = etok;
        const float bt = BT[t], eg = EG[t];
        const float* cwl = p.conv_w + (size_t)l * 4 * 1536;
        float s[16], xc[16];
        conv16(xr[0], tok, cwl + h * 128 + c0, s, xc);
        if (n == 31 && t >= 61) { float* o = p.out + OCP + ((size_t)(l * 8 + b) * 3 + (t - 61)) * 1536 + h * 128 + c0;
#pragma unroll
            for (int i = 0; i < 16; ++i) o[i] = xc[i]; }
        float ss = 0.f;
#pragma unroll
        for (int i = 0; i < 16; ++i) ss += s[i] * s[i];
        ss += __shfl_xor(ss, 1); ss += __shfl_xor(ss, 2); ss += __shfl_xor(ss, 4);
        float rs = rsqrtf(ss + 1e-6f) * 0.08838834764831845f;
        float qn[16];
#pragma unroll
        for (int i = 0; i < 16; ++i) qn[i] = s[i] * rs;
        *(LAS u32x4*)(QB + t * 136 + c0) = pack8(qn); *(LAS u32x4*)(QB + t * 136 + c0 + 8) = pack8(qn + 8);
#pragma unroll
        for (int i = 0; i < 16; ++i) qn[i] *= eg;
        *(u32x4*)(QGd + t * 128 + c0) = pack8(qn); *(u32x4*)(QGd + t * 128 + c0 + 8) = pack8(qn + 8);
        conv16(xr[1], tok, cwl + 512 + h * 128 + c0, s, xc);
        if (n == 31 && t >= 61) { float* o = p.out + OCP + ((size_t)(l * 8 + b) * 3 + (t - 61)) * 1536 + 512 + h * 128 + c0;
#pragma unroll
            for (int i = 0; i < 16; ++i) o[i] = xc[i]; }
        ss = 0.f;
#pragma unroll
        for (int i = 0; i < 16; ++i) ss += s[i] * s[i];
        ss += __shfl_xor(ss, 1); ss += __shfl_xor(ss, 2); ss += __shfl_xor(ss, 4);
        rs = rsqrtf(ss + 1e-6f);
#pragma unroll
        for (int i = 0; i < 16; ++i) s[i] *= rs;
        *(LAS u32x4*)(KB + t * 136 + c0) = pack8(s); *(LAS u32x4*)(KB + t * 136 + c0 + 8) = pack8(s + 8);
        const float be = bt * eg;
#pragma unroll
        for (int i = 0; i < 16; i += 4) *(LAS f32x4*)(RHS + t * 256 + 128 + c0 + i) = (f32x4){s[i] * be, s[i + 1] * be, s[i + 2] * be, s[i + 3] * be};
        conv16(xr[2], tok, cwl + 1024 + h * 128 + c0, s, xc);
        if (n == 31 && t >= 61) { float* o = p.out + OCP + ((size_t)(l * 8 + b) * 3 + (t - 61)) * 1536 + 1024 + h * 128 + c0;
#pragma unroll
            for (int i = 0; i < 16; ++i) o[i] = xc[i]; }
#pragma unroll
        for (int i = 0; i < 16; i += 4) *(LAS f32x4*)(RHS + t * 256 + c0 + i) = (f32x4){s[i] * bt, s[i + 1] * bt, s[i + 2] * bt, s[i + 3] * bt};
    }
    __syncthreads();
    {
        const int lr = lane & 15, lq = lane >> 4;
#pragma unroll 1
        for (int jj = 0; jj < 4; ++jj) {
            const int job = wid * 4 + jj, which = job >> 4, tile = job & 15, mi = tile >> 2, nj = tile & 3;
            LAS bf16_t* As = which ? QB : KB;
            f32x4 acc = {0.f, 0.f, 0.f, 0.f};
#pragma unroll
            for (int s = 0; s < 4; ++s) {
                const bf16x8 a = *(const LAS bf16x8*)(As + (16 * mi + lr) * 136 + 32 * s + 8 * lq);
                const bf16x8 bb = *(const LAS bf16x8*)(KB + (16 * nj + lr) * 136 + 32 * s + 8 * lq);
                acc = __builtin_amdgcn_mfma_f32_16x16x32_bf16(a, bb, acc, 0, 0, 0);
            }
            const int j = 16 * nj + lr, i0 = 16 * mi + 4 * lq;
            const float gj = GC[j];
            if (!which) {
                f32x4 o;
#pragma unroll
                for (int r = 0; r < 4; ++r) { const int i = i0 + r; o[r] = (i > j) ? BT[i] * acc[r] * __expf(GC[i] - gj) : 0.f; }
                *(LAS f32x4*)(AT + j * 64 + i0) = o;
            } else {
#pragma unroll
                for (int r = 0; r < 4; ++r) { const int i = i0 + r; const float v = (i >= j) ? acc[r] * __expf(GC[i] - gj) : 0.f; QKd[i * 64 + j] = f2bf(v); }
            }
        }
    }
    __syncthreads();
    if (tid < 256) {
        const int c = tid;
        float r[64];
#pragma unroll
        for (int i = 0; i < 64; ++i) r[i] = RHS[i * 256 + c];
#pragma unroll
        for (int j = 0; j < 63; ++j) {
            const float xj = r[j];
#pragma unroll
            for (int i4 = ((j + 1) & ~3); i4 < 64; i4 += 4) {
                const f32x4 a = *(const LAS f32x4*)(AT + j * 64 + i4);
                r[i4 + 0] -= a[0] * xj; r[i4 + 1] -= a[1] * xj; r[i4 + 2] -= a[2] * xj; r[i4 + 3] -= a[3] * xj;
            }
        }
        if (c < 128) {
#pragma unroll
            for (int i = 0; i < 64; ++i) Ud[i * 128 + c] = r[i];
        } else {
#pragma unroll
            for (int i = 0; i < 64; ++i) Wd[i * 128 + (c - 128)] = f2bf(r[i]);
        }
    } else {
        const int d = (tid - 256) >> 1, th = tid & 1;
        const float gcl = GC[63];
        float x[32];
#pragma unroll
        for (int i = 0; i < 32; ++i) { const int t = 32 * th + i; x[i] = bf2f(KB[t * 136 + d]) * __expf(gcl - GC[t]); }
#pragma unroll
        for (int q = 0; q < 4; ++q) *(u32x4*)(KGTd + d * 64 + 32 * th + 8 * q) = pack8(x + 8 * q);
    }
    __syncthreads();
}

__device__ __forceinline__ void pool_item(const Params& p, int l, int pidx, LAS unsigned char* lds) {
    const int tid = opq_tid(), wid = tid >> 6, lane = tid & 63;
    const int g = pidx & 3, T = pidx >> 2, w = 2 << g;
    const int rowbase = T * 128, b = rowbase >> 11, t0 = rowbase & 2047;
    LAS bf16_t* UT = (LAS bf16_t*)lds; LAS bf16_t* PB = (LAS bf16_t*)(lds + 38912); LAS bf16_t* WB = (LAS bf16_t*)(lds + 73728);
    const bf16_t* P0 = (const bf16_t*)(p.ws + WS_P0);
    const bf16_t* WtPool = (const bf16_t*)(p.ws + WS_WTPOOL) + (size_t)(l * 4 + g) * 16384;
    bf16_t* YM = (bf16_t*)(p.ws + WS_H);
#pragma unroll
    for (int q = 0; q < 4; ++q) { const int piece = tid + 512 * q, d = piece >> 4, k8 = (piece & 15) * 8; *(LAS u32x4*)(WB + d * 136 + k8) = *(const u32x4*)(WtPool + d * 128 + k8); }
#pragma unroll
    for (int q = 0; q < 5; ++q) {
        const int piece = tid + 512 * q;
        if (piece < 143 * 16) {
            const int rr = piece >> 4, c8 = (piece & 15) * 8, tok = t0 - 15 + rr;
            u32x4 v = *(const u32x4*)(P0 + (size_t)(b * 2048 + (tok < 0 ? 0 : tok)) * 1024 + g * 128 + c8);
            if (tok < 0) v = (u32x4){0u, 0u, 0u, 0u};
            *(LAS u32x4*)(UT + rr * 136 + c8) = v;
        }
    }
    __syncthreads();
    {
        const int c = tid & 127, q = tid >> 7, i0 = 32 * q;
        float s = 0.f;
        for (int j = 1; j < w; ++j) s += bf2f(UT[(i0 + 15 - j) * 136 + c]);
#pragma unroll 4
        for (int i = i0; i < i0 + 32; ++i) {
            const float cur = bf2f(UT[(i + 15) * 136 + c]);
            s += cur;
            const int tk = t0 + i + 1; const float cnt = (float)(tk < w ? tk : w);
            PB[i * 136 + c] = f2bf(__fdividef(s, cnt) - cur);
            s -= bf2f(UT[(i + 15 - (w - 1)) * 136 + c]);
            if (t0 == 1920 && i >= 113) p.out[OPP + ((size_t)(l * 8 + b) * 15 + (i - 113)) * 512 + g * 128 + c] = cur;
        }
    }
    __syncthreads();
    {
        const int lr = lane & 15, lq = lane >> 4;
        bf16x8 a[4];
#pragma unroll
        for (int s = 0; s < 4; ++s) a[s] = *(const LAS bf16x8*)(PB + (16 * wid + lr) * 136 + 32 * s + 8 * lq);
        const size_t prow = (size_t)(rowbase + 16 * wid + lr);
        u32x2 zr[8];
#pragma unroll
        for (int nt = 0; nt < 8; ++nt) zr[nt] = *(const u32x2*)(P0 + prow * 1024 + 512 + g * 128 + 16 * nt + 4 * lq);
#pragma unroll
        for (int nt = 0; nt < 8; ++nt) {
            f32x4 acc = {0.f, 0.f, 0.f, 0.f};
#pragma unroll
            for (int s = 0; s < 4; ++s) { const bf16x8 bb = *(const LAS bf16x8*)(WB + (16 * nt + lr) * 136 + 32 * s + 8 * lq); acc = __builtin_amdgcn_mfma_f32_16x16x32_bf16(bb, a[s], acc, 0, 0, 0); }
            const int d = g * 128 + 16 * nt + 4 * lq;
            const float4 ps = *(const float4*)(p.pool_scale + l * 512 + d);
            const float z0 = __uint_as_float(zr[nt].x << 16), z1 = __uint_as_float(zr[nt].x & 0xffff0000u), z2 = __uint_as_float(zr[nt].y << 16), z3 = __uint_as_float(zr[nt].y & 0xffff0000u);
            u32x2 w2; w2.x = pk2(acc[0] * ps.x * silu_f(z0), acc[1] * ps.y * silu_f(z1)); w2.y = pk2(acc[2] * ps.z * silu_f(z2), acc[3] * ps.w * silu_f(z3));
            *(u32x2*)(YM + prow * 1024 + d) = w2;
        }
    }
    __syncthreads();
}

__device__ __forceinline__ void sample_pool_item(const Params& p, int l, int sidx, LAS unsigned char* lds) {
    const int tid = opq_tid(), wid = tid >> 6, lane = tid & 63;
    const int g = sidx & 3, tq = sidx >> 2, w = 2 << g;
    LAS bf16_t* PB = (LAS bf16_t*)(lds + 38912); LAS bf16_t* WB = (LAS bf16_t*)(lds + 73728);
    const bf16_t* P0 = (const bf16_t*)(p.ws + WS_P0);
    const bf16_t* WtPool = (const bf16_t*)(p.ws + WS_WTPOOL) + (size_t)(l * 4 + g) * 16384;
    bf16_t* YM = (bf16_t*)(p.ws + WS_H);
#pragma unroll
    for (int q = 0; q < 4; ++q) { const int piece = tid + 512 * q, d = piece >> 4, k8 = (piece & 15) * 8; *(LAS u32x4*)(WB + d * 136 + k8) = *(const u32x4*)(WtPool + d * 128 + k8); }
    {
        const int c = tid & 127, q = tid >> 7;
#pragma unroll 2
        for (int ii = 0; ii < 8; ++ii) {
            const int il = 8 * q + ii, i = 32 * tq + il;
            const float cur = bf2f(P0[(size_t)(NP + i) * 1024 + g * 128 + c]);
            const float* sp = p.state_pool + ((size_t)(l * 128 + i) * 15) * 512 + g * 128 + c;
            float* op = p.out + OPS + ((size_t)(l * 128 + i) * 15) * 512 + g * 128 + c;
            float v[15];
#pragma unroll
            for (int j = 0; j < 15; ++j) v[j] = sp[(size_t)j * 512];
            float s = cur;
#pragma unroll
            for (int j = 0; j < 15; ++j) { if (14 - j <= w - 2) s += v[j]; if (j >= 1) op[(size_t)(j - 1) * 512] = v[j]; }
            op[(size_t)14 * 512] = cur;
            PB[il * 136 + c] = f2bf(__fdividef(s, (float)w) - cur);
        }
    }
    __syncthreads();
    if (wid < 2) {
        const int lr = lane & 15, lq = lane >> 4;
        bf16x8 a[4];
#pragma unroll
        for (int s = 0; s < 4; ++s) a[s] = *(const LAS bf16x8*)(PB + (16 * wid + lr) * 136 + 32 * s + 8 * lq);
        const size_t prow = (size_t)(NP + 32 * tq + 16 * wid + lr);
        u32x2 zr[8];
#pragma unroll
        for (int nt = 0; nt < 8; ++nt) zr[nt] = *(const u32x2*)(P0 + prow * 1024 + 512 + g * 128 + 16 * nt + 4 * lq);
#pragma unroll
        for (int nt = 0; nt < 8; ++nt) {
            f32x4 acc = {0.f, 0.f, 0.f, 0.f};
#pragma unroll
            for (int s = 0; s < 4; ++s) { const bf16x8 bb = *(const LAS bf16x8*)(WB + (16 * nt + lr) * 136 + 32 * s + 8 * lq); acc = __builtin_amdgcn_mfma_f32_16x16x32_bf16(bb, a[s], acc, 0, 0, 0); }
            const int d = g * 128 + 16 * nt + 4 * lq;
            const float4 ps = *(const float4*)(p.pool_scale + l * 512 + d);
            const float z0 = __uint_as_float(zr[nt].x << 16), z1 = __uint_as_float(zr[nt].x & 0xffff0000u), z2 = __uint_as_float(zr[nt].y << 16), z3 = __uint_as_float(zr[nt].y & 0xffff0000u);
            u32x2 w2; w2.x = pk2(acc[0] * ps.x * silu_f(z0), acc[1] * ps.y * silu_f(z1)); w2.y = pk2(acc[2] * ps.z * silu_f(z2), acc[3] * ps.w * silu_f(z3));
            *(u32x2*)(YM + prow * 1024 + d) = w2;
        }
    }
    __syncthreads();
}

__device__ __forceinline__ void sample_item(const Params& p, int l, int b, LAS unsigned char* lds) {
    const int tid = opq_tid(), wid = tid >> 6, lane = tid & 63;
    const int hd = tid >> 7, e = tid & 127;
    const size_t r = (size_t)(NP + b);
    LAS float* SQ = (LAS float*)lds; LAS float* SK = SQ + 512; LAS float* SV = SQ + 1024; LAS float* SO = SQ + 1536;
    LAS float* RED = SQ + 2048; LAS float* RED2 = SQ + 2560; LAS float* RW = SQ + 3072;
    const bf16_t* P1 = (const bf16_t*)(p.ws + WS_P1); const bf16_t* P2 = (const bf16_t*)(p.ws + WS_P2);
    const float* Gd = (const float*)(p.ws + WS_G); const float* Bd = (const float*)(p.ws + WS_BETA);
    bf16_t* YM = (bf16_t*)(p.ws + WS_H);
    const float* sc = p.state_conv + (size_t)(l * 128 + b) * 3 * 1536; const float* cw = p.conv_w + (size_t)l * 4 * 1536;
    float* oc = p.out + OCS + (size_t)(l * 128 + b) * 3 * 1536;
    const int part = hd;
    float sreg[32];
    {
        const float* Sin0 = p.state_ssm + ((size_t)((l * 128 + b) * 4 + 0) * 128) * 128;
#pragma unroll
        for (int dd = 0; dd < 32; ++dd) sreg[dd] = Sin0[(part * 32 + dd) * 128 + e];
    }
    float xin[3], cv[3];
    xin[0] = bf2f(P1[r * 1024 + tid]); xin[1] = bf2f(P1[r * 1024 + 512 + tid]); xin[2] = bf2f(P2[r * 1024 + tid]);
#pragma unroll
    for (int k = 0; k < 3; ++k) {
        const int ch = tid + 512 * k;
        const float b0 = sc[ch], b1 = sc[1536 + ch], b2 = sc[3072 + ch];
        cv[k] = silu_f(b0 * cw[ch] + b1 * cw[1536 + ch] + b2 * cw[3072 + ch] + xin[k] * cw[4608 + ch]);
        oc[ch] = b1; oc[1536 + ch] = b2; oc[3072 + ch] = xin[k];
    }
    const float sq = wave_sum(cv[0] * cv[0]), sk = wave_sum(cv[1] * cv[1]);
    if (lane == 0) { RW[wid] = sq; RW[8 + wid] = sk; }
    __syncthreads();
    {
        const float ssq = RW[2 * hd] + RW[2 * hd + 1], ssk = RW[8 + 2 * hd] + RW[8 + 2 * hd + 1];
        SQ[tid] = cv[0] * rsqrtf(ssq + 1e-6f) * 0.08838834764831845f; SK[tid] = cv[1] * rsqrtf(ssk + 1e-6f); SV[tid] = cv[2];
    }
    __syncthreads();
#pragma unroll 1
    for (int hh = 0; hh < 4; ++hh) {
        const float eg = __expf(Gd[r * 4 + hh]), bt = Bd[r * 4 + hh];
        float* Sout = p.out + OSS + ((size_t)((l * 128 + b) * 4 + hh) * 128) * 128;
        float kvp = 0.f;
#pragma unroll
        for (int dd = 0; dd < 32; ++dd) { sreg[dd] *= eg; kvp += SK[hh * 128 + part * 32 + dd] * sreg[dd]; }
        RED[part * 128 + e] = kvp;
        __syncthreads();
        const float kv = RED[e] + RED[128 + e] + RED[256 + e] + RED[384 + e];
        const float delta = (SV[hh * 128 + e] - kv) * bt;
        float op = 0.f;
#pragma unroll
        for (int dd = 0; dd < 32; ++dd) { const int d = part * 32 + dd; const float sv = sreg[dd] + SK[hh * 128 + d] * delta; Sout[d * 128 + e] = sv; op += SQ[hh * 128 + d] * sv; }
        if (hh < 3) {
            const float* Sin = p.state_ssm + ((size_t)((l * 128 + b) * 4 + hh + 1) * 128) * 128;
#pragma unroll
            for (int dd = 0; dd < 32; ++dd) sreg[dd] = Sin[(part * 32 + dd) * 128 + e];
        }
        RED2[part * 128 + e] = op;
        __syncthreads();
        if (part == 0) SO[hh * 128 + e] = RED2[e] + RED2[128 + e] + RED2[256 + e] + RED2[384 + e];
    }
    __syncthreads();
    const float o = SO[tid];
    const float so = wave_sum(o * o);
    if (lane == 0) RW[16 + wid] = so;
    __syncthreads();
    {
        const float rstd = rsqrtf((RW[16 + 2 * hd] + RW[16 + 2 * hd + 1]) * (1.0f / 128.0f) + 1e-6f);
        const float zb = bf2f(P2[r * 1024 + 512 + tid]);
        YM[r * 1024 + 512 + tid] = f2bf(o * rstd * p.o_norm_w[l * 128 + e] * silu_f(zb));
    }
    __syncthreads();
}

__device__ __forceinline__ void phase_post(const Params& p, int l, LAS unsigned char* lds) {
    for (int idx = blockIdx.x; idx < 1024 + 512; idx += gridDim.x) {
        if (idx < 1024) { if (!(SKIP & 128)) chunk_item(p, l, idx, lds); }
        else { if (!(SKIP & 256)) pool_item(p, l, idx - 1024, lds); }
    }
}

struct ScanOps { bf16x8 aA[4]; bf16x8 kgA[2]; u32x4 x8[2]; float gl; };
__device__ __forceinline__ void scan_load(ScanOps& o, const Params& p, int ci, int m, int hi, int wid, int lr, int lq, int slice) {
    const bf16_t* Ad = (const bf16_t*)(p.ws + (hi ? WS_QG : WS_W)) + (size_t)ci * 8192;
    const bf16_t* KGTd = (const bf16_t*)(p.ws + WS_KGT) + (size_t)ci * 8192;
#pragma unroll
    for (int s = 0; s < 4; ++s) o.aA[s] = *(const bf16x8*)(Ad + (16 * m + lr) * 128 + 32 * s + 8 * lq);
#pragma unroll
    for (int s = 0; s < 2; ++s) o.kgA[s] = *(const bf16x8*)(KGTd + (16 * wid + lr) * 64 + 32 * s + 8 * lq);
    if (hi) {
        const bf16_t* QKd = (const bf16_t*)(p.ws + WS_QK) + (size_t)ci * 4096;
#pragma unroll
        for (int s = 0; s < 2; ++s) o.x8[s] = *(const u32x4*)(QKd + (16 * m + lr) * 64 + 32 * s + 8 * lq);
    } else {
        const float* Ud = (const float*)(p.ws + WS_U) + (size_t)ci * 8192;
#pragma unroll
        for (int nn = 0; nn < 2; ++nn)
#pragma unroll
            for (int r = 0; r < 4; ++r) o.x8[nn][r] = __float_as_uint(Ud[(16 * m + 4 * lq + r) * 128 + 32 * slice + 16 * nn + lr]);
    }
    o.gl = ((const float*)(p.ws + WS_GL))[ci];
}

__device__ __forceinline__ void scan_step(const ScanOps& c, const Params& p, int nc, int b, int h, int m, int hi, int wid, int lr, int lq, int slice, f32x4 (&Sacc)[2], LAS bf16_t* ST, LAS bf16_t* VT, float* Od) {
    f32x4 acc[2] = {{0.f, 0.f, 0.f, 0.f}, {0.f, 0.f, 0.f, 0.f}};
#pragma unroll
    for (int s = 0; s < 4; ++s)
#pragma unroll
        for (int nn = 0; nn < 2; ++nn) {
            const bf16x8 sb = *(const LAS bf16x8*)(ST + (16 * nn + lr) * 136 + 32 * s + 8 * lq);
            acc[nn] = __builtin_amdgcn_mfma_f32_16x16x32_bf16(c.aA[s], sb, acc[nn], 0, 0, 0);
        }
    if (!hi) {
#pragma unroll
        for (int nn = 0; nn < 2; ++nn) {
            u32x2 w; w.x = pk2(__uint_as_float(c.x8[nn][0]) - acc[nn][0], __uint_as_float(c.x8[nn][1]) - acc[nn][1]); w.y = pk2(__uint_as_float(c.x8[nn][2]) - acc[nn][2], __uint_as_float(c.x8[nn][3]) - acc[nn][3]);
            *(LAS u32x2*)(VT + (16 * nn + lr) * 72 + 16 * m + 4 * lq) = w;
        }
    }
    __syncthreads();
    bf16x8 vb[2][2];
#pragma unroll
    for (int nn = 0; nn < 2; ++nn)
#pragma unroll
        for (int s = 0; s < 2; ++s) vb[nn][s] = *(const LAS bf16x8*)(VT + (16 * nn + lr) * 72 + 32 * s + 8 * lq);
    if (hi) {
        const size_t R0 = (size_t)b * 2048 + nc * 64;
#pragma unroll
        for (int nn = 0; nn < 2; ++nn) {
#pragma unroll
            for (int s = 0; s < 2; ++s) { bf16x8 qa; u32x4 t = c.x8[s]; __builtin_memcpy(&qa, &t, 16); acc[nn] = __builtin_amdgcn_mfma_f32_16x16x32_bf16(qa, vb[nn][s], acc[nn], 0, 0, 0); }
#pragma unroll
            for (int r = 0; r < 4; ++r) Od[(R0 + 16 * m + 4 * lq + r) * 512 + h * 128 + 32 * slice + 16 * nn + lr] = acc[nn][r];
        }
    }
#pragma unroll
    for (int nn = 0; nn < 2; ++nn) {
        Sacc[nn] = Sacc[nn] * c.gl;
        Sacc[nn] = __builtin_amdgcn_mfma_f32_16x16x32_bf16(c.kgA[0], vb[nn][0], Sacc[nn], 0, 0, 0);
        Sacc[nn] = __builtin_amdgcn_mfma_f32_16x16x32_bf16(c.kgA[1], vb[nn][1], Sacc[nn], 0, 0, 0);
        u32x2 w; w.x = pk2(Sacc[nn][0], Sacc[nn][1]); w.y = pk2(Sacc[nn][2], Sacc[nn][3]);
        *(LAS u32x2*)(ST + (16 * nn + lr) * 136 + 16 * wid + 4 * lq) = w;
    }
    __syncthreads();
}

__device__ __forceinline__ void scan_item(const Params& p, int l, int bh, int slice, LAS unsigned char* lds) {
    const int tid = opq_tid(), wid = tid >> 6, lane = tid & 63, lr = lane & 15, lq = lane >> 4, m = wid & 3, hi = wid >> 2;
    const int b = bh >> 2, h = bh & 3;
    LAS bf16_t* ST = (LAS bf16_t*)lds;
    LAS bf16_t* VT = (LAS bf16_t*)(lds + 8704);
    float* Od = (float*)(p.ws + WS_P0);
    for (int i = tid; i < 32 * 136 / 2; i += 512) ((LAS unsigned*)ST)[i] = 0u;
    f32x4 Sacc[2] = {{0.f, 0.f, 0.f, 0.f}, {0.f, 0.f, 0.f, 0.f}};
    ScanOps st[4];
#pragma unroll
    for (int d = 0; d < 4; ++d) scan_load(st[d], p, bh * 32 + d, m, hi, wid, lr, lq, slice);
    __syncthreads();
#pragma unroll 1
    for (int nc0 = 0; nc0 < 32; nc0 += 4) {
#pragma unroll
        for (int d = 0; d < 4; ++d) {
            const int nc = nc0 + d;
            scan_step(st[d], p, nc, b, h, m, hi, wid, lr, lq, slice, Sacc, ST, VT, Od);
            const int nn = nc + 4 < 32 ? nc + 4 : 31;
            scan_load(st[d], p, bh * 32 + nn, m, hi, wid, lr, lq, slice);
        }
    }
    float* So = p.out + OSP + ((size_t)((l * 8 + b) * 4 + h) * 128) * 128;
#pragma unroll
    for (int nn = 0; nn < 2; ++nn)
#pragma unroll
        for (int r = 0; r < 4; ++r) So[(16 * wid + 4 * lq + r) * 128 + 32 * slice + 16 * nn + lr] = Sacc[nn][r];
}

__device__ __forceinline__ void phase_scan(const Params& p, int l, LAS unsigned char* lds) {
    const int G = (int)gridDim.x, nscan = G >= 256 ? 128 : G / 2;
    if ((int)blockIdx.x < nscan) {
        for (int blk = blockIdx.x; blk < 128; blk += nscan) {
            const int bh = (blk & 7) + 8 * (blk >> 5), slice = (blk >> 3) & 3;
            scan_item(p, l, bh, slice, lds);
            __syncthreads();
        }
    } else {
        for (int it = (int)blockIdx.x - nscan; it < 128 + 16; it += G - nscan) {
            if (it < 128) sample_item(p, l, it, lds); else sample_pool_item(p, l, it - 128, lds);
        }
    }
}

__device__ __forceinline__ void phase_onorm(const Params& p, int l) {
    const int tid = opq_tid(), wid = tid >> 6, lane = tid & 63;
    const float* Od = (const float*)(p.ws + WS_P0); const bf16_t* P2 = (const bf16_t*)(p.ws + WS_P2); bf16_t* YM = (bf16_t*)(p.ws + WS_H);
    const int c = lane * 8;
    const float4 w0 = *(const float4*)(p.o_norm_w + l * 128 + (c & 127)), w1 = *(const float4*)(p.o_norm_w + l * 128 + (c & 127) + 4);
    for (int row = blockIdx.x * 8 + wid; row < NP; row += gridDim.x * 8) {
        const float4 a = *(const float4*)(Od + (size_t)row * 512 + c), bq = *(const float4*)(Od + (size_t)row * 512 + c + 4);
        float ss = a.x * a.x + a.y * a.y + a.z * a.z + a.w * a.w + bq.x * bq.x + bq.y * bq.y + bq.z * bq.z + bq.w * bq.w;
        ss += __shfl_xor(ss, 1); ss += __shfl_xor(ss, 2); ss += __shfl_xor(ss, 4); ss += __shfl_xor(ss, 8);
        const float rstd = rsqrtf(ss * (1.0f / 128.0f) + 1e-6f);
        float z[8]; unpack8(*(const u32x4*)(P2 + (size_t)row * 1024 + 512 + c), z);
        float y[8];
        y[0] = a.x * rstd * w0.x * silu_f(z[0]); y[1] = a.y * rstd * w0.y * silu_f(z[1]); y[2] = a.z * rstd * w0.z * silu_f(z[2]); y[3] = a.w * rstd * w0.w * silu_f(z[3]);
        y[4] = bq.x * rstd * w1.x * silu_f(z[4]); y[5] = bq.y * rstd * w1.y * silu_f(z[5]); y[6] = bq.z * rstd * w1.z * silu_f(z[6]); y[7] = bq.w * rstd * w1.w * silu_f(z[7]);
        *(u32x4*)(YM + (size_t)row * 1024 + 512 + c) = pack8(y);
    }
}

__global__ void __launch_bounds__(512, 2) mk_fwd(Params p) {
    extern __shared__ __attribute__((aligned(16))) unsigned char shm[];
    LAS unsigned char* lds = (LAS unsigned char*)shm;
    cg::grid_group grid = cg::this_grid();
    volatile XLAS unsigned* xst = (volatile XLAS unsigned*)(lds + 131072);
    if (threadIdx.x == 0) { xst[0] = 0u; xst[1] = 0u; }
    __syncthreads();
    const XcdBarrier xb = xcd_barrier_post((unsigned*)(p.ws + WS_BAR), xst);
    if (p.ph_lo < 0) grid.sync();
    for (int ph = p.ph_lo; ph < p.ph_hi; ++ph) {
        if (ph == 0) { if (!(SKIP & 1)) phase_convert(p, lds); }
        else if (ph == 2) { if (!(SKIP & 2)) phase_rows(p, -1, 0, lds); }
        else {
            const int l = ph >= 3 ? (ph - 3) / 6 : 0, k = ph >= 3 ? (ph - 3) % 6 : -1;
            if (ph == 1 || k == 4) { if (!(SKIP & 4)) {
                pg8::Gemm g; pg8::EpiF32 E;
                if (ph == 1) { g.A = (const bf16_t*)(p.ws + WS_AC); g.Bt = (const bf16_t*)(p.ws + WS_WTADA); g.M = 256; g.N = 6144; g.K = 1024; E.C = (float*)(p.ws + WS_MOD); E.ldc = 6144; E.bias = p.b_ada; }
                else { g.A = (const bf16_t*)(p.ws + WS_H); g.Bt = (const bf16_t*)(p.ws + WS_WTOUT) + (size_t)l * 1024 * 1024; g.M = MPAD; g.N = 1024; g.K = 1024; E.C = (float*)(p.ws + WS_P0); E.ldc = 1024; E.bias = nullptr; }
                pg8::StaticOrder S; S.init(g.M, g.N, (int)gridDim.x, (int)blockIdx.x);
                pg8::gemm_phase<pg8::EpiF32, pg8::StaticOrder, false>(lds, g, S, E, nullptr); }
            } else if (k == 0) { if (!(SKIP & 8)) {
                pg8::Gemm g; g.A = (const bf16_t*)(p.ws + WS_H); g.Bt = (const bf16_t*)(p.ws + WS_WTIN) + (size_t)l * 3072 * 1024; g.M = MPAD; g.N = 3072; g.K = 1024;
                pg8::EpiBf16<0> E; E.O = (bf16_t*)(p.ws + WS_P0); E.ldc = 1024; E.bias = nullptr; E.split_cols = 1024; E.split_stride = (size_t)MPAD * 1024;
                pg8::StaticOrder S; S.init(g.M, g.N, (int)gridDim.x, (int)blockIdx.x);
                pg8::gemm_phase<pg8::EpiBf16<0>, pg8::StaticOrder, false>(lds, g, S, E, nullptr); }
            } else if (k == 1) { if (!(SKIP & 16)) phase_post(p, l, lds); }
            else if (k == 2) { if (!(SKIP & 32)) phase_scan(p, l, lds); }
            else if (k == 3) { if (!(SKIP & 64)) phase_onorm(p, l); }
            else if (k == 5) { if (!(SKIP & 2)) phase_rows(p, l, l + 1 < 2 ? l + 1 : -1, lds); }
        }
#ifdef PROBE_KIND
        {
            const int l2 = ph >= 3 ? (ph - 3) / 6 : 0, k2 = ph >= 3 ? (ph - 3) % 6 : -1;
            for (int rep = 0; rep < PROBE_N; ++rep) {
                if (PROBE_KIND == 6 && ph == 2) xcd_barrier(xb);
                if (PROBE_KIND == 1 && k2 == 1) phase_post(p, l2, lds);
                if (PROBE_KIND == 2 && k2 == 2) phase_scan(p, l2, lds);
                if (PROBE_KIND == 3 && k2 == 3) phase_onorm(p, l2);
                if (PROBE_KIND == 5 && ph == 2) phase_rows(p, -1, 0, lds);
            }
        }
#endif
        if (ph + 1 < p.ph_hi) xcd_barrier(xb);
    }
}

extern "C" void kernel_launch(void* const* d_in, const int* in_sizes, int n_in, void* d_out, int out_size, void* d_ws, size_t ws_size, hipStream_t stream) {
    static int grid = 0;
    if (grid == 0) {
        if (n_in != 19 || ws_size < WS_END) { fprintf(stderr, "kernel_launch: unexpected n_in %d or ws_size %zu (< %zu)\n", n_in, ws_size, (size_t)WS_END); grid = -1; return; }
        int dev = 0, cus = 0, per_cu = 0;
        hipGetDevice(&dev); hipDeviceGetAttribute(&cus, hipDeviceAttributeMultiprocessorCount, dev);
        if (hipFuncSetAttribute((const void*)mk_fwd, hipFuncAttributeMaxDynamicSharedMemorySize, LDS_BYTES) != hipSuccess) { fprintf(stderr, "kernel_launch: hipFuncSetAttribute failed\n"); }
        if (hipOccupancyMaxActiveBlocksPerMultiprocessor(&per_cu, (const void*)mk_fwd, 512, LDS_BYTES) != hipSuccess || per_cu < 1) per_cu = 1;
        (void)hipGetLastError();
        grid = cus * 1;
        if (grid <= 0) grid = 256;
    }
    if (grid < 0) return;
    if (hipMemsetAsync((char*)d_ws + WS_BAR, 0, 16384, stream) != hipSuccess) { fprintf(stderr, "kernel_launch: memset failed\n"); return; }
    Params p{};
    const float** f = (const float**)&p;
    for (int i = 0; i < 19; ++i) f[i] = (const float*)d_in[i];
    p.out = (float*)d_out; p.ws = (unsigned char*)d_ws; p.ph_lo = 0; p.ph_hi = 15;
    void* args[] = {&p};
    hipError_t e = hipLaunchCooperativeKernel((const void*)mk_fwd, dim3(grid), dim3(512), args, LDS_BYTES, stream);
    if (e != hipSuccess) fprintf(stderr, "cooperative launch failed: %s (grid %d)\n", hipGetErrorString(e), grid);
}
```

```cpp
#include <hip/hip_runtime.h>
#include <hip/hip_cooperative_groups.h>
#include <cstdio>
namespace cg = cooperative_groups;
__device__ __forceinline__ int opq_tid() { int t = (int)threadIdx.x; asm volatile("" : "+v"(t)); return t; }
namespace pg8 {
#define PG8_LAS __attribute__((address_space(3)))
typedef unsigned short bf16_t;
typedef short bf16x8 __attribute__((ext_vector_type(8)));
typedef float f32x4 __attribute__((ext_vector_type(4)));
typedef unsigned u32x4 __attribute__((ext_vector_type(4)));
constexpr int BM = 256, BK = 64, HALF = 128, HTB = HALF * BK * 2  , STAGE_BYTES = 8 * HTB, NXCD = 8, WGM = 8;

__host__ __device__ __forceinline__ int lds_byte(int r, int c) { const int st = (r >> 4) * 2 + (c >> 5), rr = r & 15, cc = c & 31, ob = rr * 64 + cc * 2; return st * 1024 + (ob ^ (((ob >> 9) & 1) << 5)); }
__host__ __device__ __forceinline__ void stage_rc(int b, int& R, int& C) { const int st = b / 1024, sb = b % 1024, swz = sb ^ (((sb >> 9) & 1) << 5); R = (st >> 1) * 16 + swz / 64; C = (st & 1) * 32 + (swz % 64) / 2; }
__host__ __device__ __forceinline__ int perm32(int rho) { const int n = rho >> 4, i = rho & 15; return 8 * (i >> 2) + 4 * n + (i & 3); }

struct Unit { int pm, pn; };
struct Gemm { const bf16_t* A; const bf16_t* Bt; int M, N, K; };
struct StaticOrder {
    int nM, nN, nwg, G, c;
    __host__ __device__ void init(int M, int N, int G_, int c_) { nM = M / BM; nN = N / BM; nwg = nM * nN; G = G_; c = c_; }
    __host__ __device__ bool next(int i, Unit& u) const {
        const long L = (long)i * G + c; if (L >= nwg) return false;
        int wgid = (int)L; { const int q = nwg / NXCD, r = nwg % NXCD, xcd = wgid % NXCD, off = wgid / NXCD; wgid = (xcd < r ? xcd * (q + 1) : r * (q + 1) + (xcd - r) * q) + off; }
        const int nig = WGM * nN, gid = wgid / nig, fm = gid * WGM, gsz = (nM - fm) < WGM ? (nM - fm) : WGM;
        u.pm = fm + ((wgid % nig) % gsz); u.pn = (wgid % nig) / gsz; return true;
    }
    __device__ __forceinline__ void a_ready(const Unit&) const {}
    __device__ __forceinline__ void done(const Unit&) const {}
};
__device__ __forceinline__ unsigned cvt_pk_bf16(float lo, float hi) { unsigned r; asm volatile("v_cvt_pk_bf16_f32 %0, %1, %2" : "=v"(r) : "v"(lo), "v"(hi)); return r; }
typedef float f32x2 __attribute__((ext_vector_type(2)));
__device__ __forceinline__ f32x2 gelu_pk(f32x2 v) {
    const f32x2 av = __builtin_elementwise_abs(v), d = av * 0.2316418882f + 1.0f;
    f32x2 t; t.x = __builtin_amdgcn_rcpf(d.x); t.y = __builtin_amdgcn_rcpf(d.y);
    f32x2 q = t * 0.5307027145f + (-0.7265760135f); q = q * t + 0.7107068705f; q = q * t + (-0.142248368f); q = q * t + 0.127414796f; q = q * t;
    const f32x2 s = (v * v) * (-0.72134752044f);
    f32x2 e; e.x = __builtin_amdgcn_exp2f(s.x); e.y = __builtin_amdgcn_exp2f(s.y);
    const f32x2 m = v * (q * e), r = v - m;
    f32x2 o; o.x = v.x < 0.f ? m.x : r.x; o.y = v.y < 0.f ? m.y : r.y; return o;
}

struct EpiF32 {
    static constexpr bool PERM = false, AFTER_DRAIN = false;
    float* C; int ldc; const float* bias;
    __device__ __forceinline__ void operator()(const f32x4 (&acc)[2][2][4][2], const Unit& u, int wr, int wc, int fr, int fq) const {
        const int row0 = u.pm * BM + wr * 64 + fr, col0 = u.pn * BM + wc * 32 + 4 * fq;
        f32x4 bv[2][2];
#pragma unroll
        for (int bj = 0; bj < 2; ++bj)
#pragma unroll
            for (int n = 0; n < 2; ++n) bv[bj][n] = bias ? *(const f32x4*)(bias + col0 + bj * HALF + n * 16) : (f32x4){0.f, 0.f, 0.f, 0.f};
#pragma unroll
        for (int ai = 0; ai < 2; ++ai)
#pragma unroll
            for (int m = 0; m < 4; ++m) { float* rowp = C + (size_t)(row0 + ai * HALF + m * 16) * ldc + col0;
#pragma unroll
                for (int bj = 0; bj < 2; ++bj)
#pragma unroll
                    for (int n = 0; n < 2; ++n) *(f32x4*)(rowp + bj * HALF + n * 16) = acc[ai][bj][m][n] + bv[bj][n]; }
    }
};
template <int ACT  > struct EpiBf16 {
    static constexpr bool PERM = true, AFTER_DRAIN = false;
    bf16_t* O; int ldc; const float* bias; int split_cols; size_t split_stride;
    __device__ __forceinline__ void operator()(const f32x4 (&acc)[2][2][4][2], const Unit& u, int wr, int wc, int fr, int fq) const {
        const int row0 = u.pm * BM + wr * 64 + fr; int colt = u.pn * BM; bf16_t* base = O;
        if (split_cols) { const int t = colt / split_cols; base += (size_t)t * split_stride; colt -= t * split_cols; }
        const int col0 = colt + wc * 32 + 8 * fq, bcol0 = u.pn * BM + wc * 32 + 8 * fq;
        f32x4 bv[2][2];
#pragma unroll
        for (int bj = 0; bj < 2; ++bj)
#pragma unroll
            for (int n = 0; n < 2; ++n) bv[bj][n] = bias ? *(const f32x4*)(bias + bcol0 + bj * HALF + 4 * n) : (f32x4){0.f, 0.f, 0.f, 0.f};
#pragma unroll
        for (int ai = 0; ai < 2; ++ai)
#pragma unroll
            for (int m = 0; m < 4; ++m) { bf16_t* rowp = base + (size_t)(row0 + ai * HALF + m * 16) * ldc + col0;
#pragma unroll
                for (int bj = 0; bj < 2; ++bj) { f32x4 v0 = acc[ai][bj][m][0] + bv[bj][0], v1 = acc[ai][bj][m][1] + bv[bj][1];
                    if (ACT == 1) { f32x2 a = gelu_pk((f32x2){v0[0], v0[1]}), b = gelu_pk((f32x2){v0[2], v0[3]}), c = gelu_pk((f32x2){v1[0], v1[1]}), d = gelu_pk((f32x2){v1[2], v1[3]});
                        v0 = (f32x4){a.x, a.y, b.x, b.y}; v1 = (f32x4){c.x, c.y, d.x, d.y}; }
                    if (ACT == 2) {
#pragma unroll
                        for (int j = 0; j < 4; ++j) { v0[j] = 0.5f * v0[j] * (1.0f + erff(v0[j] * 0.70710678f)); v1[j] = 0.5f * v1[j] * (1.0f + erff(v1[j] * 0.70710678f)); } }
                    u32x4 w; w.x = cvt_pk_bf16(v0[0], v0[1]); w.y = cvt_pk_bf16(v0[2], v0[3]); w.z = cvt_pk_bf16(v1[0], v1[1]); w.w = cvt_pk_bf16(v1[2], v1[3]);
                    *(u32x4*)(rowp + bj * HALF) = w; } }
    }
};
template <class Epi, class Sched, bool STAMP = false>
__device__ __forceinline__ void gemm_phase(PG8_LAS unsigned char* lds, const Gemm g, const Sched& S, const Epi& E, unsigned long long* stamps) {
    const int tid = opq_tid(), wid = __builtin_amdgcn_readfirstlane(tid >> 6), lane = tid & 63, wr = wid >> 2, wc = wid & 3, fr = lane & 15, fq = lane >> 4;
    const int K = g.K, nt = K / BK;
    int ts_lo = 0, ts_hi = 0, nts = 0; const unsigned long long rt_entry = STAMP ? (unsigned long long)wall_clock64() : 0ull;
#define PG8_STAMP() do { if (STAMP && wid == 0 && nts < 64) { const unsigned long long _c = (unsigned long long)clock64(); \
        ts_lo = (lane == nts) ? (int)(unsigned)_c : ts_lo; ts_hi = (lane == nts) ? (int)(unsigned)(_c >> 32) : ts_hi; ++nts; } } while (0)
    PG8_STAMP();
    unsigned voffA[2], voffB[2];
#pragma unroll
    for (int i = 0; i < 2; ++i) { int R, C; stage_rc(tid * 16 + i * 8192, R, C); const int Rb = Epi::PERM ? ((R & ~31) + perm32(R & 31)) : R;
        voffA[i] = (unsigned)(R * K + C) * 2u; voffB[i] = (unsigned)(Rb * K + C) * 2u; }
    const size_t kstep = (size_t)(BK * 2);
    const size_t hstep = (size_t)HALF * K * 2;
    const size_t tstep = 2 * hstep;
    const unsigned ldsw = (unsigned)wid * 1024u;
    const int aoff = lds_byte(wr * 64 + fr, fq * 8), boff = lds_byte(wc * 32 + fr, fq * 8);
#define PG8_SA(b, h) (((b) * 2 + (h)) * HTB)
#define PG8_SB(b, h) ((4 + (b) * 2 + (h)) * HTB)
#define PG8_STAGE(bufoff, gbase, voff) do { _Pragma("unroll") for (int _i = 0; _i < 2; ++_i) \
        __builtin_amdgcn_global_load_lds((const unsigned*)((const char*)(gbase) + (voff)[_i]), (PG8_LAS unsigned*)(lds + (bufoff) + ldsw + _i * 8192), 16, 0, 0); } while (0)
#define PG8_LDA(dst, b, h) do { _Pragma("unroll") for (int m = 0; m < 4; ++m) _Pragma("unroll") for (int k = 0; k < 2; ++k) dst[m][k] = *(const PG8_LAS bf16x8*)(lds + PG8_SA(b, h) + aoff + m * 2048 + k * 1024); } while (0)
#define PG8_LDB(dst, b, h) do { _Pragma("unroll") for (int n = 0; n < 2; ++n) _Pragma("unroll") for (int k = 0; k < 2; ++k) dst[n][k] = *(const PG8_LAS bf16x8*)(lds + PG8_SB(b, h) + boff + n * 2048 + k * 1024); } while (0)
#define PG8_MMA(ai, bj, At, Bt) do { __builtin_amdgcn_s_setprio(1); _Pragma("unroll") for (int m = 0; m < 4; ++m) _Pragma("unroll") for (int n = 0; n < 2; ++n) _Pragma("unroll") for (int k = 0; k < 2; ++k) \
        acc[ai][bj][m][n] = __builtin_amdgcn_mfma_f32_16x16x32_bf16(Bt[n][k], At[m][k], acc[ai][bj][m][n], 0, 0, 0); __builtin_amdgcn_s_setprio(0); } while (0)
#define PG8_WAIT_V(n) asm volatile("s_waitcnt vmcnt(" #n ")" ::: "memory")
#define PG8_WAIT_L(n) asm volatile("s_waitcnt lgkmcnt(" #n ")" ::: "memory")
#define PG8_BAR __builtin_amdgcn_s_barrier()
#define PG8_SCHED __builtin_amdgcn_sched_barrier(0)
    Unit cur, nxt; int ui = 0;
    if (!S.next(0, cur)) return;
    f32x4 acc[2][2][4][2];
#pragma unroll
    for (int a = 0; a < 2; ++a)
#pragma unroll
        for (int b = 0; b < 2; ++b)
#pragma unroll
            for (int m = 0; m < 4; ++m)
#pragma unroll
                for (int n = 0; n < 2; ++n) acc[a][b][m][n] = (f32x4){0.f, 0.f, 0.f, 0.f};
    bf16x8 At[4][2], B0[2][2], B1[2][2];
    const char* cA = (const char*)g.A + (size_t)cur.pm * tstep; const char* cB = (const char*)g.Bt + (size_t)cur.pn * tstep;
    S.a_ready(cur);
    PG8_STAGE(PG8_SB(0, 0), cB, voffB); PG8_STAGE(PG8_SA(0, 0), cA, voffA); PG8_STAGE(PG8_SB(0, 1), cB + hstep, voffB); PG8_STAGE(PG8_SA(0, 1), cA + hstep, voffA);
    if (wr == 1) PG8_BAR;
    PG8_WAIT_V(4); PG8_BAR;
    PG8_STAGE(PG8_SB(1, 0), cB + kstep, voffB); PG8_STAGE(PG8_SA(1, 0), cA + kstep, voffA); PG8_STAGE(PG8_SB(1, 1), cB + hstep + kstep, voffB);
    PG8_WAIT_V(6); PG8_BAR;
    PG8_STAMP();
    for (;;) {
        const bool has_next = S.next(ui + 1, nxt);
        const char* nA = has_next ? (const char*)g.A + (size_t)nxt.pm * tstep : cA; const char* nB = has_next ? (const char*)g.Bt + (size_t)nxt.pn * tstep : cB;
        for (int t = 0; t < nt; t += 2) {
            const bool last = (t == nt - 2);
            const char* a1 = cA + (size_t)(t + 1) * kstep;
            const char* a2 = last ? nA : cA + (size_t)(t + 2) * kstep; const char* b2 = last ? nB : cB + (size_t)(t + 2) * kstep;
            const char* a3 = a2 + kstep; const char* b3 = b2 + kstep;
            if (last && has_next) S.a_ready(nxt);
            PG8_LDB(B0, 0, 0); PG8_SCHED; PG8_LDA(At, 0, 0); PG8_STAGE(PG8_SA(1, 1), a1 + hstep, voffA);
            PG8_WAIT_L(8); PG8_BAR; PG8_WAIT_L(0); PG8_MMA(0, 0, At, B0); PG8_BAR; PG8_SCHED;
            PG8_LDB(B1, 0, 1); PG8_STAGE(PG8_SB(0, 0), b2, voffB);
            PG8_BAR; PG8_WAIT_L(0); PG8_MMA(0, 1, At, B1); PG8_BAR;
            PG8_LDA(At, 0, 1); PG8_STAGE(PG8_SA(0, 0), a2, voffA);
            PG8_BAR; PG8_WAIT_L(0); PG8_MMA(1, 0, At, B0); PG8_BAR; PG8_SCHED;
            PG8_STAGE(PG8_SB(0, 1), b2 + hstep, voffB);
            PG8_WAIT_V(6); PG8_BAR; PG8_MMA(1, 1, At, B1); PG8_BAR;
            PG8_LDB(B0, 1, 0); PG8_SCHED; PG8_LDA(At, 1, 0); PG8_STAGE(PG8_SA(0, 1), a2 + hstep, voffA);
            PG8_WAIT_L(8); PG8_BAR; PG8_WAIT_L(0); PG8_MMA(0, 0, At, B0); PG8_BAR; PG8_SCHED;
            PG8_LDB(B1, 1, 1); PG8_STAGE(PG8_SB(1, 0), b3, voffB);
            PG8_BAR; PG8_WAIT_L(0); PG8_MMA(0, 1, At, B1); PG8_BAR;
            PG8_LDA(At, 1, 1); PG8_STAGE(PG8_SA(1, 0), a3, voffA);
            PG8_BAR; PG8_WAIT_L(0); PG8_MMA(1, 0, At, B0); PG8_BAR; PG8_SCHED;
            PG8_STAGE(PG8_SB(1, 1), b3 + hstep, voffB);
            PG8_WAIT_V(6); PG8_BAR; PG8_MMA(1, 1, At, B1); PG8_BAR;
        }
        PG8_STAMP();
        if constexpr (!Epi::AFTER_DRAIN) { E(acc, cur, wr, wc, fr, fq); S.done(cur); }
        PG8_STAMP();
        if (!has_next) break;
#pragma unroll
        for (int a = 0; a < 2; ++a)
#pragma unroll
            for (int b = 0; b < 2; ++b)
#pragma unroll
                for (int m = 0; m < 4; ++m)
#pragma unroll
                    for (int n = 0; n < 2; ++n) acc[a][b][m][n] = (f32x4){0.f, 0.f, 0.f, 0.f};
        cur = nxt; cA = nA; cB = nB; ++ui;
    }
    PG8_WAIT_V(0);
    if (wr == 0) PG8_BAR;
    PG8_BAR;
    if constexpr (Epi::AFTER_DRAIN) { E.fused(acc, cur, wr, wc, fr, fq, lds, wid, lane); S.done(cur); }
    PG8_STAMP();
    if (STAMP && wid == 0) { stamps[lane] = lane < nts ? (((unsigned long long)(unsigned)ts_hi << 32) | (unsigned)ts_lo) : 0ull;
        if (lane == 62) stamps[62] = rt_entry; if (lane == 63) stamps[63] = (unsigned long long)wall_clock64(); }
#undef PG8_STAMP
#undef PG8_SA
#undef PG8_SB
#undef PG8_STAGE
#undef PG8_LDA
#undef PG8_LDB
#undef PG8_MMA
#undef PG8_WAIT_V
#undef PG8_WAIT_L
#undef PG8_BAR
#undef PG8_SCHED
}
}
#include <cstdint>
#include <cstdlib>
#include <vector>

#define XB_TMO      128
#define XB_XCNT(j)  (256  + 64 * (j))
#define XB_XSUB(j)  (1280 + 64 * (j))
#define XB_XGEN(j)  (2304 + 64 * (j))
#define XB_TOP      3328
#define XB_TOPGEN   3392
#define XCD_BAR_WORDS 3456
#define XB_SPIN_CAP (1u << 18)
#define XLAS __attribute__((address_space(3)))

__device__ __forceinline__ unsigned xb_ld(unsigned* p)              { return __hip_atomic_load(p, __ATOMIC_RELAXED, __HIP_MEMORY_SCOPE_AGENT); }
__device__ __forceinline__ unsigned xb_add(unsigned* p, unsigned v) { return __hip_atomic_fetch_add(p, v, __ATOMIC_RELAXED, __HIP_MEMORY_SCOPE_AGENT); }
__device__ __forceinline__ unsigned xb_xcc_id() { return (unsigned)__builtin_amdgcn_s_getreg((3 << 11) | 20) & 0xFu; }
#define XB_SPIN(cond, bar) do { unsigned _sp = 0; while (cond) { __builtin_amdgcn_s_sleep(1); \
    if ((++_sp & 255u) == 0u) { if (xb_ld(&(bar)[XB_TMO])) break; if (_sp > XB_SPIN_CAP) { atomicAdd(&(bar)[XB_TMO], 1u); break; } } } } while (0)

struct XcdBarrier {
    unsigned* bar; unsigned x;
    volatile XLAS unsigned* st;
};

__device__ __forceinline__ XcdBarrier xcd_barrier_post(unsigned* bar, volatile XLAS unsigned* st) {
    XcdBarrier b; b.bar = bar; b.x = xb_xcc_id(); b.st = st;
    if (threadIdx.x == 0) (void)xb_add(&bar[XB_XCNT(b.x)], 1u);
    return b;
}
__device__ __forceinline__ void xcd_barrier_complete(unsigned* bar, unsigned x, unsigned& nloc, unsigned& nx) {
    const unsigned G = gridDim.x * gridDim.y * gridDim.z;
    unsigned sum, cnt, mine, sp = 0u;
    for (;;) {
        sum = 0u; cnt = 0u; mine = 0u;
#pragma unroll
        for (unsigned j = 0; j < 16; ++j) { const unsigned c = xb_ld(&bar[XB_XCNT(j)]); sum += c; cnt += (c > 0u) ? 1u : 0u; mine = (j == x) ? c : mine; }
        if (sum == G) break;
        __builtin_amdgcn_s_sleep(1);
        if ((++sp & 255u) == 0u) { if (xb_ld(&bar[XB_TMO])) break; if (sp > XB_SPIN_CAP) { atomicAdd(&bar[XB_TMO], 1u); break; } }
    }
    nloc = mine > 0u ? mine : 1u; nx = cnt > 0u ? cnt : 1u;
}

__device__ __forceinline__ void xcd_barrier(const XcdBarrier& b) {
    asm volatile("s_waitcnt vmcnt(0)" ::: "memory");
    __syncthreads();
    if (threadIdx.x == 0) {
        unsigned* bar = b.bar;
        __builtin_amdgcn_s_waitcnt(0);
        unsigned nloc = b.st[0], nx = b.st[1];
        if (nloc == 0u) { xcd_barrier_complete(bar, b.x, nloc, nx); b.st[0] = nloc; b.st[1] = nx; }
        const unsigned old = xb_add(&bar[XB_XSUB(b.x)], 1u);
        const unsigned gen = old / nloc;
        if (old + 1u == (gen + 1u) * nloc) {
            __builtin_amdgcn_fence(__ATOMIC_RELEASE, "agent");
            asm volatile("s_waitcnt vmcnt(0)" ::: "memory");
            const unsigned og = xb_add(&bar[XB_TOP], 1u);
            const unsigned tg = og / nx;
            if (og + 1u == (tg + 1u) * nx) xb_add(&bar[XB_TOPGEN], 1u);
            else XB_SPIN(xb_ld(&bar[XB_TOPGEN]) == tg, bar);
            __builtin_amdgcn_fence(__ATOMIC_ACQUIRE, "agent");
            xb_add(&bar[XB_XGEN(b.x)], 1u);
            asm volatile("s_waitcnt vmcnt(0)" ::: "memory");
        } else {
            XB_SPIN(xb_ld(&bar[XB_XGEN(b.x)]) == gen, bar);
            __builtin_amdgcn_fence(__ATOMIC_ACQUIRE, "agent");
            asm volatile("s_waitcnt vmcnt(0)" ::: "memory");
        }
    }
    __syncthreads();
}

#ifndef SKIP
#define SKIP 0
#endif
#ifndef PROBE_KIND
#define PROBE_KIND 0
#define PROBE_N 0
#endif
#define LAS PG8_LAS
typedef pg8::bf16_t bf16_t;
typedef pg8::bf16x8 bf16x8;
typedef pg8::f32x4 f32x4;
typedef pg8::u32x4 u32x4;
typedef unsigned u32x2 __attribute__((ext_vector_type(2)));
constexpr int NP = 16384, NS = 128, NR = NP + NS, MPAD = 16640, DM = 1024, DIN = 3080;
constexpr int LDS_BYTES = 131072 + 16;
constexpr size_t OYS = 16777216, OPP = 16908288, OCP = 17031168, OSP = 17104896, OPS = 18153472, OCS = 20119552, OSS = 21299200;
constexpr size_t WS_WTIN = 0;
constexpr size_t WS_WTOUT = WS_WTIN + 12582912;
constexpr size_t WS_WTPOOL = WS_WTOUT + 4194304;
constexpr size_t WS_MOD = WS_WTPOOL + 262144;
constexpr size_t WS_H = WS_MOD + 6291456;
constexpr size_t WS_P0 = WS_H + 34078720;
constexpr size_t WS_P1 = WS_P0 + 34078720;
constexpr size_t WS_P2 = WS_P1 + 34078720;
constexpr size_t WS_G = WS_P2 + 34078720;
constexpr size_t WS_BETA = WS_G + 264192;
constexpr size_t WS_GL = WS_BETA + 264192;
constexpr size_t WS_W = WS_GL + 4096;
constexpr size_t WS_QG = WS_W + 16777216;
constexpr size_t WS_KGT = WS_QG + 16777216;
constexpr size_t WS_QK = WS_KGT + 16777216;
constexpr size_t WS_U = WS_QK + 8388608;
constexpr size_t WS_WTADA = WS_U;
constexpr size_t WS_AC = WS_U + 12582912;
constexpr size_t WS_BAR = WS_U + 33554432;
constexpr size_t WS_END = WS_BAR + 16384;

struct Params {
    const float* x_prompt; const float* x_sample; const float* c_prompt; const float* c_sample;
    const float* state_pool; const float* state_conv; const float* state_ssm;
    const float* w_ada; const float* b_ada; const float* pre_norm_w; const float* post_norm_w; const float* w_in; const float* conv_w;
    const float* pool_w; const float* pool_scale; const float* a_log; const float* dt_bias; const float* o_norm_w; const float* w_out;
    float* out; unsigned char* ws; int ph_lo, ph_hi;
};

__device__ __forceinline__ float bf2f(unsigned short b) { return __uint_as_float(((unsigned)b) << 16); }
typedef __bf16 bf16x2_t __attribute__((ext_vector_type(2)));
typedef float f32x2_t __attribute__((ext_vector_type(2)));
__device__ __forceinline__ unsigned pk2(float lo, float hi) { f32x2_t v = {lo, hi}; bf16x2_t r = __builtin_convertvector(v, bf16x2_t); unsigned u; __builtin_memcpy(&u, &r, 4); return u; }
__device__ __forceinline__ unsigned short f2bf(float f) { return (unsigned short)(pk2(f, 0.f) & 0xffffu); }
__device__ __forceinline__ float silu_f(float x) { return x * __builtin_amdgcn_rcpf(1.0f + __expf(-x)); }
__device__ __forceinline__ void unpack8(const u32x4 v, float* x) {
    x[0] = __uint_as_float(v.x << 16); x[1] = __uint_as_float(v.x & 0xffff0000u); x[2] = __uint_as_float(v.y << 16); x[3] = __uint_as_float(v.y & 0xffff0000u);
    x[4] = __uint_as_float(v.z << 16); x[5] = __uint_as_float(v.z & 0xffff0000u); x[6] = __uint_as_float(v.w << 16); x[7] = __uint_as_float(v.w & 0xffff0000u);
}
__device__ __forceinline__ u32x4 pack8(const float* x) { u32x4 w; w.x = pk2(x[0], x[1]); w.y = pk2(x[2], x[3]); w.z = pk2(x[4], x[5]); w.w = pk2(x[6], x[7]); return w; }
__device__ __forceinline__ float wave_sum(float v) {
#pragma unroll
    for (int o = 32; o >= 1; o >>= 1) v += __shfl_xor(v, o);
    return v;
}

__device__ __forceinline__ void transpose_tile(const float* __restrict__ src, int ld, bf16_t* __restrict__ dst, int ldd, int k0, int n0, LAS float* tile) {
    const int tid = opq_tid();
#pragma unroll
    for (int p = 0; p < 2; ++p) {
        const int kk = (tid >> 4) + 32 * p, n4 = (tid & 15) * 4;
        const float4 v = *(const float4*)(src + (size_t)(k0 + kk) * ld + n0 + n4);
        tile[kk * 65 + n4 + 0] = v.x; tile[kk * 65 + n4 + 1] = v.y; tile[kk * 65 + n4 + 2] = v.z; tile[kk * 65 + n4 + 3] = v.w;
    }
    __syncthreads();
    const int n = tid >> 3, k8 = (tid & 7) * 8;
    float x[8];
#pragma unroll
    for (int i = 0; i < 8; ++i) x[i] = tile[(k8 + i) * 65 + n];
    *(u32x4*)(dst + (size_t)(n0 + n) * ldd + k0 + k8) = pack8(x);
    __syncthreads();
}

__device__ __forceinline__ void phase_convert(const Params& p, LAS unsigned char* lds) {
    LAS float* tile = (LAS float*)lds;
    bf16_t* WtIn = (bf16_t*)(p.ws + WS_WTIN); bf16_t* WtAda = (bf16_t*)(p.ws + WS_WTADA); bf16_t* WtOut = (bf16_t*)(p.ws + WS_WTOUT); bf16_t* WtPool = (bf16_t*)(p.ws + WS_WTPOOL);
    for (int t = blockIdx.x; t < 3616; t += gridDim.x) {
        if (t < 1536) { const int l = t / 768, rem = t % 768; transpose_tile(p.w_in + (size_t)l * 1024 * DIN, DIN, WtIn + (size_t)l * 3072 * 1024, 1024, (rem / 48) * 64, (rem % 48) * 64, tile); }
        else if (t < 3072) { const int tt = t - 1536, l = tt / 768, rem = tt % 768; transpose_tile(p.w_ada + (size_t)l * 1024 * 3072, 3072, WtAda + (size_t)l * 3072 * 1024, 1024, (rem / 48) * 64, (rem % 48) * 64, tile); }
        else if (t < 3584) { const int tt = t - 3072, l = tt / 256, rem = tt % 256; transpose_tile(p.w_out + (size_t)l * 1024 * 1024, 1024, WtOut + (size_t)l * 1024 * 1024, 1024, (rem / 16) * 64, (rem % 16) * 64, tile); }
        else { const int tt = t - 3584, lg = tt / 4, rem = tt % 4; transpose_tile(p.pool_w + (size_t)lg * 16384, 128, WtPool + (size_t)lg * 16384, 128, (rem / 2) * 64, (rem % 2) * 64, tile); }
    }
    bf16_t* Ac = (bf16_t*)(p.ws + WS_AC);
    for (int i = blockIdx.x * 512 + opq_tid(); i < 65536; i += gridDim.x * 512) {
        const int row = i >> 8, c4 = (i & 255) * 4;
        float4 v = make_float4(0.f, 0.f, 0.f, 0.f);
        if (row < 8) v = *(const float4*)(p.c_prompt + row * 1024 + c4); else if (row < 136) v = *(const float4*)(p.c_sample + (row - 8) * 1024 + c4);
        uint2 w; w.x = pk2(silu_f(v.x), silu_f(v.y)); w.y = pk2(silu_f(v.z), silu_f(v.w));
        *(uint2*)(Ac + row * 1024 + c4) = w;
    }
}

__device__ __forceinline__ void phase_rows(const Params& p, int lF, int lA, LAS unsigned char* lds) {
    const int tid = opq_tid(), wid = tid >> 6, lane = tid & 63;
    LAS float* W8t = (LAS float*)lds;
    const float* mod = (const float*)(p.ws + WS_MOD);
    const float* Y = (const float*)(p.ws + WS_P0);
    bf16_t* H = (bf16_t*)(p.ws + WS_H);
    float* Gd = (float*)(p.ws + WS_G); float* Bd = (float*)(p.ws + WS_BETA);
    if (lA >= 0) {
        for (int i = tid; i < 8192; i += 512) { const int k = i >> 3, j = i & 7; W8t[j * 1024 + k] = p.w_in[(size_t)lA * 1024 * DIN + (size_t)k * DIN + 3072 + j]; }
        __syncthreads();
    }
    for (int row = blockIdx.x * 8 + wid; row < NR; row += gridDim.x * 8) {
        const int mrow = row < NP ? (row >> 11) : (8 + row - NP);
        const float* xorig = row < NP ? p.x_prompt + (size_t)row * 1024 : p.x_sample + (size_t)(row - NP) * 1024;
        float* xout = p.out + (size_t)row * 1024;
        float4 xv[4];
        if (lF >= 0) {
            const float* yrow = Y + (size_t)row * 1024; const float* mF = mod + (size_t)mrow * 6144 + lF * 3072 + 2048;
            const float* xsrc = (lF == 0) ? xorig : xout;
            float4 yv[4]; float ss = 0.f;
#pragma unroll
            for (int i = 0; i < 4; ++i) { yv[i] = *(const float4*)(yrow + lane * 4 + 256 * i); ss += yv[i].x * yv[i].x + yv[i].y * yv[i].y + yv[i].z * yv[i].z + yv[i].w * yv[i].w; }
            ss = wave_sum(ss);
            const float rstd = rsqrtf(ss * (1.0f / 1024.0f) + 1e-6f);
#pragma unroll
            for (int i = 0; i < 4; ++i) {
                const int c = lane * 4 + 256 * i;
                const float4 gt = *(const float4*)(mF + c), pw = *(const float4*)(p.post_norm_w + lF * 1024 + c), xi = *(const float4*)(xsrc + c);
                xv[i].x = xi.x + gt.x * (yv[i].x * rstd * pw.x); xv[i].y = xi.y + gt.y * (yv[i].y * rstd * pw.y);
                xv[i].z = xi.z + gt.z * (yv[i].z * rstd * pw.z); xv[i].w = xi.w + gt.w * (yv[i].w * rstd * pw.w);
                *(float4*)(xout + c) = xv[i];
            }
        } else {
#pragma unroll
            for (int i = 0; i < 4; ++i) xv[i] = *(const float4*)(xorig + lane * 4 + 256 * i);
        }
        if (lA >= 0) {
            float ss = 0.f;
#pragma unroll
            for (int i = 0; i < 4; ++i) ss += xv[i].x * xv[i].x + xv[i].y * xv[i].y + xv[i].z * xv[i].z + xv[i].w * xv[i].w;
            ss = wave_sum(ss);
            const float rstd = rsqrtf(ss * (1.0f / 1024.0f) + 1e-6f);
            const float* mA = mod + (size_t)mrow * 6144 + lA * 3072;
            float d[8];
#pragma unroll
            for (int j = 0; j < 8; ++j) d[j] = 0.f;
#pragma unroll
            for (int i = 0; i < 4; ++i) {
                const int c = lane * 4 + 256 * i;
                const float4 sh = *(const float4*)(mA + c), sc = *(const float4*)(mA + 1024 + c), pw = *(const float4*)(p.pre_norm_w + lA * 1024 + c);
                float4 hv;
                hv.x = xv[i].x * rstd * pw.x * (1.0f + sc.x) + sh.x; hv.y = xv[i].y * rstd * pw.y * (1.0f + sc.y) + sh.y;
                hv.z = xv[i].z * rstd * pw.z * (1.0f + sc.z) + sh.z; hv.w = xv[i].w * rstd * pw.w * (1.0f + sc.w) + sh.w;
                uint2 w; w.x = pk2(hv.x, hv.y); w.y = pk2(hv.z, hv.w);
                *(uint2*)(H + (size_t)row * 1024 + c) = w;
#pragma unroll
                for (int j = 0; j < 8; ++j) { const f32x4 wv = *(const LAS f32x4*)(W8t + j * 1024 + c); d[j] += hv.x * wv[0] + hv.y * wv[1] + hv.z * wv[2] + hv.w * wv[3]; }
            }
#pragma unroll
            for (int j = 0; j < 8; ++j) d[j] = wave_sum(d[j]);
            if (lane < 4) {
                const float br = lane == 0 ? d[0] : lane == 1 ? d[1] : lane == 2 ? d[2] : d[3];
                const float ar = lane == 0 ? d[4] : lane == 1 ? d[5] : lane == 2 ? d[6] : d[7];
                const float xs = ar + p.dt_bias[lA * 4 + lane];
                const float sp = fmaxf(xs, 0.f) + log1pf(__expf(-fabsf(xs)));
                Bd[row * 4 + lane] = 1.0f / (1.0f + __expf(-br));
                Gd[row * 4 + lane] = -__expf(p.a_log[lA * 4 + lane]) * sp;
            }
        }
    }
}

__device__ __forceinline__ void conv16(const u32x4 (&xr)[4][2], int tok, const LAS float* cw, float* out, float* xcur) {
    float acc[16];
#pragma unroll
    for (int i = 0; i < 16; ++i) acc[i] = 0.f;
#pragma unroll
    for (int j = 0; j < 4; ++j) {
        const bool valid = (tok - 3 + j) >= 0;
        float x[16]; unpack8(xr[j][0], x); unpack8(xr[j][1], x + 8);
#pragma unroll
        for (int q = 0; q < 4; ++q) {
            const f32x4 w = *(const LAS f32x4*)(cw + j * 128 + 4 * q);
            const float x0 = valid ? x[4 * q] : 0.f, x1 = valid ? x[4 * q + 1] : 0.f, x2 = valid ? x[4 * q + 2] : 0.f, x3 = valid ? x[4 * q + 3] : 0.f;
            acc[4 * q] += x0 * w[0]; acc[4 * q + 1] += x1 * w[1]; acc[4 * q + 2] += x2 * w[2]; acc[4 * q + 3] += x3 * w[3];
        }
        if (j == 3) {
#pragma unroll
            for (int i = 0; i < 16; ++i) xcur[i] = x[i];
        }
    }
#pragma unroll
    for (int i = 0; i < 16; ++i) out[i] = silu_f(acc[i]);
}

template <int STOP> __device__ __forceinline__ void chunk_item(const Params& p, int l, int idx, LAS unsigned char* lds) {
    const int tid = opq_tid(), wid = tid >> 6, lane = tid & 63;
    const int b = idx >> 7, h = (idx >> 5) & 3, n = idx & 31, R0 = b * 2048 + n * 64;
    LAS bf16_t* KB = (LAS bf16_t*)lds; LAS bf16_t* QB = (LAS bf16_t*)(lds + 17408);
    LAS float* AT = (LAS float*)(lds + 34816); LAS float* RHS = (LAS float*)(lds + 51200);
    LAS float* GC = (LAS float*)(lds + 116736); LAS float* BT = GC + 64; LAS float* EG = GC + 128;
    const float* Gd = (const float*)(p.ws + WS_G); const float* Bd = (const float*)(p.ws + WS_BETA);
    const bf16_t* P1 = (const bf16_t*)(p.ws + WS_P1); const bf16_t* P2 = (const bf16_t*)(p.ws + WS_P2);
    bf16_t* Wd = (bf16_t*)(p.ws + WS_W) + (size_t)idx * 8192; bf16_t* QGd = (bf16_t*)(p.ws + WS_QG) + (size_t)idx * 8192;
    bf16_t* KGTd = (bf16_t*)(p.ws + WS_KGT) + (size_t)idx * 8192; bf16_t* QKd = (bf16_t*)(p.ws + WS_QK) + (size_t)idx * 4096;
    float* Ud = (float*)(p.ws + WS_U) + (size_t)idx * 8192; float* GLd = (float*)(p.ws + WS_GL);
    const int et = tid >> 3, ec0 = (tid & 7) * 16, etok = n * 64 + et;
    u32x4 xr[3][4][2];
#pragma unroll
    for (int a = 0; a < 3; ++a) {
        const bf16_t* base = (a == 0 ? P1 + h * 128 : a == 1 ? P1 + 512 + h * 128 : P2 + h * 128) + ec0;
#pragma unroll
        for (int j = 0; j < 4; ++j) {
            const int tj = etok - 3 + j, tjc = tj < 0 ? 0 : tj;
            const bf16_t* ptr = base + (size_t)(b * 2048 + tjc) * 1024;
            xr[a][j][0] = *(const u32x4*)ptr; xr[a][j][1] = *(const u32x4*)(ptr + 8);
        }
    }
    LAS float* CW = (LAS float*)(lds + 117504);
    if (tid >= 128) { const int ci = tid - 128, a = ci >> 7, d = ci & 127;
#pragma unroll
        for (int j = 0; j < 4; ++j) CW[(a * 4 + j) * 128 + d] = p.conv_w[(size_t)l * 4 * 1536 + j * 1536 + a * 512 + h * 128 + d]; }
    if (tid < 64) {
        float v = Gd[(R0 + tid) * 4 + h];
#pragma unroll
        for (int o = 1; o < 64; o <<= 1) { const float t = __shfl_up(v, o); if (lane >= o) v += t; }
        GC[tid] = v; BT[tid] = Bd[(R0 + tid) * 4 + h]; const float e = __expf(v); EG[tid] = e;
        if (tid == 63) GLd[idx] = e;
    }
    __syncthreads();
    if (STOP == 1) { if (xr[0][0][0][0] == 0x12345u && xr[2][3][1][3] == 0x54321u) GLd[idx] = 0.f; return; }
    {
        const int t = et, c0 = ec0, tok = etok;
        const float bt = BT[t], eg = EG[t];
        float s[16], xc[16];
        conv16(xr[0], tok, CW + c0, s, xc);
        if (n == 31 && t >= 61) { float* o = p.out + OCP + ((size_t)(l * 8 + b) * 3 + (t - 61)) * 1536 + h * 128 + c0;
#pragma unroll
            for (int i = 0; i < 16; ++i) o[i] = xc[i]; }
        float ss = 0.f;
#pragma unroll
        for (int i = 0; i < 16; ++i) ss += s[i] * s[i];
        ss += __shfl_xor(ss, 1); ss += __shfl_xor(ss, 2); ss += __shfl_xor(ss, 4);
        float rs = rsqrtf(ss + 1e-6f) * 0.08838834764831845f;
        float qn[16];
#pragma unroll
        for (int i = 0; i < 16; ++i) qn[i] = s[i] * rs;
        *(LAS u32x4*)(QB + t * 136 + c0) = pack8(qn); *(LAS u32x4*)(QB + t * 136 + c0 + 8) = pack8(qn + 8);
#pragma unroll
        for (int i = 0; i < 16; ++i) qn[i] *= eg;
        *(u32x4*)(QGd + (((((t >> 4) * 4 + (c0 >> 5)) * 4 + ((c0 >> 3) & 3)) * 16 + (t & 15)) * 8)) = pack8(qn);
        *(u32x4*)(QGd + (((((t >> 4) * 4 + ((c0 + 8) >> 5)) * 4 + (((c0 + 8) >> 3) & 3)) * 16 + (t & 15)) * 8)) = pack8(qn + 8);
        conv16(xr[1], tok, CW + 512 + c0, s, xc);
        if (n == 31 && t >= 61) { float* o = p.out + OCP + ((size_t)(l * 8 + b) * 3 + (t - 61)) * 1536 + 512 + h * 128 + c0;
#pragma unroll
            for (int i = 0; i < 16; ++i) o[i] = xc[i]; }
        ss = 0.f;
#pragma unroll
        for (int i = 0; i < 16; ++i) ss += s[i] * s[i];
        ss += __shfl_xor(ss, 1); ss += __shfl_xor(ss, 2); ss += __shfl_xor(ss, 4);
        rs = rsqrtf(ss + 1e-6f);
#pragma unroll
        for (int i = 0; i < 16; ++i) s[i] *= rs;
        *(LAS u32x4*)(KB + t * 136 + c0) = pack8(s); *(LAS u32x4*)(KB + t * 136 + c0 + 8) = pack8(s + 8);
        const float be = bt * eg;
#pragma unroll
        for (int i = 0; i < 16; i += 4) *(LAS f32x4*)(RHS + t * 256 + 128 + c0 + i) = (f32x4){s[i] * be, s[i + 1] * be, s[i + 2] * be, s[i + 3] * be};
        conv16(xr[2], tok, CW + 1024 + c0, s, xc);
        if (n == 31 && t >= 61) { float* o = p.out + OCP + ((size_t)(l * 8 + b) * 3 + (t - 61)) * 1536 + 1024 + h * 128 + c0;
#pragma unroll
            for (int i = 0; i < 16; ++i) o[i] = xc[i]; }
#pragma unroll
        for (int i = 0; i < 16; i += 4) *(LAS f32x4*)(RHS + t * 256 + c0 + i) = (f32x4){s[i] * bt, s[i + 1] * bt, s[i + 2] * bt, s[i + 3] * bt};
    }
    __syncthreads();
    if (STOP == 2) return;
    {
        const int lr = lane & 15, lq = lane >> 4;
#pragma unroll 1
        for (int jj = 0; jj < 4; ++jj) {
            const int job = wid * 4 + jj, which = job >> 4, tile = job & 15, mi = tile >> 2, nj = tile & 3;
            LAS bf16_t* As = which ? QB : KB;
            f32x4 acc = {0.f, 0.f, 0.f, 0.f};
            if (!which) {
#pragma unroll
                for (int s = 0; s < 4; ++s) {
                    const bf16x8 a = *(const LAS bf16x8*)(As + (16 * mi + lr) * 136 + 32 * s + 8 * lq);
                    const bf16x8 bb = *(const LAS bf16x8*)(KB + (16 * nj + lr) * 136 + 32 * s + 8 * lq);
                    acc = __builtin_amdgcn_mfma_f32_16x16x32_bf16(a, bb, acc, 0, 0, 0);
                }
                const int j = 16 * nj + lr, i0 = 16 * mi + 4 * lq;
                const float gj = GC[j];
                f32x4 o;
#pragma unroll
                for (int r = 0; r < 4; ++r) { const int i = i0 + r; o[r] = (i > j) ? BT[i] * acc[r] * __expf(GC[i] - gj) : 0.f; }
                *(LAS f32x4*)(AT + j * 64 + i0) = o;
            } else {
#pragma unroll
                for (int s = 0; s < 4; ++s) {
                    const bf16x8 a = *(const LAS bf16x8*)(As + (16 * mi + lr) * 136 + 32 * s + 8 * lq);
                    const bf16x8 bb = *(const LAS bf16x8*)(KB + (16 * nj + lr) * 136 + 32 * s + 8 * lq);
                    acc = __builtin_amdgcn_mfma_f32_16x16x32_bf16(bb, a, acc, 0, 0, 0);
                }
                const int i = 16 * mi + lr, j0 = 16 * nj + 4 * lq;
                const float gi = GC[i];
                float v[4];
#pragma unroll
                for (int r = 0; r < 4; ++r) { const int j = j0 + r; v[r] = (i >= j) ? acc[r] * __expf(gi - GC[j]) : 0.f; }
                u32x2 w; w.x = pk2(v[0], v[1]); w.y = pk2(v[2], v[3]);
                *(u32x2*)(QKd + ((((mi * 2 + (j0 >> 5)) * 4 + ((j0 >> 3) & 3)) * 16 + lr) * 8 + (j0 & 7))) = w;
            }
        }
    }
    __syncthreads();
    if (STOP == 3) return;
    if (tid < 256) {
        const int c = tid;
        float r[64];
#pragma unroll
        for (int i = 0; i < 64; ++i) r[i] = RHS[i * 256 + c];
#pragma unroll
        for (int j = 0; j < 63; ++j) {
            const float xj = r[j];
#pragma unroll
            for (int i4 = ((j + 1) & ~3); i4 < 64; i4 += 4) {
                const f32x4 a = *(const LAS f32x4*)(AT + j * 64 + i4);
                r[i4 + 0] -= a[0] * xj; r[i4 + 1] -= a[1] * xj; r[i4 + 2] -= a[2] * xj; r[i4 + 3] -= a[3] * xj;
            }
        }
#pragma unroll
        for (int i = 0; i < 64; ++i) RHS[i * 256 + c] = r[i];
    } else {
        const int d = (tid - 256) >> 1, th = tid & 1;
        const float gcl = GC[63];
        float x[32];
#pragma unroll
        for (int i = 0; i < 32; ++i) { const int t = 32 * th + i; x[i] = bf2f(KB[t * 136 + d]) * __expf(gcl - GC[t]); }
#pragma unroll
        for (int q = 0; q < 4; ++q) *(u32x4*)(KGTd + (((((d >> 4) * 2 + th) * 4 + q) * 16 + (d & 15)) * 8)) = pack8(x + 8 * q);
    }
    __syncthreads();
    {
#pragma unroll
        for (int k = 0; k < 4; ++k) {
            const int pi = tid + 512 * k, nn = pi & 1, ulr = (pi >> 1) & 15, ulq = (pi >> 5) & 3, um = (pi >> 7) & 3, usl = pi >> 9;
            const int row = 16 * um + 4 * ulq, col = 32 * usl + 16 * nn + ulr;
            *(f32x4*)(Ud + pi * 4) = (f32x4){RHS[row * 256 + col], RHS[(row + 1) * 256 + col], RHS[(row + 2) * 256 + col], RHS[(row + 3) * 256 + col]};
        }
#pragma unroll
        for (int k = 0; k < 2; ++k) {
            const int pw = tid + 512 * k, wl = pw & 63, wms = pw >> 6, row = 16 * (wms >> 2) + (wl & 15), c8 = 32 * (wms & 3) + 8 * (wl >> 4);
            const f32x4 v0 = *(const LAS f32x4*)(RHS + row * 256 + 128 + c8), v1 = *(const LAS f32x4*)(RHS + row * 256 + 128 + c8 + 4);
            u32x4 w; w.x = pk2(v0[0], v0[1]); w.y = pk2(v0[2], v0[3]); w.z = pk2(v1[0], v1[1]); w.w = pk2(v1[2], v1[3]);
            *(u32x4*)(Wd + pw * 8) = w;
        }
    }
    __syncthreads();
}

__device__ __forceinline__ void pool_item(const Params& p, int l, int pidx, LAS unsigned char* lds) {
    const int tid = opq_tid(), wid = tid >> 6, lane = tid & 63;
    const int g = pidx & 3, T = pidx >> 2, w = 2 << g;
    const int rowbase = T * 128, b = rowbase >> 11, t0 = rowbase & 2047;
    LAS bf16_t* UT = (LAS bf16_t*)lds; LAS bf16_t* PB = (LAS bf16_t*)(lds + 38912); LAS bf16_t* WB = (LAS bf16_t*)(lds + 73728);
    const bf16_t* P0 = (const bf16_t*)(p.ws + WS_P0);
    const bf16_t* WtPool = (const bf16_t*)(p.ws + WS_WTPOOL) + (size_t)(l * 4 + g) * 16384;
    bf16_t* YM = (bf16_t*)(p.ws + WS_H);
#pragma unroll
    for (int q = 0; q < 4; ++q) { const int piece = tid + 512 * q, d = piece >> 4, k8 = (piece & 15) * 8; *(LAS u32x4*)(WB + d * 136 + k8) = *(const u32x4*)(WtPool + d * 128 + k8); }
#pragma unroll
    for (int q = 0; q < 5; ++q) {
        const int piece = tid + 512 * q;
        if (piece < 143 * 16) {
            const int rr = piece >> 4, c8 = (piece & 15) * 8, tok = t0 - 15 + rr;
            u32x4 v = *(const u32x4*)(P0 + (size_t)(b * 2048 + (tok < 0 ? 0 : tok)) * 1024 + g * 128 + c8);
            if (tok < 0) v = (u32x4){0u, 0u, 0u, 0u};
            *(LAS u32x4*)(UT + rr * 136 + c8) = v;
        }
    }
    __syncthreads();
    {
        const int c = tid & 127, q = tid >> 7, i0 = 32 * q;
        float s = 0.f;
        for (int j = 1; j < w; ++j) s += bf2f(UT[(i0 + 15 - j) * 136 + c]);
#pragma unroll 4
        for (int i = i0; i < i0 + 32; ++i) {
            const float cur = bf2f(UT[(i + 15) * 136 + c]);
            s += cur;
            const int tk = t0 + i + 1; const float cnt = (float)(tk < w ? tk : w);
            PB[i * 136 + c] = f2bf(s * __builtin_amdgcn_rcpf(cnt) - cur);
            s -= bf2f(UT[(i + 15 - (w - 1)) * 136 + c]);
            if (t0 == 1920 && i >= 113) p.out[OPP + ((size_t)(l * 8 + b) * 15 + (i - 113)) * 512 + g * 128 + c] = cur;
        }
    }
    __syncthreads();
    {
        const int lr = lane & 15, lq = lane >> 4;
        bf16x8 a[4];
#pragma unroll
        for (int s = 0; s < 4; ++s) a[s] = *(const LAS bf16x8*)(PB + (16 * wid + lr) * 136 + 32 * s + 8 * lq);
        const size_t prow = (size_t)(rowbase + 16 * wid + lr);
        u32x2 zr[8];
#pragma unroll
        for (int nt = 0; nt < 8; ++nt) zr[nt] = *(const u32x2*)(P0 + prow * 1024 + 512 + g * 128 + 16 * nt + 4 * lq);
#pragma unroll
        for (int nt = 0; nt < 8; ++nt) {
            f32x4 acc = {0.f, 0.f, 0.f, 0.f};
#pragma unroll
            for (int s = 0; s < 4; ++s) { const bf16x8 bb = *(const LAS bf16x8*)(WB + (16 * nt + lr) * 136 + 32 * s + 8 * lq); acc = __builtin_amdgcn_mfma_f32_16x16x32_bf16(bb, a[s], acc, 0, 0, 0); }
            const int d = g * 128 + 16 * nt + 4 * lq;
            const float4 ps = *(const float4*)(p.pool_scale + l * 512 + d);
            const float z0 = __uint_as_float(zr[nt].x << 16), z1 = __uint_as_float(zr[nt].x & 0xffff0000u), z2 = __uint_as_float(zr[nt].y << 16), z3 = __uint_as_float(zr[nt].y & 0xffff0000u);
            u32x2 w2; w2.x = pk2(acc[0] * ps.x * silu_f(z0), acc[1] * ps.y * silu_f(z1)); w2.y = pk2(acc[2] * ps.z * silu_f(z2), acc[3] * ps.w * silu_f(z3));
            *(u32x2*)(YM + prow * 1024 + d) = w2;
        }
    }
    __syncthreads();
}

__device__ __forceinline__ void sample_pool_item(const Params& p, int l, int sidx, LAS unsigned char* lds) {
    const int tid = opq_tid(), wid = tid >> 6, lane = tid & 63;
    const int g = sidx & 3, tq = sidx >> 2, w = 2 << g;
    LAS bf16_t* PB = (LAS bf16_t*)(lds + 38912); LAS bf16_t* WB = (LAS bf16_t*)(lds + 73728);
    const bf16_t* P0 = (const bf16_t*)(p.ws + WS_P0);
    const bf16_t* WtPool = (const bf16_t*)(p.ws + WS_WTPOOL) + (size_t)(l * 4 + g) * 16384;
    bf16_t* YM = (bf16_t*)(p.ws + WS_H);
#pragma unroll
    for (int q = 0; q < 4; ++q) { const int piece = tid + 512 * q, d = piece >> 4, k8 = (piece & 15) * 8; *(LAS u32x4*)(WB + d * 136 + k8) = *(const u32x4*)(WtPool + d * 128 + k8); }
    {
        const int c = tid & 127, q = tid >> 7;
#pragma unroll 2
        for (int ii = 0; ii < 8; ++ii) {
            const int il = 8 * q + ii, i = 32 * tq + il;
            const float cur = bf2f(P0[(size_t)(NP + i) * 1024 + g * 128 + c]);
            const float* sp = p.state_pool + ((size_t)(l * 128 + i) * 15) * 512 + g * 128 + c;
            float* op = p.out + OPS + ((size_t)(l * 128 + i) * 15) * 512 + g * 128 + c;
            float v[15];
#pragma unroll
            for (int j = 0; j < 15; ++j) v[j] = sp[(size_t)j * 512];
            float s = cur;
#pragma unroll
            for (int j = 0; j < 15; ++j) { if (14 - j <= w - 2) s += v[j]; if (j >= 1) op[(size_t)(j - 1) * 512] = v[j]; }
            op[(size_t)14 * 512] = cur;
            PB[il * 136 + c] = f2bf(s * (1.0f / (float)w) - cur);
        }
    }
    __syncthreads();
    if (wid < 2) {
        const int lr = lane & 15, lq = lane >> 4;
        bf16x8 a[4];
#pragma unroll
        for (int s = 0; s < 4; ++s) a[s] = *(const LAS bf16x8*)(PB + (16 * wid + lr) * 136 + 32 * s + 8 * lq);
        const size_t prow = (size_t)(NP + 32 * tq + 16 * wid + lr);
        u32x2 zr[8];
#pragma unroll
        for (int nt = 0; nt < 8; ++nt) zr[nt] = *(const u32x2*)(P0 + prow * 1024 + 512 + g * 128 + 16 * nt + 4 * lq);
#pragma unroll
        for (int nt = 0; nt < 8; ++nt) {
            f32x4 acc = {0.f, 0.f, 0.f, 0.f};
#pragma unroll
            for (int s = 0; s < 4; ++s) { const bf16x8 bb = *(const LAS bf16x8*)(WB + (16 * nt + lr) * 136 + 32 * s + 8 * lq); acc = __builtin_amdgcn_mfma_f32_16x16x32_bf16(bb, a[s], acc, 0, 0, 0); }
            const int d = g * 128 + 16 * nt + 4 * lq;
            const float4 ps = *(const float4*)(p.pool_scale + l * 512 + d);
            const float z0 = __uint_as_float(zr[nt].x << 16), z1 = __uint_as_float(zr[nt].x & 0xffff0000u), z2 = __uint_as_float(zr[nt].y << 16), z3 = __uint_as_float(zr[nt].y & 0xffff0000u);
            u32x2 w2; w2.x = pk2(acc[0] * ps.x * silu_f(z0), acc[1] * ps.y * silu_f(z1)); w2.y = pk2(acc[2] * ps.z * silu_f(z2), acc[3] * ps.w * silu_f(z3));
            *(u32x2*)(YM + prow * 1024 + d) = w2;
        }
    }
    __syncthreads();
}

__device__ __forceinline__ void sample_item(const Params& p, int l, int b, LAS unsigned char* lds) {
    const int tid = opq_tid(), wid = tid >> 6, lane = tid & 63;
    const int hd = tid >> 7, e = tid & 127;
    const size_t r = (size_t)(NP + b);
    LAS float* SQ = (LAS float*)lds; LAS float* SK = SQ + 512; LAS float* SV = SQ + 1024; LAS float* SO = SQ + 1536;
    LAS float* RED = SQ + 2048; LAS float* RED2 = SQ + 2560; LAS float* RW = SQ + 3072;
    const bf16_t* P1 = (const bf16_t*)(p.ws + WS_P1); const bf16_t* P2 = (const bf16_t*)(p.ws + WS_P2);
    const float* Gd = (const float*)(p.ws + WS_G); const float* Bd = (const float*)(p.ws + WS_BETA);
    bf16_t* YM = (bf16_t*)(p.ws + WS_H);
    const float* sc = p.state_conv + (size_t)(l * 128 + b) * 3 * 1536; const float* cw = p.conv_w + (size_t)l * 4 * 1536;
    float* oc = p.out + OCS + (size_t)(l * 128 + b) * 3 * 1536;
    const int part = hd;
    float sreg[32];
    {
        const float* Sin0 = p.state_ssm + ((size_t)((l * 128 + b) * 4 + 0) * 128) * 128;
#pragma unroll
        for (int dd = 0; dd < 32; ++dd) sreg[dd] = Sin0[(part * 32 + dd) * 128 + e];
    }
    float xin[3], cv[3];
    xin[0] = bf2f(P1[r * 1024 + tid]); xin[1] = bf2f(P1[r * 1024 + 512 + tid]); xin[2] = bf2f(P2[r * 1024 + tid]);
#pragma unroll
    for (int k = 0; k < 3; ++k) {
        const int ch = tid + 512 * k;
        const float b0 = sc[ch], b1 = sc[1536 + ch], b2 = sc[3072 + ch];
        cv[k] = silu_f(b0 * cw[ch] + b1 * cw[1536 + ch] + b2 * cw[3072 + ch] + xin[k] * cw[4608 + ch]);
        oc[ch] = b1; oc[1536 + ch] = b2; oc[3072 + ch] = xin[k];
    }
    const float sq = wave_sum(cv[0] * cv[0]), sk = wave_sum(cv[1] * cv[1]);
    if (lane == 0) { RW[wid] = sq; RW[8 + wid] = sk; }
    __syncthreads();
    {
        const float ssq = RW[2 * hd] + RW[2 * hd + 1], ssk = RW[8 + 2 * hd] + RW[8 + 2 * hd + 1];
        SQ[tid] = cv[0] * rsqrtf(ssq + 1e-6f) * 0.08838834764831845f; SK[tid] = cv[1] * rsqrtf(ssk + 1e-6f); SV[tid] = cv[2];
    }
    __syncthreads();
#pragma unroll 1
    for (int hh = 0; hh < 4; ++hh) {
        const float eg = __expf(Gd[r * 4 + hh]), bt = Bd[r * 4 + hh];
        float* Sout = p.out + OSS + ((size_t)((l * 128 + b) * 4 + hh) * 128) * 128;
        float kvp = 0.f;
#pragma unroll
        for (int dd = 0; dd < 32; ++dd) { sreg[dd] *= eg; kvp += SK[hh * 128 + part * 32 + dd] * sreg[dd]; }
        RED[part * 128 + e] = kvp;
        __syncthreads();
        const float kv = RED[e] + RED[128 + e] + RED[256 + e] + RED[384 + e];
        const float delta = (SV[hh * 128 + e] - kv) * bt;
        float op = 0.f;
#pragma unroll
        for (int dd = 0; dd < 32; ++dd) { const int d = part * 32 + dd; const float sv = sreg[dd] + SK[hh * 128 + d] * delta; Sout[d * 128 + e] = sv; op += SQ[hh * 128 + d] * sv; }
        if (hh < 3) {
            const float* Sin = p.state_ssm + ((size_t)((l * 128 + b) * 4 + hh + 1) * 128) * 128;
#pragma unroll
            for (int dd = 0; dd < 32; ++dd) sreg[dd] = Sin[(part * 32 + dd) * 128 + e];
        }
        RED2[part * 128 + e] = op;
        __syncthreads();
        if (part == 0) SO[hh * 128 + e] = RED2[e] + RED2[128 + e] + RED2[256 + e] + RED2[384 + e];
    }
    __syncthreads();
    const float o = SO[tid];
    const float so = wave_sum(o * o);
    if (lane == 0) RW[16 + wid] = so;
    __syncthreads();
    {
        const float rstd = rsqrtf((RW[16 + 2 * hd] + RW[16 + 2 * hd + 1]) * (1.0f / 128.0f) + 1e-6f);
        const float zb = bf2f(P2[r * 1024 + 512 + tid]);
        YM[r * 1024 + 512 + tid] = f2bf(o * rstd * p.o_norm_w[l * 128 + e] * silu_f(zb));
    }
    __syncthreads();
}

__device__ __forceinline__ void phase_post(const Params& p, int l, LAS unsigned char* lds) {
    for (int idx = blockIdx.x; idx < 1024 + 512; idx += gridDim.x) {
        if (idx < 1024) { if (!(SKIP & 128)) chunk_item<0>(p, l, idx, lds); }
        else { if (!(SKIP & 256)) pool_item(p, l, idx - 1024, lds); }
    }
}

struct ScanOps { bf16x8 aA[4]; bf16x8 kgA[2]; u32x4 x8[2]; float gl; };
struct ScanPtrs { const char* a; const char* kg; const char* x; const float* gl; int xitem, xstep; };
__device__ __forceinline__ void scan_load(ScanOps& o, const ScanPtrs& q, int nc) {
    const char* ap = q.a + (size_t)nc * 16384; const char* kp = q.kg + (size_t)nc * 16384; const char* xp = q.x + (size_t)nc * q.xitem;
#pragma unroll
    for (int s = 0; s < 4; ++s) o.aA[s] = *(const bf16x8*)(ap + 1024 * s);
#pragma unroll
    for (int s = 0; s < 2; ++s) o.kgA[s] = *(const bf16x8*)(kp + 1024 * s);
#pragma unroll
    for (int s = 0; s < 2; ++s) o.x8[s] = *(const u32x4*)(xp + s * q.xstep);
    o.gl = q.gl[nc];
}

__device__ __forceinline__ void scan_step(const ScanOps& c, int m, int hi, int wid, int lr, int lq, f32x4 (&Sacc)[2], LAS bf16_t* ST, LAS bf16_t* VT, LAS float* OB) {
    f32x4 acc[2] = {{0.f, 0.f, 0.f, 0.f}, {0.f, 0.f, 0.f, 0.f}};
#pragma unroll
    for (int s = 0; s < 4; ++s)
#pragma unroll
        for (int nn = 0; nn < 2; ++nn) {
            const bf16x8 sb = *(const LAS bf16x8*)(ST + (16 * nn + lr) * 136 + 32 * s + 8 * lq);
            acc[nn] = __builtin_amdgcn_mfma_f32_16x16x32_bf16(c.aA[s], sb, acc[nn], 0, 0, 0);
        }
    if (!hi) {
#pragma unroll
        for (int nn = 0; nn < 2; ++nn) {
            u32x2 w; w.x = pk2(__uint_as_float(c.x8[nn][0]) - acc[nn][0], __uint_as_float(c.x8[nn][1]) - acc[nn][1]); w.y = pk2(__uint_as_float(c.x8[nn][2]) - acc[nn][2], __uint_as_float(c.x8[nn][3]) - acc[nn][3]);
            *(LAS u32x2*)(VT + (16 * nn + lr) * 72 + 16 * m + 4 * lq) = w;
        }
    }
    __syncthreads();
    bf16x8 vb[2][2];
#pragma unroll
    for (int nn = 0; nn < 2; ++nn)
#pragma unroll
        for (int s = 0; s < 2; ++s) vb[nn][s] = *(const LAS bf16x8*)(VT + (16 * nn + lr) * 72 + 32 * s + 8 * lq);
    if (hi) {
#pragma unroll
        for (int nn = 0; nn < 2; ++nn) {
#pragma unroll
            for (int s = 0; s < 2; ++s) { bf16x8 qa; u32x4 t = c.x8[s]; __builtin_memcpy(&qa, &t, 16); acc[nn] = __builtin_amdgcn_mfma_f32_16x16x32_bf16(qa, vb[nn][s], acc[nn], 0, 0, 0); }
#pragma unroll
            for (int r = 0; r < 4; ++r) OB[(16 * m + 4 * lq + r) * 36 + 16 * nn + lr] = acc[nn][r];
        }
    }
#pragma unroll
    for (int nn = 0; nn < 2; ++nn) {
        Sacc[nn] = Sacc[nn] * c.gl;
        Sacc[nn] = __builtin_amdgcn_mfma_f32_16x16x32_bf16(c.kgA[0], vb[nn][0], Sacc[nn], 0, 0, 0);
        Sacc[nn] = __builtin_amdgcn_mfma_f32_16x16x32_bf16(c.kgA[1], vb[nn][1], Sacc[nn], 0, 0, 0);
        u32x2 w; w.x = pk2(Sacc[nn][0], Sacc[nn][1]); w.y = pk2(Sacc[nn][2], Sacc[nn][3]);
        *(LAS u32x2*)(ST + (16 * nn + lr) * 136 + 16 * wid + 4 * lq) = w;
    }
    __syncthreads();
}

__device__ __forceinline__ void scan_item(const Params& p, int l, int bh, int slice, LAS unsigned char* lds) {
    const int tid = opq_tid(), wid = tid >> 6, lane = tid & 63, lr = lane & 15, lq = lane >> 4, m = wid & 3, hi = wid >> 2;
    const int b = bh >> 2, h = bh & 3;
    LAS bf16_t* ST = (LAS bf16_t*)lds;
    LAS bf16_t* VT = (LAS bf16_t*)(lds + 8704);
    LAS float* OB = (LAS float*)(lds + 13312);
    for (int i = tid; i < 32 * 136 / 2; i += 512) ((LAS unsigned*)ST)[i] = 0u;
    f32x4 Sacc[2] = {{0.f, 0.f, 0.f, 0.f}, {0.f, 0.f, 0.f, 0.f}};
    ScanPtrs q;
    const size_t ci0 = (size_t)bh * 32;
    q.a = (const char*)(p.ws + (hi ? WS_QG : WS_W)) + ci0 * 16384 + (m * 4 * 64 + lane) * 16;
    q.kg = (const char*)(p.ws + WS_KGT) + ci0 * 16384 + (wid * 2 * 64 + lane) * 16;
    q.x = hi ? (const char*)(p.ws + WS_QK) + ci0 * 8192 + (m * 2 * 64 + lane) * 16
             : (const char*)(p.ws + WS_U) + ci0 * 32768 + ((((slice * 4 + m) * 4 + lq) * 16 + lr) * 8) * 4;
    q.xitem = hi ? 8192 : 32768; q.xstep = hi ? 1024 : 16;
    q.gl = (const float*)(p.ws + WS_GL) + ci0;
    float* Orow = (float*)(p.ws + WS_P0) + ((size_t)b * 2048 + (tid >> 3)) * 512 + h * 128 + 32 * slice + (tid & 7) * 4;
    const int obo = (tid >> 3) * 36 + (tid & 7) * 4;
    ScanOps st[4];
#pragma unroll
    for (int d = 0; d < 4; ++d) scan_load(st[d], q, d);
    __syncthreads();
#pragma unroll 1
    for (int nc0 = 0; nc0 < 32; nc0 += 4) {
#pragma unroll
        for (int d = 0; d < 4; ++d) {
            const int nc = nc0 + d;
            if (nc > 0) *(f32x4*)(Orow + (size_t)(nc - 1) * 64 * 512) = *(const LAS f32x4*)(OB + obo);
            scan_step(st[d], m, hi, wid, lr, lq, Sacc, ST, VT, OB);
            scan_load(st[d], q, nc + 4 < 32 ? nc + 4 : 31);
        }
    }
    *(f32x4*)(Orow + (size_t)31 * 64 * 512) = *(const LAS f32x4*)(OB + obo);
    float* So = p.out + OSP + ((size_t)((l * 8 + b) * 4 + h) * 128) * 128;
#pragma unroll
    for (int nn = 0; nn < 2; ++nn)
#pragma unroll
        for (int r = 0; r < 4; ++r) So[(16 * wid + 4 * lq + r) * 128 + 32 * slice + 16 * nn + lr] = Sacc[nn][r];
}

__device__ __forceinline__ void phase_scan(const Params& p, int l, LAS unsigned char* lds) {
    const int G = (int)gridDim.x, nscan = G >= 256 ? 128 : G / 2;
    if ((int)blockIdx.x < nscan) {
        for (int blk = blockIdx.x; blk < 128; blk += nscan) {
            const int bh = (blk & 7) + 8 * (blk >> 5), slice = (blk >> 3) & 3;
            scan_item(p, l, bh, slice, lds);
            __syncthreads();
        }
    } else {
        for (int it = (int)blockIdx.x - nscan; it < 128 + 16; it += G - nscan) {
            if (it < 128) sample_item(p, l, it, lds); else sample_pool_item(p, l, it - 128, lds);
        }
    }
}

__device__ __forceinline__ void phase_onorm(const Params& p, int l, int nskip) {
    if ((int)blockIdx.x < nskip) return;
    const int tid = opq_tid(), wid = tid >> 6, lane = tid & 63;
    const float* Od = (const float*)(p.ws + WS_P0); const bf16_t* P2 = (const bf16_t*)(p.ws + WS_P2); bf16_t* YM = (bf16_t*)(p.ws + WS_H);
    const int c = lane * 8;
    const float4 w0 = *(const float4*)(p.o_norm_w + l * 128 + (c & 127)), w1 = *(const float4*)(p.o_norm_w + l * 128 + (c & 127) + 4);
    for (int row = ((int)blockIdx.x - nskip) * 8 + wid; row < NP; row += ((int)gridDim.x - nskip) * 8) {
        const float4 a = *(const float4*)(Od + (size_t)row * 512 + c), bq = *(const float4*)(Od + (size_t)row * 512 + c + 4);
        float ss = a.x * a.x + a.y * a.y + a.z * a.z + a.w * a.w + bq.x * bq.x + bq.y * bq.y + bq.z * bq.z + bq.w * bq.w;
        ss += __shfl_xor(ss, 1); ss += __shfl_xor(ss, 2); ss += __shfl_xor(ss, 4); ss += __shfl_xor(ss, 8);
        const float rstd = rsqrtf(ss * (1.0f / 128.0f) + 1e-6f);
        float z[8]; unpack8(*(const u32x4*)(P2 + (size_t)row * 1024 + 512 + c), z);
        float y[8];
        y[0] = a.x * rstd * w0.x * silu_f(z[0]); y[1] = a.y * rstd * w0.y * silu_f(z[1]); y[2] = a.z * rstd * w0.z * silu_f(z[2]); y[3] = a.w * rstd * w0.w * silu_f(z[3]);
        y[4] = bq.x * rstd * w1.x * silu_f(z[4]); y[5] = bq.y * rstd * w1.y * silu_f(z[5]); y[6] = bq.z * rstd * w1.z * silu_f(z[6]); y[7] = bq.w * rstd * w1.w * silu_f(z[7]);
        *(u32x4*)(YM + (size_t)row * 1024 + 512 + c) = pack8(y);
    }
}

struct Sched : pg8::StaticOrder {
    int ppm, pcnt;
    __device__ __forceinline__ bool next(int i, pg8::Unit& u) const {
        if (ppm < 0) return pg8::StaticOrder::next(i, u);
        const long L = (long)i * G + c; if (L >= pcnt) return false;
        u.pm = ppm; u.pn = (int)L; return true;
    }
};
__global__ void __launch_bounds__(512, 2) mk_fwd(Params p) {
    extern __shared__ __attribute__((aligned(16))) unsigned char shm[];
    LAS unsigned char* lds = (LAS unsigned char*)shm;
    cg::grid_group grid = cg::this_grid();
    volatile XLAS unsigned* xst = (volatile XLAS unsigned*)(lds + 131072);
    if (threadIdx.x == 0) { xst[0] = 0u; xst[1] = 0u; }
    __syncthreads();
    const XcdBarrier xb = xcd_barrier_post((unsigned*)(p.ws + WS_BAR), xst);
    if (p.ph_lo < 0) grid.sync();
    for (int ph = p.ph_lo; ph < p.ph_hi; ++ph) {
        if (ph == 0) { if (!(SKIP & 1)) phase_convert(p, lds); }
        else if (ph == 2) { if (!(SKIP & 2)) phase_rows(p, -1, 0, lds); }
        else {
            const int l = ph >= 3 ? (ph - 3) / 6 : 0, k = ph >= 3 ? (ph - 3) % 6 : -1;
            const int nsk = (int)gridDim.x > 8 ? 4 : 0;
            if (ph == 1 || k == 4 || k == 3) { if (!(SKIP & 4)) {
                pg8::Gemm g; pg8::EpiF32 E; Sched S; S.ppm = -1; S.pcnt = 0;
                if (ph == 1) { g.A = (const bf16_t*)(p.ws + WS_AC); g.Bt = (const bf16_t*)(p.ws + WS_WTADA); g.M = 256; g.N = 6144; g.K = 1024; E.C = (float*)(p.ws + WS_MOD); E.ldc = 6144; E.bias = p.b_ada; }
                else { g.A = (const bf16_t*)(p.ws + WS_H); g.Bt = (const bf16_t*)(p.ws + WS_WTOUT) + (size_t)l * 1024 * 1024; g.M = NP; g.N = 1024; g.K = 1024; E.C = (float*)(p.ws + WS_P0); E.ldc = 1024; E.bias = nullptr;
                       if (k == 3) { S.ppm = 64; S.pcnt = nsk ? 4 : 0; } }
                S.init(g.M, g.N, (int)gridDim.x, (int)blockIdx.x);
                if (k == 3 && !nsk) { S.ppm = 64; S.pcnt = 4; }
                for (int rep = 0; rep < 1 + ((PROBE_KIND == 12 && k == 4) ? PROBE_N : 0); ++rep) pg8::gemm_phase<pg8::EpiF32, Sched, false>(lds, g, S, E, nullptr); }
                if (k == 3) { if (!(SKIP & 64)) phase_onorm(p, l, nsk); }
            } else if (k == 0 || k == 1) { if (!(SKIP & 8)) {
                pg8::Gemm g; g.A = (const bf16_t*)(p.ws + WS_H); g.Bt = (const bf16_t*)(p.ws + WS_WTIN) + (size_t)l * 3072 * 1024; g.M = NP; g.N = 3072; g.K = 1024;
                pg8::EpiBf16<0> E; E.O = (bf16_t*)(p.ws + WS_P0); E.ldc = 1024; E.bias = nullptr; E.split_cols = 1024; E.split_stride = (size_t)MPAD * 1024;
                Sched S; S.init(g.M, g.N, (int)gridDim.x, (int)blockIdx.x); S.ppm = (k == 1) ? 64 : -1; S.pcnt = 12;
                for (int rep = 0; rep < 1 + ((PROBE_KIND == 11 && k == 0) ? PROBE_N : 0); ++rep) pg8::gemm_phase<pg8::EpiBf16<0>, Sched, false>(lds, g, S, E, nullptr); }
                if (k == 1) { if (!(SKIP & 16)) phase_post(p, l, lds); }
            }
            else if (k == 2) { if (!(SKIP & 32)) phase_scan(p, l, lds); }
            else if (k == 5) { if (!(SKIP & 2)) phase_rows(p, l, l + 1 < 2 ? l + 1 : -1, lds); }
        }
#if PROBE_KIND
        {
            const int l2 = ph >= 3 ? (ph - 3) / 6 : 0, k2 = ph >= 3 ? (ph - 3) % 6 : -1;
            for (int rep = 0; rep < PROBE_N; ++rep) {
                if (PROBE_KIND == 6 && ph == 2) xcd_barrier(xb);
                if (PROBE_KIND == 1 && k2 == 1) phase_post(p, l2, lds);
                if (PROBE_KIND == 3 && k2 == 3) phase_onorm(p, l2, 0);
                if (PROBE_KIND == 13 && k2 == 5 && l2 == 0) phase_rows(p, 0, 1, lds);
                if (PROBE_KIND == 14 && ph == 0) phase_convert(p, lds);
                if (PROBE_KIND == 7 && k2 == 1) { for (int idx = blockIdx.x; idx < 1024; idx += gridDim.x) chunk_item<PROBE_N>(p, l2, idx, lds); }
                if (PROBE_KIND == 8 && k2 == 1) { for (int idx = blockIdx.x; idx < 512; idx += gridDim.x) pool_item(p, l2, idx, lds); }
                if (PROBE_KIND == 9 && k2 == 2) { if (blockIdx.x < 128) { const int blk = blockIdx.x; scan_item(p, l2, (blk & 7) + 8 * (blk >> 5), (blk >> 3) & 3, lds); __syncthreads(); } }
                if (PROBE_KIND == 10 && k2 == 2) { if (blockIdx.x >= 128) { for (int it = (int)blockIdx.x - 128; it < 144; it += 128) { if (it < 128) sample_item(p, l2, it, lds); else sample_pool_item(p, l2, it - 128, lds); } } }
                if (PROBE_KIND == 5 && ph == 2) phase_rows(p, -1, 0, lds);
            }
        }
#endif
        if (ph + 1 < p.ph_hi) xcd_barrier(xb);
    }
}

extern "C" void kernel_launch(void* const* d_in, const int* in_sizes, int n_in, void* d_out, int out_size, void* d_ws, size_t ws_size, hipStream_t stream) {
    static int grid = 0;
    if (grid == 0) {
        if (n_in != 19 || ws_size < WS_END) { fprintf(stderr, "kernel_launch: unexpected n_in %d or ws_size %zu (< %zu)\n", n_in, ws_size, (size_t)WS_END); grid = -1; return; }
        int dev = 0, cus = 0, per_cu = 0;
        hipGetDevice(&dev); hipDeviceGetAttribute(&cus, hipDeviceAttributeMultiprocessorCount, dev);
        if (hipFuncSetAttribute((const void*)mk_fwd, hipFuncAttributeMaxDynamicSharedMemorySize, LDS_BYTES) != hipSuccess) { fprintf(stderr, "kernel_launch: hipFuncSetAttribute failed\n"); }
        if (hipOccupancyMaxActiveBlocksPerMultiprocessor(&per_cu, (const void*)mk_fwd, 512, LDS_BYTES) != hipSuccess || per_cu < 1) per_cu = 1;
        (void)hipGetLastError();
        grid = cus * 1;
        if (grid <= 0) grid = 256;
    }
    if (grid < 0) return;
    if (hipMemsetAsync((char*)d_ws + WS_BAR, 0, 16384, stream) != hipSuccess) { fprintf(stderr, "kernel_launch: memset failed\n"); return; }
    Params p{};
    const float** f = (const float**)&p;
    for (int i = 0; i < 19; ++i) f[i] = (const float*)d_in[i];
    p.out = (float*)d_out; p.ws = (unsigned char*)d_ws; p.ph_lo = 0; p.ph_hi = 15;
    void* args[] = {&p};
    hipError_t e = hipLaunchCooperativeKernel((const void*)mk_fwd, dim3(grid), dim3(512), args, LDS_BYTES, stream);
    if (e != hipSuccess) fprintf(stderr, "cooperative launch failed: %s (grid %d)\n", hipGetErrorString(e), grid);
}
```

```cpp
#include <hip/hip_runtime.h>
#include <hip/hip_cooperative_groups.h>
#include <cstdio>
namespace cg = cooperative_groups;
__device__ __forceinline__ int opq_tid() { int t = (int)threadIdx.x; asm volatile("" : "+v"(t)); return t; }
namespace pg8 {
#define PG8_LAS __attribute__((address_space(3)))
typedef unsigned short bf16_t;
typedef short bf16x8 __attribute__((ext_vector_type(8)));
typedef float f32x4 __attribute__((ext_vector_type(4)));
typedef unsigned u32x4 __attribute__((ext_vector_type(4)));
constexpr int BM = 256, BK = 64, HALF = 128, HTB = HALF * BK * 2  , STAGE_BYTES = 8 * HTB, NXCD = 8, WGM = 8;

__host__ __device__ __forceinline__ int lds_byte(int r, int c) { const int st = (r >> 4) * 2 + (c >> 5), rr = r & 15, cc = c & 31, ob = rr * 64 + cc * 2; return st * 1024 + (ob ^ (((ob >> 9) & 1) << 5)); }
__host__ __device__ __forceinline__ void stage_rc(int b, int& R, int& C) { const int st = b / 1024, sb = b % 1024, swz = sb ^ (((sb >> 9) & 1) << 5); R = (st >> 1) * 16 + swz / 64; C = (st & 1) * 32 + (swz % 64) / 2; }
__host__ __device__ __forceinline__ int perm32(int rho) { const int n = rho >> 4, i = rho & 15; return 8 * (i >> 2) + 4 * n + (i & 3); }

struct Unit { int pm, pn; };
struct Gemm { const bf16_t* A; const bf16_t* Bt; int M, N, K; };
struct StaticOrder {
    int nM, nN, nwg, G, c;
    __host__ __device__ void init(int M, int N, int G_, int c_) { nM = M / BM; nN = N / BM; nwg = nM * nN; G = G_; c = c_; }
    __host__ __device__ bool next(int i, Unit& u) const {
        const long L = (long)i * G + c; if (L >= nwg) return false;
        int wgid = (int)L; { const int q = nwg / NXCD, r = nwg % NXCD, xcd = wgid % NXCD, off = wgid / NXCD; wgid = (xcd < r ? xcd * (q + 1) : r * (q + 1) + (xcd - r) * q) + off; }
        const int nig = WGM * nN, gid = wgid / nig, fm = gid * WGM, gsz = (nM - fm) < WGM ? (nM - fm) : WGM;
        u.pm = fm + ((wgid % nig) % gsz); u.pn = (wgid % nig) / gsz; return true;
    }
    __device__ __forceinline__ void a_ready(const Unit&) const {}
    __device__ __forceinline__ void done(const Unit&) const {}
};
__device__ __forceinline__ unsigned cvt_pk_bf16(float lo, float hi) { unsigned r; asm volatile("v_cvt_pk_bf16_f32 %0, %1, %2" : "=v"(r) : "v"(lo), "v"(hi)); return r; }
typedef float f32x2 __attribute__((ext_vector_type(2)));
__device__ __forceinline__ f32x2 gelu_pk(f32x2 v) {
    const f32x2 av = __builtin_elementwise_abs(v), d = av * 0.2316418882f + 1.0f;
    f32x2 t; t.x = __builtin_amdgcn_rcpf(d.x); t.y = __builtin_amdgcn_rcpf(d.y);
    f32x2 q = t * 0.5307027145f + (-0.7265760135f); q = q * t + 0.7107068705f; q = q * t + (-0.142248368f); q = q * t + 0.127414796f; q = q * t;
    const f32x2 s = (v * v) * (-0.72134752044f);
    f32x2 e; e.x = __builtin_amdgcn_exp2f(s.x); e.y = __builtin_amdgcn_exp2f(s.y);
    const f32x2 m = v * (q * e), r = v - m;
    f32x2 o; o.x = v.x < 0.f ? m.x : r.x; o.y = v.y < 0.f ? m.y : r.y; return o;
}

struct EpiF32 {
    static constexpr bool PERM = false, AFTER_DRAIN = false;
    float* C; int ldc; const float* bias;
    __device__ __forceinline__ void operator()(const f32x4 (&acc)[2][2][4][2], const Unit& u, int wr, int wc, int fr, int fq) const {
        const int row0 = u.pm * BM + wr * 64 + fr, col0 = u.pn * BM + wc * 32 + 4 * fq;
        f32x4 bv[2][2];
#pragma unroll
        for (int bj = 0; bj < 2; ++bj)
#pragma unroll
            for (int n = 0; n < 2; ++n) bv[bj][n] = bias ? *(const f32x4*)(bias + col0 + bj * HALF + n * 16) : (f32x4){0.f, 0.f, 0.f, 0.f};
#pragma unroll
        for (int ai = 0; ai < 2; ++ai)
#pragma unroll
            for (int m = 0; m < 4; ++m) { float* rowp = C + (size_t)(row0 + ai * HALF + m * 16) * ldc + col0;
#pragma unroll
                for (int bj = 0; bj < 2; ++bj)
#pragma unroll
                    for (int n = 0; n < 2; ++n) *(f32x4*)(rowp + bj * HALF + n * 16) = acc[ai][bj][m][n] + bv[bj][n]; }
    }
};
template <int ACT  > struct EpiBf16 {
    static constexpr bool PERM = true, AFTER_DRAIN = false;
    bf16_t* O; int ldc; const float* bias; int split_cols; size_t split_stride;
    __device__ __forceinline__ void operator()(const f32x4 (&acc)[2][2][4][2], const Unit& u, int wr, int wc, int fr, int fq) const {
        const int row0 = u.pm * BM + wr * 64 + fr; int colt = u.pn * BM; bf16_t* base = O;
        if (split_cols) { const int t = colt / split_cols; base += (size_t)t * split_stride; colt -= t * split_cols; }
        const int col0 = colt + wc * 32 + 8 * fq, bcol0 = u.pn * BM + wc * 32 + 8 * fq;
        f32x4 bv[2][2];
#pragma unroll
        for (int bj = 0; bj < 2; ++bj)
#pragma unroll
            for (int n = 0; n < 2; ++n) bv[bj][n] = bias ? *(const f32x4*)(bias + bcol0 + bj * HALF + 4 * n) : (f32x4){0.f, 0.f, 0.f, 0.f};
#pragma unroll
        for (int ai = 0; ai < 2; ++ai)
#pragma unroll
            for (int m = 0; m < 4; ++m) { bf16_t* rowp = base + (size_t)(row0 + ai * HALF + m * 16) * ldc + col0;
#pragma unroll
                for (int bj = 0; bj < 2; ++bj) { f32x4 v0 = acc[ai][bj][m][0] + bv[bj][0], v1 = acc[ai][bj][m][1] + bv[bj][1];
                    if (ACT == 1) { f32x2 a = gelu_pk((f32x2){v0[0], v0[1]}), b = gelu_pk((f32x2){v0[2], v0[3]}), c = gelu_pk((f32x2){v1[0], v1[1]}), d = gelu_pk((f32x2){v1[2], v1[3]});
                        v0 = (f32x4){a.x, a.y, b.x, b.y}; v1 = (f32x4){c.x, c.y, d.x, d.y}; }
                    if (ACT == 2) {
#pragma unroll
                        for (int j = 0; j < 4; ++j) { v0[j] = 0.5f * v0[j] * (1.0f + erff(v0[j] * 0.70710678f)); v1[j] = 0.5f * v1[j] * (1.0f + erff(v1[j] * 0.70710678f)); } }
                    u32x4 w; w.x = cvt_pk_bf16(v0[0], v0[1]); w.y = cvt_pk_bf16(v0[2], v0[3]); w.z = cvt_pk_bf16(v1[0], v1[1]); w.w = cvt_pk_bf16(v1[2], v1[3]);
                    *(u32x4*)(rowp + bj * HALF) = w; } }
    }
};
template <class Epi, class Sched, bool STAMP = false>
__device__ __forceinline__ void gemm_phase(PG8_LAS unsigned char* lds, const Gemm g, const Sched& S, const Epi& E, unsigned long long* stamps) {
    const int tid = opq_tid(), wid = __builtin_amdgcn_readfirstlane(tid >> 6), lane = tid & 63, wr = wid >> 2, wc = wid & 3, fr = lane & 15, fq = lane >> 4;
    const int K = g.K, nt = K / BK;
    int ts_lo = 0, ts_hi = 0, nts = 0; const unsigned long long rt_entry = STAMP ? (unsigned long long)wall_clock64() : 0ull;
#define PG8_STAMP() do { if (STAMP && wid == 0 && nts < 64) { const unsigned long long _c = (unsigned long long)clock64(); \
        ts_lo = (lane == nts) ? (int)(unsigned)_c : ts_lo; ts_hi = (lane == nts) ? (int)(unsigned)(_c >> 32) : ts_hi; ++nts; } } while (0)
    PG8_STAMP();
    unsigned voffA[2], voffB[2];
#pragma unroll
    for (int i = 0; i < 2; ++i) { int R, C; stage_rc(tid * 16 + i * 8192, R, C); const int Rb = Epi::PERM ? ((R & ~31) + perm32(R & 31)) : R;
        voffA[i] = (unsigned)(R * K + C) * 2u; voffB[i] = (unsigned)(Rb * K + C) * 2u; }
    const size_t kstep = (size_t)(BK * 2);
    const size_t hstep = (size_t)HALF * K * 2;
    const size_t tstep = 2 * hstep;
    const unsigned ldsw = (unsigned)wid * 1024u;
    const int aoff = lds_byte(wr * 64 + fr, fq * 8), boff = lds_byte(wc * 32 + fr, fq * 8);
#define PG8_SA(b, h) (((b) * 2 + (h)) * HTB)
#define PG8_SB(b, h) ((4 + (b) * 2 + (h)) * HTB)
#define PG8_STAGE(bufoff, gbase, voff) do { _Pragma("unroll") for (int _i = 0; _i < 2; ++_i) \
        __builtin_amdgcn_global_load_lds((const unsigned*)((const char*)(gbase) + (voff)[_i]), (PG8_LAS unsigned*)(lds + (bufoff) + ldsw + _i * 8192), 16, 0, 0); } while (0)
#define PG8_LDA(dst, b, h) do { _Pragma("unroll") for (int m = 0; m < 4; ++m) _Pragma("unroll") for (int k = 0; k < 2; ++k) dst[m][k] = *(const PG8_LAS bf16x8*)(lds + PG8_SA(b, h) + aoff + m * 2048 + k * 1024); } while (0)
#define PG8_LDB(dst, b, h) do { _Pragma("unroll") for (int n = 0; n < 2; ++n) _Pragma("unroll") for (int k = 0; k < 2; ++k) dst[n][k] = *(const PG8_LAS bf16x8*)(lds + PG8_SB(b, h) + boff + n * 2048 + k * 1024); } while (0)
#define PG8_MMA(ai, bj, At, Bt) do { __builtin_amdgcn_s_setprio(1); _Pragma("unroll") for (int m = 0; m < 4; ++m) _Pragma("unroll") for (int n = 0; n < 2; ++n) _Pragma("unroll") for (int k = 0; k < 2; ++k) \
        acc[ai][bj][m][n] = __builtin_amdgcn_mfma_f32_16x16x32_bf16(Bt[n][k], At[m][k], acc[ai][bj][m][n], 0, 0, 0); __builtin_amdgcn_s_setprio(0); } while (0)
#define PG8_WAIT_V(n) asm volatile("s_waitcnt vmcnt(" #n ")" ::: "memory")
#define PG8_WAIT_L(n) asm volatile("s_waitcnt lgkmcnt(" #n ")" ::: "memory")
#define PG8_BAR __builtin_amdgcn_s_barrier()
#define PG8_SCHED __builtin_amdgcn_sched_barrier(0)
    Unit cur, nxt; int ui = 0;
    if (!S.next(0, cur)) return;
    f32x4 acc[2][2][4][2];
#pragma unroll
    for (int a = 0; a < 2; ++a)
#pragma unroll
        for (int b = 0; b < 2; ++b)
#pragma unroll
            for (int m = 0; m < 4; ++m)
#pragma unroll
                for (int n = 0; n < 2; ++n) acc[a][b][m][n] = (f32x4){0.f, 0.f, 0.f, 0.f};
    bf16x8 At[4][2], B0[2][2], B1[2][2];
    const char* cA = (const char*)g.A + (size_t)cur.pm * tstep; const char* cB = (const char*)g.Bt + (size_t)cur.pn * tstep;
    S.a_ready(cur);
    PG8_STAGE(PG8_SB(0, 0), cB, voffB); PG8_STAGE(PG8_SA(0, 0), cA, voffA); PG8_STAGE(PG8_SB(0, 1), cB + hstep, voffB); PG8_STAGE(PG8_SA(0, 1), cA + hstep, voffA);
    if (wr == 1) PG8_BAR;
    PG8_WAIT_V(4); PG8_BAR;
    PG8_STAGE(PG8_SB(1, 0), cB + kstep, voffB); PG8_STAGE(PG8_SA(1, 0), cA + kstep, voffA); PG8_STAGE(PG8_SB(1, 1), cB + hstep + kstep, voffB);
    PG8_WAIT_V(6); PG8_BAR;
    PG8_STAMP();
    for (;;) {
        const bool has_next = S.next(ui + 1, nxt);
        const char* nA = has_next ? (const char*)g.A + (size_t)nxt.pm * tstep : cA; const char* nB = has_next ? (const char*)g.Bt + (size_t)nxt.pn * tstep : cB;
        for (int t = 0; t < nt; t += 2) {
            const bool last = (t == nt - 2);
            const char* a1 = cA + (size_t)(t + 1) * kstep;
            const char* a2 = last ? nA : cA + (size_t)(t + 2) * kstep; const char* b2 = last ? nB : cB + (size_t)(t + 2) * kstep;
            const char* a3 = a2 + kstep; const char* b3 = b2 + kstep;
            if (last && has_next) S.a_ready(nxt);
            PG8_LDB(B0, 0, 0); PG8_SCHED; PG8_LDA(At, 0, 0); PG8_STAGE(PG8_SA(1, 1), a1 + hstep, voffA);
            PG8_WAIT_L(8); PG8_BAR; PG8_WAIT_L(0); PG8_MMA(0, 0, At, B0); PG8_BAR; PG8_SCHED;
            PG8_LDB(B1, 0, 1); PG8_STAGE(PG8_SB(0, 0), b2, voffB);
            PG8_BAR; PG8_WAIT_L(0); PG8_MMA(0, 1, At, B1); PG8_BAR;
            PG8_LDA(At, 0, 1); PG8_STAGE(PG8_SA(0, 0), a2, voffA);
            PG8_BAR; PG8_WAIT_L(0); PG8_MMA(1, 0, At, B0); PG8_BAR; PG8_SCHED;
            PG8_STAGE(PG8_SB(0, 1), b2 + hstep, voffB);
            PG8_WAIT_V(6); PG8_BAR; PG8_MMA(1, 1, At, B1); PG8_BAR;
            PG8_LDB(B0, 1, 0); PG8_SCHED; PG8_LDA(At, 1, 0); PG8_STAGE(PG8_SA(0, 1), a2 + hstep, voffA);
            PG8_WAIT_L(8); PG8_BAR; PG8_WAIT_L(0); PG8_MMA(0, 0, At, B0); PG8_BAR; PG8_SCHED;
            PG8_LDB(B1, 1, 1); PG8_STAGE(PG8_SB(1, 0), b3, voffB);
            PG8_BAR; PG8_WAIT_L(0); PG8_MMA(0, 1, At, B1); PG8_BAR;
            PG8_LDA(At, 1, 1); PG8_STAGE(PG8_SA(1, 0), a3, voffA);
            PG8_BAR; PG8_WAIT_L(0); PG8_MMA(1, 0, At, B0); PG8_BAR; PG8_SCHED;
            PG8_STAGE(PG8_SB(1, 1), b3 + hstep, voffB);
            PG8_WAIT_V(6); PG8_BAR; PG8_MMA(1, 1, At, B1); PG8_BAR;
        }
        PG8_STAMP();
        if constexpr (!Epi::AFTER_DRAIN) { E(acc, cur, wr, wc, fr, fq); S.done(cur); }
        PG8_STAMP();
        if (!has_next) break;
#pragma unroll
        for (int a = 0; a < 2; ++a)
#pragma unroll
            for (int b = 0; b < 2; ++b)
#pragma unroll
                for (int m = 0; m < 4; ++m)
#pragma unroll
                    for (int n = 0; n < 2; ++n) acc[a][b][m][n] = (f32x4){0.f, 0.f, 0.f, 0.f};
        cur = nxt; cA = nA; cB = nB; ++ui;
    }
    PG8_WAIT_V(0);
    if (wr == 0) PG8_BAR;
    PG8_BAR;
    if constexpr (Epi::AFTER_DRAIN) { E.fused(acc, cur, wr, wc, fr, fq, lds, wid, lane); S.done(cur); }
    PG8_STAMP();
    if (STAMP && wid == 0) { stamps[lane] = lane < nts ? (((unsigned long long)(unsigned)ts_hi << 32) | (unsigned)ts_lo) : 0ull;
        if (lane == 62) stamps[62] = rt_entry; if (lane == 63) stamps[63] = (unsigned long long)wall_clock64(); }
#undef PG8_STAMP
#undef PG8_SA
#undef PG8_SB
#undef PG8_STAGE
#undef PG8_LDA
#undef PG8_LDB
#undef PG8_MMA
#undef PG8_WAIT_V
#undef PG8_WAIT_L
#undef PG8_BAR
#undef PG8_SCHED
}
}
#include <cstdint>
#include <cstdlib>
#include <vector>

#define XB_TMO      128
#define XB_XCNT(j)  (256  + 64 * (j))
#define XB_XSUB(j)  (1280 + 64 * (j))
#define XB_XGEN(j)  (2304 + 64 * (j))
#define XB_TOP      3328
#define XB_TOPGEN   3392
#define XCD_BAR_WORDS 3456
#define XB_SPIN_CAP (1u << 18)
#define XLAS __attribute__((address_space(3)))

__device__ __forceinline__ unsigned xb_ld(unsigned* p)              { return __hip_atomic_load(p, __ATOMIC_RELAXED, __HIP_MEMORY_SCOPE_AGENT); }
__device__ __forceinline__ unsigned xb_add(unsigned* p, unsigned v) { return __hip_atomic_fetch_add(p, v, __ATOMIC_RELAXED, __HIP_MEMORY_SCOPE_AGENT); }
__device__ __forceinline__ unsigned xb_xcc_id() { return (unsigned)__builtin_amdgcn_s_getreg((3 << 11) | 20) & 0xFu; }
#define XB_SPIN(cond, bar) do { unsigned _sp = 0; while (cond) { __builtin_amdgcn_s_sleep(1); \
    if ((++_sp & 255u) == 0u) { if (xb_ld(&(bar)[XB_TMO])) break; if (_sp > XB_SPIN_CAP) { atomicAdd(&(bar)[XB_TMO], 1u); break; } } } } while (0)

struct XcdBarrier {
    unsigned* bar; unsigned x;
    volatile XLAS unsigned* st;
};

__device__ __forceinline__ XcdBarrier xcd_barrier_post(unsigned* bar, volatile XLAS unsigned* st) {
    XcdBarrier b; b.bar = bar; b.x = xb_xcc_id(); b.st = st;
    if (threadIdx.x == 0) (void)xb_add(&bar[XB_XCNT(b.x)], 1u);
    return b;
}
__device__ __forceinline__ void xcd_barrier_complete(unsigned* bar, unsigned x, unsigned& nloc, unsigned& nx) {
    const unsigned G = gridDim.x * gridDim.y * gridDim.z;
    unsigned sum, cnt, mine, sp = 0u;
    for (;;) {
        sum = 0u; cnt = 0u; mine = 0u;
#pragma unroll
        for (unsigned j = 0; j < 16; ++j) { const unsigned c = xb_ld(&bar[XB_XCNT(j)]); sum += c; cnt += (c > 0u) ? 1u : 0u; mine = (j == x) ? c : mine; }
        if (sum == G) break;
        __builtin_amdgcn_s_sleep(1);
        if ((++sp & 255u) == 0u) { if (xb_ld(&bar[XB_TMO])) break; if (sp > XB_SPIN_CAP) { atomicAdd(&bar[XB_TMO], 1u); break; } }
    }
    nloc = mine > 0u ? mine : 1u; nx = cnt > 0u ? cnt : 1u;
}

__device__ __forceinline__ void xcd_barrier(const XcdBarrier& b) {
    asm volatile("s_waitcnt vmcnt(0)" ::: "memory");
    __syncthreads();
    if (threadIdx.x == 0) {
        unsigned* bar = b.bar;
        __builtin_amdgcn_s_waitcnt(0);
        unsigned nloc = b.st[0], nx = b.st[1];
        if (nloc == 0u) { xcd_barrier_complete(bar, b.x, nloc, nx); b.st[0] = nloc; b.st[1] = nx; }
        const unsigned old = xb_add(&bar[XB_XSUB(b.x)], 1u);
        const unsigned gen = old / nloc;
        if (old + 1u == (gen + 1u) * nloc) {
            __builtin_amdgcn_fence(__ATOMIC_RELEASE, "agent");
            asm volatile("s_waitcnt vmcnt(0)" ::: "memory");
            const unsigned og = xb_add(&bar[XB_TOP], 1u);
            const unsigned tg = og / nx;
            if (og + 1u == (tg + 1u) * nx) xb_add(&bar[XB_TOPGEN], 1u);
            else XB_SPIN(xb_ld(&bar[XB_TOPGEN]) == tg, bar);
            __builtin_amdgcn_fence(__ATOMIC_ACQUIRE, "agent");
            xb_add(&bar[XB_XGEN(b.x)], 1u);
            asm volatile("s_waitcnt vmcnt(0)" ::: "memory");
        } else {
            XB_SPIN(xb_ld(&bar[XB_XGEN(b.x)]) == gen, bar);
            __builtin_amdgcn_fence(__ATOMIC_ACQUIRE, "agent");
            asm volatile("s_waitcnt vmcnt(0)" ::: "memory");
        }
    }
    __syncthreads();
}

#ifndef SKIP
#define SKIP 0
#endif
#ifndef PROBE_KIND
#define PROBE_KIND 0
#define PROBE_N 0
#endif
#define LAS PG8_LAS
typedef pg8::bf16_t bf16_t;
typedef pg8::bf16x8 bf16x8;
typedef pg8::f32x4 f32x4;
typedef pg8::u32x4 u32x4;
typedef unsigned u32x2 __attribute__((ext_vector_type(2)));
constexpr int NP = 16384, NS = 128, NR = NP + NS, MPAD = 16640, DM = 1024, DIN = 3080;
constexpr int LDS_BYTES = 131072 + 16;
constexpr size_t OYS = 16777216, OPP = 16908288, OCP = 17031168, OSP = 17104896, OPS = 18153472, OCS = 20119552, OSS = 21299200;
constexpr size_t WS_WTIN = 0;
constexpr size_t WS_WTOUT = WS_WTIN + 12582912;
constexpr size_t WS_WTPOOL = WS_WTOUT + 4194304;
constexpr size_t WS_MOD = WS_WTPOOL + 262144;
constexpr size_t WS_H = WS_MOD + 6291456;
constexpr size_t WS_P0 = WS_H + 34078720;
constexpr size_t WS_P1 = WS_P0 + 34078720;
constexpr size_t WS_P2 = WS_P1 + 34078720;
constexpr size_t WS_G = WS_P2 + 34078720;
constexpr size_t WS_BETA = WS_G + 264192;
constexpr size_t WS_GL = WS_BETA + 264192;
constexpr size_t WS_W = WS_GL + 4096;
constexpr size_t WS_QG = WS_W + 16777216;
constexpr size_t WS_KGT = WS_QG + 16777216;
constexpr size_t WS_QK = WS_KGT + 16777216;
constexpr size_t WS_U = WS_QK + 8388608;
constexpr size_t WS_WTADA = WS_U;
constexpr size_t WS_AC = WS_U + 12582912;
constexpr size_t WS_BAR = WS_U + 33554432;
constexpr size_t WS_END = WS_BAR + 16384;

struct Params {
    const float* x_prompt; const float* x_sample; const float* c_prompt; const float* c_sample;
    const float* state_pool; const float* state_conv; const float* state_ssm;
    const float* w_ada; const float* b_ada; const float* pre_norm_w; const float* post_norm_w; const float* w_in; const float* conv_w;
    const float* pool_w; const float* pool_scale; const float* a_log; const float* dt_bias; const float* o_norm_w; const float* w_out;
    float* out; unsigned char* ws; int ph_lo, ph_hi;
};

__device__ __forceinline__ float bf2f(unsigned short b) { return __uint_as_float(((unsigned)b) << 16); }
typedef __bf16 bf16x2_t __attribute__((ext_vector_type(2)));
typedef float f32x2_t __attribute__((ext_vector_type(2)));
__device__ __forceinline__ unsigned pk2(float lo, float hi) { f32x2_t v = {lo, hi}; bf16x2_t r = __builtin_convertvector(v, bf16x2_t); unsigned u; __builtin_memcpy(&u, &r, 4); return u; }
__device__ __forceinline__ unsigned short f2bf(float f) { return (unsigned short)(pk2(f, 0.f) & 0xffffu); }
__device__ __forceinline__ float silu_f(float x) { return x * __builtin_amdgcn_rcpf(1.0f + __expf(-x)); }
__device__ __forceinline__ void unpack8(const u32x4 v, float* x) {
    x[0] = __uint_as_float(v.x << 16); x[1] = __uint_as_float(v.x & 0xffff0000u); x[2] = __uint_as_float(v.y << 16); x[3] = __uint_as_float(v.y & 0xffff0000u);
    x[4] = __uint_as_float(v.z << 16); x[5] = __uint_as_float(v.z & 0xffff0000u); x[6] = __uint_as_float(v.w << 16); x[7] = __uint_as_float(v.w & 0xffff0000u);
}
__device__ __forceinline__ u32x4 pack8(const float* x) { u32x4 w; w.x = pk2(x[0], x[1]); w.y = pk2(x[2], x[3]); w.z = pk2(x[4], x[5]); w.w = pk2(x[6], x[7]); return w; }
__device__ __forceinline__ float wave_sum(float v) {
#pragma unroll
    for (int o = 32; o >= 1; o >>= 1) v += __shfl_xor(v, o);
    return v;
}

__device__ __forceinline__ void transpose_tile(const float* __restrict__ src, int ld, bf16_t* __restrict__ dst, int ldd, int k0, int n0, LAS float* tile) {
    const int tid = opq_tid();
#pragma unroll
    for (int p = 0; p < 2; ++p) {
        const int kk = (tid >> 4) + 32 * p, n4 = (tid & 15) * 4;
        const float4 v = *(const float4*)(src + (size_t)(k0 + kk) * ld + n0 + n4);
        tile[kk * 65 + n4 + 0] = v.x; tile[kk * 65 + n4 + 1] = v.y; tile[kk * 65 + n4 + 2] = v.z; tile[kk * 65 + n4 + 3] = v.w;
    }
    __syncthreads();
    const int n = tid >> 3, k8 = (tid & 7) * 8;
    float x[8];
#pragma unroll
    for (int i = 0; i < 8; ++i) x[i] = tile[(k8 + i) * 65 + n];
    *(u32x4*)(dst + (size_t)(n0 + n) * ldd + k0 + k8) = pack8(x);
    __syncthreads();
}

__device__ __forceinline__ void phase_convert(const Params& p, LAS unsigned char* lds) {
    LAS float* tile = (LAS float*)lds;
    bf16_t* WtIn = (bf16_t*)(p.ws + WS_WTIN); bf16_t* WtAda = (bf16_t*)(p.ws + WS_WTADA); bf16_t* WtOut = (bf16_t*)(p.ws + WS_WTOUT); bf16_t* WtPool = (bf16_t*)(p.ws + WS_WTPOOL);
    for (int t = blockIdx.x; t < 3616; t += gridDim.x) {
        if (t < 1536) { const int l = t / 768, rem = t % 768; transpose_tile(p.w_in + (size_t)l * 1024 * DIN, DIN, WtIn + (size_t)l * 3072 * 1024, 1024, (rem / 48) * 64, (rem % 48) * 64, tile); }
        else if (t < 3072) { const int tt = t - 1536, l = tt / 768, rem = tt % 768; transpose_tile(p.w_ada + (size_t)l * 1024 * 3072, 3072, WtAda + (size_t)l * 3072 * 1024, 1024, (rem / 48) * 64, (rem % 48) * 64, tile); }
        else if (t < 3584) { const int tt = t - 3072, l = tt / 256, rem = tt % 256; transpose_tile(p.w_out + (size_t)l * 1024 * 1024, 1024, WtOut + (size_t)l * 1024 * 1024, 1024, (rem / 16) * 64, (rem % 16) * 64, tile); }
        else { const int tt = t - 3584, lg = tt / 4, rem = tt % 4; transpose_tile(p.pool_w + (size_t)lg * 16384, 128, WtPool + (size_t)lg * 16384, 128, (rem / 2) * 64, (rem % 2) * 64, tile); }
    }
    bf16_t* Ac = (bf16_t*)(p.ws + WS_AC);
    for (int i = blockIdx.x * 512 + opq_tid(); i < 65536; i += gridDim.x * 512) {
        const int row = i >> 8, c4 = (i & 255) * 4;
        float4 v = make_float4(0.f, 0.f, 0.f, 0.f);
        if (row < 8) v = *(const float4*)(p.c_prompt + row * 1024 + c4); else if (row < 136) v = *(const float4*)(p.c_sample + (row - 8) * 1024 + c4);
        uint2 w; w.x = pk2(silu_f(v.x), silu_f(v.y)); w.y = pk2(silu_f(v.z), silu_f(v.w));
        *(uint2*)(Ac + row * 1024 + c4) = w;
    }
}

struct RowVecs { float4 gp[4], sh[4], ps[4]; };
__device__ __forceinline__ void row_body(const Params& p, int lF, int lA, int row, int lane, float4 (&yv)[4], float4 (&xv)[4], const RowVecs& v, LAS float* W8t) {
    float* xout = p.out + (size_t)row * 1024;
    bf16_t* H = (bf16_t*)(p.ws + WS_H);
    float* Gd = (float*)(p.ws + WS_G); float* Bd = (float*)(p.ws + WS_BETA);
    if (lF >= 0) {
        float ss = 0.f;
#pragma unroll
        for (int i = 0; i < 4; ++i) ss += yv[i].x * yv[i].x + yv[i].y * yv[i].y + yv[i].z * yv[i].z + yv[i].w * yv[i].w;
        ss = wave_sum(ss);
        const float rstd = rsqrtf(ss * (1.0f / 1024.0f) + 1e-6f);
#pragma unroll
        for (int i = 0; i < 4; ++i) {
            const int c = lane * 4 + 256 * i;
            xv[i].x += v.gp[i].x * (yv[i].x * rstd); xv[i].y += v.gp[i].y * (yv[i].y * rstd);
            xv[i].z += v.gp[i].z * (yv[i].z * rstd); xv[i].w += v.gp[i].w * (yv[i].w * rstd);
            *(float4*)(xout + c) = xv[i];
        }
    }
    if (lA >= 0) {
        asm volatile("" ::: "memory");
        float ss = 0.f;
#pragma unroll
        for (int i = 0; i < 4; ++i) ss += xv[i].x * xv[i].x + xv[i].y * xv[i].y + xv[i].z * xv[i].z + xv[i].w * xv[i].w;
        ss = wave_sum(ss);
        const float rstd = rsqrtf(ss * (1.0f / 1024.0f) + 1e-6f);
        float d[8];
#pragma unroll
        for (int j = 0; j < 8; ++j) d[j] = 0.f;
#pragma unroll
        for (int i = 0; i < 4; ++i) {
            const int c = lane * 4 + 256 * i;
            float4 hv;
            hv.x = xv[i].x * rstd * v.ps[i].x + v.sh[i].x; hv.y = xv[i].y * rstd * v.ps[i].y + v.sh[i].y;
            hv.z = xv[i].z * rstd * v.ps[i].z + v.sh[i].z; hv.w = xv[i].w * rstd * v.ps[i].w + v.sh[i].w;
            uint2 w; w.x = pk2(hv.x, hv.y); w.y = pk2(hv.z, hv.w);
            *(uint2*)(H + (size_t)row * 1024 + c) = w;
#pragma unroll
            for (int j = 0; j < 8; ++j) { const f32x4 wv = *(const LAS f32x4*)(W8t + j * 1024 + c); d[j] += hv.x * wv[0] + hv.y * wv[1] + hv.z * wv[2] + hv.w * wv[3]; }
        }
#pragma unroll
        for (int j = 0; j < 8; ++j) d[j] = wave_sum(d[j]);
        if (lane < 4) {
            const float br = lane == 0 ? d[0] : lane == 1 ? d[1] : lane == 2 ? d[2] : d[3];
            const float ar = lane == 0 ? d[4] : lane == 1 ? d[5] : lane == 2 ? d[6] : d[7];
            const float xs = ar + p.dt_bias[lA * 4 + lane];
            const float sp = fmaxf(xs, 0.f) + log1pf(__expf(-fabsf(xs)));
            Bd[row * 4 + lane] = 1.0f / (1.0f + __expf(-br));
            Gd[row * 4 + lane] = -__expf(p.a_log[lA * 4 + lane]) * sp;
        }
    }
}
__device__ __forceinline__ void row_vecs(RowVecs& v, const Params& p, int lF, int lA, int mrow, int lane) {
    const float* mod = (const float*)(p.ws + WS_MOD) + (size_t)mrow * 6144;
#pragma unroll
    for (int i = 0; i < 4; ++i) {
        const int c = lane * 4 + 256 * i;
        if (lF >= 0) { const float4 g = *(const float4*)(mod + lF * 3072 + 2048 + c), w = *(const float4*)(p.post_norm_w + lF * 1024 + c); v.gp[i] = make_float4(g.x * w.x, g.y * w.y, g.z * w.z, g.w * w.w); }
        if (lA >= 0) { v.sh[i] = *(const float4*)(mod + lA * 3072 + c); const float4 sc = *(const float4*)(mod + lA * 3072 + 1024 + c), w = *(const float4*)(p.pre_norm_w + lA * 1024 + c);
                       v.ps[i] = make_float4(w.x * (1.0f + sc.x), w.y * (1.0f + sc.y), w.z * (1.0f + sc.z), w.w * (1.0f + sc.w)); }
    }
}
__device__ __forceinline__ void row_load(const Params& p, int lF, int row, int lane, float4 (&yv)[4], float4 (&xv)[4]) {
    const float* xorig = row < NP ? p.x_prompt + (size_t)row * 1024 : p.x_sample + (size_t)(row - NP) * 1024;
    const float* xsrc = (lF <= 0) ? xorig : p.out + (size_t)row * 1024;
    const bf16_t* yrow = (const bf16_t*)(p.ws + WS_P0) + (size_t)row * 1024;
#pragma unroll
    for (int i = 0; i < 4; ++i) {
        xv[i] = *(const float4*)(xsrc + lane * 4 + 256 * i);
        if (lF >= 0) { const uint2 t = *(const uint2*)(yrow + lane * 4 + 256 * i); yv[i] = make_float4(__uint_as_float(t.x << 16), __uint_as_float(t.x & 0xffff0000u), __uint_as_float(t.y << 16), __uint_as_float(t.y & 0xffff0000u)); }
    }
}
__device__ __forceinline__ void phase_rows(const Params& p, int lF, int lA, LAS unsigned char* lds) {
    const int tid = opq_tid(), wid = tid >> 6, lane = tid & 63;
    LAS float* W8t = (LAS float*)lds;
    if (lA >= 0) {
        for (int i = tid; i < 8192; i += 512) { const int k = i >> 3, j = i & 7; W8t[j * 1024 + k] = p.w_in[(size_t)lA * 1024 * DIN + (size_t)k * DIN + 3072 + j]; }
        __syncthreads();
    }
    const int nwaves = (int)gridDim.x * 8, gw = (int)blockIdx.x * 8 + wid;
    for (int r0 = gw * 8; r0 < NP; r0 += nwaves * 8) {
        RowVecs v; row_vecs(v, p, lF, lA, r0 >> 11, lane);
        float4 ya[4], xa[4], yb[4], xb[4];
        row_load(p, lF, r0, lane, ya, xa);
#pragma unroll 1
        for (int rr = 0; rr < 8; rr += 2) {
            row_load(p, lF, r0 + rr + 1, lane, yb, xb);
            row_body(p, lF, lA, r0 + rr, lane, ya, xa, v, W8t);
            if (rr + 2 < 8) row_load(p, lF, r0 + rr + 2, lane, ya, xa);
            row_body(p, lF, lA, r0 + rr + 1, lane, yb, xb, v, W8t);
        }
    }
    for (int row = NP + gw; row < NR; row += nwaves) {
        RowVecs v; row_vecs(v, p, lF, lA, 8 + row - NP, lane);
        float4 ya[4], xa[4];
        row_load(p, lF, row, lane, ya, xa);
        row_body(p, lF, lA, row, lane, ya, xa, v, W8t);
    }
}

__device__ __forceinline__ void conv16(const u32x4 (&xr)[4][2], int tok, const LAS float* cw, float* out, float* xcur) {
    float acc[16];
#pragma unroll
    for (int i = 0; i < 16; ++i) acc[i] = 0.f;
#pragma unroll
    for (int j = 0; j < 4; ++j) {
        const bool valid = (tok - 3 + j) >= 0;
        float x[16]; unpack8(xr[j][0], x); unpack8(xr[j][1], x + 8);
#pragma unroll
        for (int q = 0; q < 4; ++q) {
            const f32x4 w = *(const LAS f32x4*)(cw + j * 128 + 4 * q);
            const float x0 = valid ? x[4 * q] : 0.f, x1 = valid ? x[4 * q + 1] : 0.f, x2 = valid ? x[4 * q + 2] : 0.f, x3 = valid ? x[4 * q + 3] : 0.f;
            acc[4 * q] += x0 * w[0]; acc[4 * q + 1] += x1 * w[1]; acc[4 * q + 2] += x2 * w[2]; acc[4 * q + 3] += x3 * w[3];
        }
        if (j == 3) {
#pragma unroll
            for (int i = 0; i < 16; ++i) xcur[i] = x[i];
        }
    }
#pragma unroll
    for (int i = 0; i < 16; ++i) out[i] = silu_f(acc[i]);
}

template <int STOP> __device__ __forceinline__ void chunk_item(const Params& p, int l, int idx, LAS unsigned char* lds) {
    const int tid = opq_tid(), wid = tid >> 6, lane = tid & 63;
    const int b = idx >> 7, h = (idx >> 5) & 3, n = idx & 31, R0 = b * 2048 + n * 64;
    LAS bf16_t* KB = (LAS bf16_t*)lds; LAS bf16_t* QB = (LAS bf16_t*)(lds + 17408);
    LAS float* AT = (LAS float*)(lds + 34816); LAS float* RHS = (LAS float*)(lds + 51200);
    LAS float* GC = (LAS float*)(lds + 116736); LAS float* BT = GC + 64; LAS float* EG = GC + 128;
    const float* Gd = (const float*)(p.ws + WS_G); const float* Bd = (const float*)(p.ws + WS_BETA);
    const bf16_t* P1 = (const bf16_t*)(p.ws + WS_P1); const bf16_t* P2 = (const bf16_t*)(p.ws + WS_P2);
    bf16_t* Wd = (bf16_t*)(p.ws + WS_W) + (size_t)idx * 8192; bf16_t* QGd = (bf16_t*)(p.ws + WS_QG) + (size_t)idx * 8192;
    bf16_t* KGTd = (bf16_t*)(p.ws + WS_KGT) + (size_t)idx * 8192; bf16_t* QKd = (bf16_t*)(p.ws + WS_QK) + (size_t)idx * 4096;
    bf16_t* Ud = (bf16_t*)(p.ws + WS_U) + (size_t)idx * 8192; float* GLd = (float*)(p.ws + WS_GL);
    const int et = tid >> 3, ec0 = (tid & 7) * 16, etok = n * 64 + et;
    u32x4 xr[3][4][2];
#pragma unroll
    for (int a = 0; a < 3; ++a) {
        const bf16_t* base = (a == 0 ? P1 + h * 128 : a == 1 ? P1 + 512 + h * 128 : P2 + h * 128) + ec0;
#pragma unroll
        for (int j = 0; j < 4; ++j) {
            const int tj = etok - 3 + j, tjc = tj < 0 ? 0 : tj;
            const bf16_t* ptr = base + (size_t)(b * 2048 + tjc) * 1024;
            xr[a][j][0] = *(const u32x4*)ptr; xr[a][j][1] = *(const u32x4*)(ptr + 8);
        }
    }
    LAS float* CW = (LAS float*)(lds + 117504);
    if (tid >= 128) { const int ci = tid - 128, a = ci >> 7, d = ci & 127;
#pragma unroll
        for (int j = 0; j < 4; ++j) CW[(a * 4 + j) * 128 + d] = p.conv_w[(size_t)l * 4 * 1536 + j * 1536 + a * 512 + h * 128 + d]; }
    if (tid < 64) {
        float v = Gd[(R0 + tid) * 4 + h];
#pragma unroll
        for (int o = 1; o < 64; o <<= 1) { const float t = __shfl_up(v, o); if (lane >= o) v += t; }
        GC[tid] = v; BT[tid] = Bd[(R0 + tid) * 4 + h]; const float e = __expf(v); EG[tid] = e;
        if (tid == 63) GLd[idx] = e;
    }
    __syncthreads();
    if (STOP == 1) { if (xr[0][0][0][0] == 0x12345u && xr[2][3][1][3] == 0x54321u) GLd[idx] = 0.f; return; }
    {
        const int t = et, c0 = ec0, tok = etok;
        const float bt = BT[t], eg = EG[t];
        float s[16], xc[16];
        conv16(xr[0], tok, CW + c0, s, xc);
        if (n == 31 && t >= 61) { float* o = p.out + OCP + ((size_t)(l * 8 + b) * 3 + (t - 61)) * 1536 + h * 128 + c0;
#pragma unroll
            for (int i = 0; i < 16; ++i) o[i] = xc[i]; }
        float ss = 0.f;
#pragma unroll
        for (int i = 0; i < 16; ++i) ss += s[i] * s[i];
        ss += __shfl_xor(ss, 1); ss += __shfl_xor(ss, 2); ss += __shfl_xor(ss, 4);
        float rs = rsqrtf(ss + 1e-6f) * 0.08838834764831845f;
        float qn[16];
#pragma unroll
        for (int i = 0; i < 16; ++i) qn[i] = s[i] * rs;
        *(LAS u32x4*)(QB + t * 136 + c0) = pack8(qn); *(LAS u32x4*)(QB + t * 136 + c0 + 8) = pack8(qn + 8);
#pragma unroll
        for (int i = 0; i < 16; ++i) qn[i] *= eg;
        *(u32x4*)(QGd + (((((t >> 4) * 4 + (c0 >> 5)) * 4 + ((c0 >> 3) & 3)) * 16 + (t & 15)) * 8)) = pack8(qn);
        *(u32x4*)(QGd + (((((t >> 4) * 4 + ((c0 + 8) >> 5)) * 4 + (((c0 + 8) >> 3) & 3)) * 16 + (t & 15)) * 8)) = pack8(qn + 8);
        conv16(xr[1], tok, CW + 512 + c0, s, xc);
        if (n == 31 && t >= 61) { float* o = p.out + OCP + ((size_t)(l * 8 + b) * 3 + (t - 61)) * 1536 + 512 + h * 128 + c0;
#pragma unroll
            for (int i = 0; i < 16; ++i) o[i] = xc[i]; }
        ss = 0.f;
#pragma unroll
        for (int i = 0; i < 16; ++i) ss += s[i] * s[i];
        ss += __shfl_xor(ss, 1); ss += __shfl_xor(ss, 2); ss += __shfl_xor(ss, 4);
        rs = rsqrtf(ss + 1e-6f);
#pragma unroll
        for (int i = 0; i < 16; ++i) s[i] *= rs;
        *(LAS u32x4*)(KB + t * 136 + c0) = pack8(s); *(LAS u32x4*)(KB + t * 136 + c0 + 8) = pack8(s + 8);
        const float be = bt * eg;
#pragma unroll
        for (int i = 0; i < 16; i += 4) *(LAS f32x4*)(RHS + t * 256 + 128 + c0 + i) = (f32x4){s[i] * be, s[i + 1] * be, s[i + 2] * be, s[i + 3] * be};
        conv16(xr[2], tok, CW + 1024 + c0, s, xc);
        if (n == 31 && t >= 61) { float* o = p.out + OCP + ((size_t)(l * 8 + b) * 3 + (t - 61)) * 1536 + 1024 + h * 128 + c0;
#pragma unroll
            for (int i = 0; i < 16; ++i) o[i] = xc[i]; }
#pragma unroll
        for (int i = 0; i < 16; i += 4) *(LAS f32x4*)(RHS + t * 256 + c0 + i) = (f32x4){s[i] * bt, s[i + 1] * bt, s[i + 2] * bt, s[i + 3] * bt};
    }
    __syncthreads();
    if (STOP == 2) return;
    {
        const int lr = lane & 15, lq = lane >> 4;
#pragma unroll 1
        for (int jj = 0; jj < 4; ++jj) {
            const int job = wid * 4 + jj, which = job >> 4, tile = job & 15, mi = tile >> 2, nj = tile & 3;
            LAS bf16_t* As = which ? QB : KB;
            f32x4 acc = {0.f, 0.f, 0.f, 0.f};
            if (!which) {
#pragma unroll
                for (int s = 0; s < 4; ++s) {
                    const bf16x8 a = *(const LAS bf16x8*)(As + (16 * mi + lr) * 136 + 32 * s + 8 * lq);
                    const bf16x8 bb = *(const LAS bf16x8*)(KB + (16 * nj + lr) * 136 + 32 * s + 8 * lq);
                    acc = __builtin_amdgcn_mfma_f32_16x16x32_bf16(a, bb, acc, 0, 0, 0);
                }
                const int j = 16 * nj + lr, i0 = 16 * mi + 4 * lq;
                const float gj = GC[j];
                f32x4 o;
#pragma unroll
                for (int r = 0; r < 4; ++r) { const int i = i0 + r; o[r] = (i > j) ? BT[i] * acc[r] * __expf(GC[i] - gj) : 0.f; }
                *(LAS f32x4*)(AT + j * 64 + i0) = o;
            } else {
#pragma unroll
                for (int s = 0; s < 4; ++s) {
                    const bf16x8 a = *(const LAS bf16x8*)(As + (16 * mi + lr) * 136 + 32 * s + 8 * lq);
                    const bf16x8 bb = *(const LAS bf16x8*)(KB + (16 * nj + lr) * 136 + 32 * s + 8 * lq);
                    acc = __builtin_amdgcn_mfma_f32_16x16x32_bf16(bb, a, acc, 0, 0, 0);
                }
                const int i = 16 * mi + lr, j0 = 16 * nj + 4 * lq;
                const float gi = GC[i];
                float v[4];
#pragma unroll
                for (int r = 0; r < 4; ++r) { const int j = j0 + r; v[r] = (i >= j) ? acc[r] * __expf(gi - GC[j]) : 0.f; }
                u32x2 w; w.x = pk2(v[0], v[1]); w.y = pk2(v[2], v[3]);
                *(u32x2*)(QKd + ((((mi * 2 + (j0 >> 5)) * 4 + ((j0 >> 3) & 3)) * 16 + lr) * 8 + (j0 & 7))) = w;
            }
        }
    }
    __syncthreads();
    if (STOP == 3) return;
    if (tid < 256) {
        const int c = tid;
        float r[64];
#pragma unroll
        for (int i = 0; i < 64; ++i) r[i] = RHS[i * 256 + c];
#pragma unroll
        for (int j = 0; j < 63; ++j) {
            const float xj = r[j];
#pragma unroll
            for (int i4 = ((j + 1) & ~3); i4 < 64; i4 += 4) {
                const f32x4 a = *(const LAS f32x4*)(AT + j * 64 + i4);
                r[i4 + 0] -= a[0] * xj; r[i4 + 1] -= a[1] * xj; r[i4 + 2] -= a[2] * xj; r[i4 + 3] -= a[3] * xj;
            }
        }
#pragma unroll
        for (int i = 0; i < 64; ++i) RHS[i * 256 + c] = r[i];
    } else {
        const int d = (tid - 256) >> 1, th = tid & 1;
        const float gcl = GC[63];
        float x[32];
#pragma unroll
        for (int i = 0; i < 32; ++i) { const int t = 32 * th + i; x[i] = bf2f(KB[t * 136 + d]) * __expf(gcl - GC[t]); }
#pragma unroll
        for (int q = 0; q < 4; ++q) *(u32x4*)(KGTd + (((((d >> 4) * 2 + th) * 4 + q) * 16 + (d & 15)) * 8)) = pack8(x + 8 * q);
    }
    __syncthreads();
    {
#pragma unroll
        for (int k = 0; k < 4; ++k) {
            const int pi = tid + 512 * k, nn = pi & 1, ulr = (pi >> 1) & 15, ulq = (pi >> 5) & 3, um = (pi >> 7) & 3, usl = pi >> 9;
            const int row = 16 * um + 4 * ulq, col = 32 * usl + 16 * nn + ulr;
            u32x2 uw; uw.x = pk2(RHS[row * 256 + col], RHS[(row + 1) * 256 + col]); uw.y = pk2(RHS[(row + 2) * 256 + col], RHS[(row + 3) * 256 + col]);
            *(u32x2*)(Ud + pi * 4) = uw;
        }
#pragma unroll
        for (int k = 0; k < 2; ++k) {
            const int pw = tid + 512 * k, wl = pw & 63, wms = pw >> 6, row = 16 * (wms >> 2) + (wl & 15), c8 = 32 * (wms & 3) + 8 * (wl >> 4);
            const f32x4 v0 = *(const LAS f32x4*)(RHS + row * 256 + 128 + c8), v1 = *(const LAS f32x4*)(RHS + row * 256 + 128 + c8 + 4);
            u32x4 w; w.x = pk2(v0[0], v0[1]); w.y = pk2(v0[2], v0[3]); w.z = pk2(v1[0], v1[1]); w.w = pk2(v1[2], v1[3]);
            *(u32x4*)(Wd + pw * 8) = w;
        }
    }
    __syncthreads();
}

__device__ __forceinline__ void pool_item(const Params& p, int l, int pidx, LAS unsigned char* lds) {
    const int tid = opq_tid(), wid = tid >> 6, lane = tid & 63;
    const int g = pidx & 3, T = pidx >> 2, w = 2 << g;
    const int rowbase = T * 128, b = rowbase >> 11, t0 = rowbase & 2047;
    LAS bf16_t* UT = (LAS bf16_t*)lds; LAS bf16_t* PB = (LAS bf16_t*)(lds + 38912); LAS bf16_t* WB = (LAS bf16_t*)(lds + 73728);
    const bf16_t* P0 = (const bf16_t*)(p.ws + WS_P0);
    const bf16_t* WtPool = (const bf16_t*)(p.ws + WS_WTPOOL) + (size_t)(l * 4 + g) * 16384;
    bf16_t* YM = (bf16_t*)(p.ws + WS_H);
#pragma unroll
    for (int q = 0; q < 4; ++q) { const int piece = tid + 512 * q, d = piece >> 4, k8 = (piece & 15) * 8; *(LAS u32x4*)(WB + d * 136 + k8) = *(const u32x4*)(WtPool + d * 128 + k8); }
#pragma unroll
    for (int q = 0; q < 5; ++q) {
        const int piece = tid + 512 * q;
        if (piece < 143 * 16) {
            const int rr = piece >> 4, c8 = (piece & 15) * 8, tok = t0 - 15 + rr;
            u32x4 v = *(const u32x4*)(P0 + (size_t)(b * 2048 + (tok < 0 ? 0 : tok)) * 1024 + g * 128 + c8);
            if (tok < 0) v = (u32x4){0u, 0u, 0u, 0u};
            *(LAS u32x4*)(UT + rr * 136 + c8) = v;
        }
    }
    __syncthreads();
    {
        const int c = tid & 127, q = tid >> 7, i0 = 32 * q;
        float s = 0.f;
        for (int j = 1; j < w; ++j) s += bf2f(UT[(i0 + 15 - j) * 136 + c]);
#pragma unroll 4
        for (int i = i0; i < i0 + 32; ++i) {
            const float cur = bf2f(UT[(i + 15) * 136 + c]);
            s += cur;
            const int tk = t0 + i + 1; const float cnt = (float)(tk < w ? tk : w);
            PB[i * 136 + c] = f2bf(s * __builtin_amdgcn_rcpf(cnt) - cur);
            s -= bf2f(UT[(i + 15 - (w - 1)) * 136 + c]);
            if (t0 == 1920 && i >= 113) p.out[OPP + ((size_t)(l * 8 + b) * 15 + (i - 113)) * 512 + g * 128 + c] = cur;
        }
    }
    __syncthreads();
    {
        const int lr = lane & 15, lq = lane >> 4;
        bf16x8 a[4];
#pragma unroll
        for (int s = 0; s < 4; ++s) a[s] = *(const LAS bf16x8*)(PB + (16 * wid + lr) * 136 + 32 * s + 8 * lq);
        const size_t prow = (size_t)(rowbase + 16 * wid + lr);
        u32x2 zr[8];
#pragma unroll
        for (int nt = 0; nt < 8; ++nt) zr[nt] = *(const u32x2*)(P0 + prow * 1024 + 512 + g * 128 + 16 * nt + 4 * lq);
#pragma unroll
        for (int nt = 0; nt < 8; ++nt) {
            f32x4 acc = {0.f, 0.f, 0.f, 0.f};
#pragma unroll
            for (int s = 0; s < 4; ++s) { const bf16x8 bb = *(const LAS bf16x8*)(WB + (16 * nt + lr) * 136 + 32 * s + 8 * lq); acc = __builtin_amdgcn_mfma_f32_16x16x32_bf16(bb, a[s], acc, 0, 0, 0); }
            const int d = g * 128 + 16 * nt + 4 * lq;
            const float4 ps = *(const float4*)(p.pool_scale + l * 512 + d);
            const float z0 = __uint_as_float(zr[nt].x << 16), z1 = __uint_as_float(zr[nt].x & 0xffff0000u), z2 = __uint_as_float(zr[nt].y << 16), z3 = __uint_as_float(zr[nt].y & 0xffff0000u);
            u32x2 w2; w2.x = pk2(acc[0] * ps.x * silu_f(z0), acc[1] * ps.y * silu_f(z1)); w2.y = pk2(acc[2] * ps.z * silu_f(z2), acc[3] * ps.w * silu_f(z3));
            *(u32x2*)(YM + prow * 1024 + d) = w2;
        }
    }
    __syncthreads();
}

__device__ __forceinline__ void sample_pool_item(const Params& p, int l, int sidx, LAS unsigned char* lds) {
    const int tid = opq_tid(), wid = tid >> 6, lane = tid & 63;
    const int g = sidx & 3, tq = sidx >> 2, w = 2 << g;
    LAS bf16_t* PB = (LAS bf16_t*)(lds + 38912); LAS bf16_t* WB = (LAS bf16_t*)(lds + 73728);
    const bf16_t* P0 = (const bf16_t*)(p.ws + WS_P0);
    const bf16_t* WtPool = (const bf16_t*)(p.ws + WS_WTPOOL) + (size_t)(l * 4 + g) * 16384;
    bf16_t* YM = (bf16_t*)(p.ws + WS_H);
#pragma unroll
    for (int q = 0; q < 4; ++q) { const int piece = tid + 512 * q, d = piece >> 4, k8 = (piece & 15) * 8; *(LAS u32x4*)(WB + d * 136 + k8) = *(const u32x4*)(WtPool + d * 128 + k8); }
    {
        const int c = tid & 127, q = tid >> 7;
#pragma unroll 2
        for (int ii = 0; ii < 8; ++ii) {
            const int il = 8 * q + ii, i = 32 * tq + il;
            const float cur = bf2f(P0[(size_t)(NP + i) * 1024 + g * 128 + c]);
            const float* sp = p.state_pool + ((size_t)(l * 128 + i) * 15) * 512 + g * 128 + c;
            float* op = p.out + OPS + ((size_t)(l * 128 + i) * 15) * 512 + g * 128 + c;
            float v[15];
#pragma unroll
            for (int j = 0; j < 15; ++j) v[j] = sp[(size_t)j * 512];
            float s = cur;
#pragma unroll
            for (int j = 0; j < 15; ++j) { if (14 - j <= w - 2) s += v[j]; if (j >= 1) op[(size_t)(j - 1) * 512] = v[j]; }
            op[(size_t)14 * 512] = cur;
            PB[il * 136 + c] = f2bf(s * (1.0f / (float)w) - cur);
        }
    }
    __syncthreads();
    if (wid < 2) {
        const int lr = lane & 15, lq = lane >> 4;
        bf16x8 a[4];
#pragma unroll
        for (int s = 0; s < 4; ++s) a[s] = *(const LAS bf16x8*)(PB + (16 * wid + lr) * 136 + 32 * s + 8 * lq);
        const size_t prow = (size_t)(NP + 32 * tq + 16 * wid + lr);
        u32x2 zr[8];
#pragma unroll
        for (int nt = 0; nt < 8; ++nt) zr[nt] = *(const u32x2*)(P0 + prow * 1024 + 512 + g * 128 + 16 * nt + 4 * lq);
#pragma unroll
        for (int nt = 0; nt < 8; ++nt) {
            f32x4 acc = {0.f, 0.f, 0.f, 0.f};
#pragma unroll
            for (int s = 0; s < 4; ++s) { const bf16x8 bb = *(const LAS bf16x8*)(WB + (16 * nt + lr) * 136 + 32 * s + 8 * lq); acc = __builtin_amdgcn_mfma_f32_16x16x32_bf16(bb, a[s], acc, 0, 0, 0); }
            const int d = g * 128 + 16 * nt + 4 * lq;
            const float4 ps = *(const float4*)(p.pool_scale + l * 512 + d);
            const float z0 = __uint_as_float(zr[nt].x << 16), z1 = __uint_as_float(zr[nt].x & 0xffff0000u), z2 = __uint_as_float(zr[nt].y << 16), z3 = __uint_as_float(zr[nt].y & 0xffff0000u);
            u32x2 w2; w2.x = pk2(acc[0] * ps.x * silu_f(z0), acc[1] * ps.y * silu_f(z1)); w2.y = pk2(acc[2] * ps.z * silu_f(z2), acc[3] * ps.w * silu_f(z3));
            *(u32x2*)(YM + prow * 1024 + d) = w2;
        }
    }
    __syncthreads();
}

__device__ __forceinline__ void sample_item(const Params& p, int l, int b, LAS unsigned char* lds) {
    const int tid = opq_tid(), wid = tid >> 6, lane = tid & 63;
    const int hd = tid >> 7, e = tid & 127;
    const size_t r = (size_t)(NP + b);
    LAS float* SQ = (LAS float*)lds; LAS float* SK = SQ + 512; LAS float* SV = SQ + 1024; LAS float* SO = SQ + 1536;
    LAS float* RED = SQ + 2048; LAS float* RED2 = SQ + 2560; LAS float* RW = SQ + 3072;
    const bf16_t* P1 = (const bf16_t*)(p.ws + WS_P1); const bf16_t* P2 = (const bf16_t*)(p.ws + WS_P2);
    const float* Gd = (const float*)(p.ws + WS_G); const float* Bd = (const float*)(p.ws + WS_BETA);
    bf16_t* YM = (bf16_t*)(p.ws + WS_H);
    const float* sc = p.state_conv + (size_t)(l * 128 + b) * 3 * 1536; const float* cw = p.conv_w + (size_t)l * 4 * 1536;
    float* oc = p.out + OCS + (size_t)(l * 128 + b) * 3 * 1536;
    const int part = hd;
    float sreg[32];
    {
        const float* Sin0 = p.state_ssm + ((size_t)((l * 128 + b) * 4 + 0) * 128) * 128;
#pragma unroll
        for (int dd = 0; dd < 32; ++dd) sreg[dd] = Sin0[(part * 32 + dd) * 128 + e];
    }
    float xin[3], cv[3];
    xin[0] = bf2f(P1[r * 1024 + tid]); xin[1] = bf2f(P1[r * 1024 + 512 + tid]); xin[2] = bf2f(P2[r * 1024 + tid]);
#pragma unroll
    for (int k = 0; k < 3; ++k) {
        const int ch = tid + 512 * k;
        const float b0 = sc[ch], b1 = sc[1536 + ch], b2 = sc[3072 + ch];
        cv[k] = silu_f(b0 * cw[ch] + b1 * cw[1536 + ch] + b2 * cw[3072 + ch] + xin[k] * cw[4608 + ch]);
        oc[ch] = b1; oc[1536 + ch] = b2; oc[3072 + ch] = xin[k];
    }
    const float sq = wave_sum(cv[0] * cv[0]), sk = wave_sum(cv[1] * cv[1]);
    if (lane == 0) { RW[wid] = sq; RW[8 + wid] = sk; }
    __syncthreads();
    {
        const float ssq = RW[2 * hd] + RW[2 * hd + 1], ssk = RW[8 + 2 * hd] + RW[8 + 2 * hd + 1];
        SQ[tid] = cv[0] * rsqrtf(ssq + 1e-6f) * 0.08838834764831845f; SK[tid] = cv[1] * rsqrtf(ssk + 1e-6f); SV[tid] = cv[2];
    }
    __syncthreads();
#pragma unroll 1
    for (int hh = 0; hh < 4; ++hh) {
        const float eg = __expf(Gd[r * 4 + hh]), bt = Bd[r * 4 + hh];
        float* Sout = p.out + OSS + ((size_t)((l * 128 + b) * 4 + hh) * 128) * 128;
        float kvp = 0.f;
#pragma unroll
        for (int dd = 0; dd < 32; ++dd) { sreg[dd] *= eg; kvp += SK[hh * 128 + part * 32 + dd] * sreg[dd]; }
        RED[part * 128 + e] = kvp;
        __syncthreads();
        const float kv = RED[e] + RED[128 + e] + RED[256 + e] + RED[384 + e];
        const float delta = (SV[hh * 128 + e] - kv) * bt;
        float op = 0.f;
#pragma unroll
        for (int dd = 0; dd < 32; ++dd) { const int d = part * 32 + dd; const float sv = sreg[dd] + SK[hh * 128 + d] * delta; Sout[d * 128 + e] = sv; op += SQ[hh * 128 + d] * sv; }
        if (hh < 3) {
            const float* Sin = p.state_ssm + ((size_t)((l * 128 + b) * 4 + hh + 1) * 128) * 128;
#pragma unroll
            for (int dd = 0; dd < 32; ++dd) sreg[dd] = Sin[(part * 32 + dd) * 128 + e];
        }
        RED2[part * 128 + e] = op;
        __syncthreads();
        if (part == 0) SO[hh * 128 + e] = RED2[e] + RED2[128 + e] + RED2[256 + e] + RED2[384 + e];
    }
    __syncthreads();
    const float o = SO[tid];
    const float so = wave_sum(o * o);
    if (lane == 0) RW[16 + wid] = so;
    __syncthreads();
    {
        const float rstd = rsqrtf((RW[16 + 2 * hd] + RW[16 + 2 * hd + 1]) * (1.0f / 128.0f) + 1e-6f);
        const float zb = bf2f(P2[r * 1024 + 512 + tid]);
        YM[r * 1024 + 512 + tid] = f2bf(o * rstd * p.o_norm_w[l * 128 + e] * silu_f(zb));
    }
    __syncthreads();
}

__device__ __forceinline__ void phase_post(const Params& p, int l, LAS unsigned char* lds) {
    for (int idx = blockIdx.x; idx < 1024 + 512; idx += gridDim.x) {
        if (idx < 1024) { if (!(SKIP & 128)) chunk_item<0>(p, l, idx, lds); }
        else { if (!(SKIP & 256)) pool_item(p, l, idx - 1024, lds); }
    }
}

struct ScanOps { bf16x8 aA[4]; bf16x8 kgA[2]; u32x4 x8[2]; float gl; };
struct ScanPtrs { const char* a; const char* kg; const char* x; const float* gl; int xitem, xstep; };
__device__ __forceinline__ void scan_load(ScanOps& o, const ScanPtrs& q, int nc) {
    const char* ap = q.a + (size_t)nc * 16384; const char* kp = q.kg + (size_t)nc * 16384; const char* xp = q.x + (size_t)nc * q.xitem;
#pragma unroll
    for (int s = 0; s < 4; ++s) o.aA[s] = *(const bf16x8*)(ap + 1024 * s);
#pragma unroll
    for (int s = 0; s < 2; ++s) o.kgA[s] = *(const bf16x8*)(kp + 1024 * s);
#pragma unroll
    for (int s = 0; s < 2; ++s) o.x8[s] = *(const u32x4*)(xp + s * q.xstep);
    o.gl = q.gl[nc];
}

__device__ __forceinline__ void scan_step(const ScanOps& c, int m, int hi, int wid, int lr, int lq, f32x4 (&Sacc)[2], LAS bf16_t* ST, LAS bf16_t* VT, LAS float* OB) {
    f32x4 acc[2] = {{0.f, 0.f, 0.f, 0.f}, {0.f, 0.f, 0.f, 0.f}};
#pragma unroll
    for (int s = 0; s < 4; ++s)
#pragma unroll
        for (int nn = 0; nn < 2; ++nn) {
            const bf16x8 sb = *(const LAS bf16x8*)(ST + (16 * nn + lr) * 136 + 32 * s + 8 * lq);
            acc[nn] = __builtin_amdgcn_mfma_f32_16x16x32_bf16(c.aA[s], sb, acc[nn], 0, 0, 0);
        }
    if (!hi) {
#pragma unroll
        for (int nn = 0; nn < 2; ++nn) {
            const unsigned ua = c.x8[0][2 * nn], ub = c.x8[0][2 * nn + 1];
            u32x2 w; w.x = pk2(__uint_as_float(ua << 16) - acc[nn][0], __uint_as_float(ua & 0xffff0000u) - acc[nn][1]); w.y = pk2(__uint_as_float(ub << 16) - acc[nn][2], __uint_as_float(ub & 0xffff0000u) - acc[nn][3]);
            *(LAS u32x2*)(VT + (16 * nn + lr) * 72 + 16 * m + 4 * lq) = w;
        }
    }
    __syncthreads();
    bf16x8 vb[2][2];
#pragma unroll
    for (int nn = 0; nn < 2; ++nn)
#pragma unroll
        for (int s = 0; s < 2; ++s) vb[nn][s] = *(const LAS bf16x8*)(VT + (16 * nn + lr) * 72 + 32 * s + 8 * lq);
    if (hi) {
#pragma unroll
        for (int nn = 0; nn < 2; ++nn) {
#pragma unroll
            for (int s = 0; s < 2; ++s) { bf16x8 qa; u32x4 t = c.x8[s]; __builtin_memcpy(&qa, &t, 16); acc[nn] = __builtin_amdgcn_mfma_f32_16x16x32_bf16(qa, vb[nn][s], acc[nn], 0, 0, 0); }
#pragma unroll
            for (int r = 0; r < 4; ++r) OB[(16 * m + 4 * lq + r) * 36 + 16 * nn + lr] = acc[nn][r];
        }
    }
#pragma unroll
    for (int nn = 0; nn < 2; ++nn) {
        Sacc[nn] = Sacc[nn] * c.gl;
        Sacc[nn] = __builtin_amdgcn_mfma_f32_16x16x32_bf16(c.kgA[0], vb[nn][0], Sacc[nn], 0, 0, 0);
        Sacc[nn] = __builtin_amdgcn_mfma_f32_16x16x32_bf16(c.kgA[1], vb[nn][1], Sacc[nn], 0, 0, 0);
        u32x2 w; w.x = pk2(Sacc[nn][0], Sacc[nn][1]); w.y = pk2(Sacc[nn][2], Sacc[nn][3]);
        *(LAS u32x2*)(ST + (16 * nn + lr) * 136 + 16 * wid + 4 * lq) = w;
    }
    __syncthreads();
}

__device__ __forceinline__ void scan_item(const Params& p, int l, int bh, int slice, LAS unsigned char* lds) {
    const int tid = opq_tid(), wid = tid >> 6, lane = tid & 63, lr = lane & 15, lq = lane >> 4, m = wid & 3, hi = wid >> 2;
    const int b = bh >> 2, h = bh & 3;
    LAS bf16_t* ST = (LAS bf16_t*)lds;
    LAS bf16_t* VT = (LAS bf16_t*)(lds + 8704);
    LAS float* OB = (LAS float*)(lds + 13312);
    for (int i = tid; i < 32 * 136 / 2; i += 512) ((LAS unsigned*)ST)[i] = 0u;
    f32x4 Sacc[2] = {{0.f, 0.f, 0.f, 0.f}, {0.f, 0.f, 0.f, 0.f}};
    ScanPtrs q;
    const size_t ci0 = (size_t)bh * 32;
    q.a = (const char*)(p.ws + (hi ? WS_QG : WS_W)) + ci0 * 16384 + (m * 4 * 64 + lane) * 16;
    q.kg = (const char*)(p.ws + WS_KGT) + ci0 * 16384 + (wid * 2 * 64 + lane) * 16;
    q.x = hi ? (const char*)(p.ws + WS_QK) + ci0 * 8192 + (m * 2 * 64 + lane) * 16
             : (const char*)(p.ws + WS_U) + ci0 * 16384 + ((((slice * 4 + m) * 4 + lq) * 16 + lr) * 8) * 2;
    q.xitem = hi ? 8192 : 16384; q.xstep = hi ? 1024 : 0;
    q.gl = (const float*)(p.ws + WS_GL) + ci0;
    bf16_t* Orow = (bf16_t*)(p.ws + WS_P1) + ((size_t)b * 2048 + (tid >> 3)) * 512 + h * 128 + 32 * slice + (tid & 7) * 4;
    const int obo = (tid >> 3) * 36 + (tid & 7) * 4;
    ScanOps st[4];
#pragma unroll
    for (int d = 0; d < 4; ++d) scan_load(st[d], q, d);
    __syncthreads();
#pragma unroll 1
    for (int nc0 = 0; nc0 < 32; nc0 += 4) {
#pragma unroll
        for (int d = 0; d < 4; ++d) {
            const int nc = nc0 + d;
            if (nc > 0) { const f32x4 ov = *(const LAS f32x4*)(OB + obo); u32x2 ow; ow.x = pk2(ov[0], ov[1]); ow.y = pk2(ov[2], ov[3]); *(u32x2*)(Orow + (size_t)(nc - 1) * 64 * 512) = ow; }
            scan_step(st[d], m, hi, wid, lr, lq, Sacc, ST, VT, OB);
            scan_load(st[d], q, nc + 4 < 32 ? nc + 4 : 31);
        }
    }
    { const f32x4 ov = *(const LAS f32x4*)(OB + obo); u32x2 ow; ow.x = pk2(ov[0], ov[1]); ow.y = pk2(ov[2], ov[3]); *(u32x2*)(Orow + (size_t)31 * 64 * 512) = ow; }
    float* So = p.out + OSP + ((size_t)((l * 8 + b) * 4 + h) * 128) * 128;
#pragma unroll
    for (int nn = 0; nn < 2; ++nn)
#pragma unroll
        for (int r = 0; r < 4; ++r) So[(16 * wid + 4 * lq + r) * 128 + 32 * slice + 16 * nn + lr] = Sacc[nn][r];
}

__device__ __forceinline__ void phase_scan(const Params& p, int l, LAS unsigned char* lds) {
    const int G = (int)gridDim.x, nscan = G >= 256 ? 128 : G / 2;
    if ((int)blockIdx.x < nscan) {
        for (int blk = blockIdx.x; blk < 128; blk += nscan) {
            const int bh = (blk & 7) + 8 * (blk >> 5), slice = (blk >> 3) & 3;
            scan_item(p, l, bh, slice, lds);
            __syncthreads();
        }
    } else {
        for (int it = (int)blockIdx.x - nscan; it < 128 + 16; it += G - nscan) {
            if (it < 128) sample_item(p, l, it, lds); else sample_pool_item(p, l, it - 128, lds);
        }
    }
}

__device__ __forceinline__ void phase_onorm(const Params& p, int l, int nskip) {
    if ((int)blockIdx.x < nskip) return;
    const int tid = opq_tid(), wid = tid >> 6, lane = tid & 63;
    const bf16_t* Od = (const bf16_t*)(p.ws + WS_P1); const bf16_t* P2 = (const bf16_t*)(p.ws + WS_P2); bf16_t* YM = (bf16_t*)(p.ws + WS_H);
    const int c = lane * 8;
    const float4 w0 = *(const float4*)(p.o_norm_w + l * 128 + (c & 127)), w1 = *(const float4*)(p.o_norm_w + l * 128 + (c & 127) + 4);
    for (int row = ((int)blockIdx.x - nskip) * 8 + wid; row < NP; row += ((int)gridDim.x - nskip) * 8) {
        float ov[8]; unpack8(*(const u32x4*)(Od + (size_t)row * 512 + c), ov);
        const float4 a = make_float4(ov[0], ov[1], ov[2], ov[3]), bq = make_float4(ov[4], ov[5], ov[6], ov[7]);
        float ss = a.x * a.x + a.y * a.y + a.z * a.z + a.w * a.w + bq.x * bq.x + bq.y * bq.y + bq.z * bq.z + bq.w * bq.w;
        ss += __shfl_xor(ss, 1); ss += __shfl_xor(ss, 2); ss += __shfl_xor(ss, 4); ss += __shfl_xor(ss, 8);
        const float rstd = rsqrtf(ss * (1.0f / 128.0f) + 1e-6f);
        float z[8]; unpack8(*(const u32x4*)(P2 + (size_t)row * 1024 + 512 + c), z);
        float y[8];
        y[0] = a.x * rstd * w0.x * silu_f(z[0]); y[1] = a.y * rstd * w0.y * silu_f(z[1]); y[2] = a.z * rstd * w0.z * silu_f(z[2]); y[3] = a.w * rstd * w0.w * silu_f(z[3]);
        y[4] = bq.x * rstd * w1.x * silu_f(z[4]); y[5] = bq.y * rstd * w1.y * silu_f(z[5]); y[6] = bq.z * rstd * w1.z * silu_f(z[6]); y[7] = bq.w * rstd * w1.w * silu_f(z[7]);
        *(u32x4*)(YM + (size_t)row * 1024 + 512 + c) = pack8(y);
    }
}

struct Sched : pg8::StaticOrder {
    int ppm, pcnt;
    __device__ __forceinline__ bool next(int i, pg8::Unit& u) const {
        if (ppm < 0) return pg8::StaticOrder::next(i, u);
        const long L = (long)i * G + c; if (L >= pcnt) return false;
        u.pm = ppm; u.pn = (int)L; return true;
    }
};
__global__ void __launch_bounds__(512, 2) mk_fwd(Params p) {
    extern __shared__ __attribute__((aligned(16))) unsigned char shm[];
    LAS unsigned char* lds = (LAS unsigned char*)shm;
    cg::grid_group grid = cg::this_grid();
    volatile XLAS unsigned* xst = (volatile XLAS unsigned*)(lds + 131072);
    if (threadIdx.x == 0) { xst[0] = 0u; xst[1] = 0u; }
    __syncthreads();
    const XcdBarrier xb = xcd_barrier_post((unsigned*)(p.ws + WS_BAR), xst);
    if (p.ph_lo < 0) grid.sync();
    for (int ph = p.ph_lo; ph < p.ph_hi; ++ph) {
        if (ph == 0) { if (!(SKIP & 1)) phase_convert(p, lds); }
        else if (ph == 2) { if (!(SKIP & 2)) phase_rows(p, -1, 0, lds); }
        else {
            const int l = ph >= 3 ? (ph - 3) / 6 : 0, k = ph >= 3 ? (ph - 3) % 6 : -1;
            const int nsk = (int)gridDim.x > 8 ? 4 : 0;
            if (ph == 1) { if (!(SKIP & 4)) {
                pg8::Gemm g; pg8::EpiF32 E; Sched S; S.ppm = -1; S.pcnt = 0;
                g.A = (const bf16_t*)(p.ws + WS_AC); g.Bt = (const bf16_t*)(p.ws + WS_WTADA); g.M = 256; g.N = 6144; g.K = 1024; E.C = (float*)(p.ws + WS_MOD); E.ldc = 6144; E.bias = p.b_ada;
                S.init(g.M, g.N, (int)gridDim.x, (int)blockIdx.x);
                pg8::gemm_phase<pg8::EpiF32, Sched, false>(lds, g, S, E, nullptr); }
            } else if (k == 0 || k == 1 || k == 3 || k == 4) { if (!(SKIP & 8)) {
                pg8::Gemm g; pg8::EpiBf16<0> E; Sched S; E.bias = nullptr;
                g.A = (const bf16_t*)(p.ws + WS_H); g.K = 1024; g.M = NP;
                if (k <= 1) { g.Bt = (const bf16_t*)(p.ws + WS_WTIN) + (size_t)l * 3072 * 1024; g.N = 3072; E.O = (bf16_t*)(p.ws + WS_P0); E.ldc = 1024; E.split_cols = 1024; E.split_stride = (size_t)MPAD * 1024; }
                else { g.Bt = (const bf16_t*)(p.ws + WS_WTOUT) + (size_t)l * 1024 * 1024; g.N = 1024; E.O = (bf16_t*)(p.ws + WS_P0); E.ldc = 1024; E.split_cols = 0; E.split_stride = 0; }
                S.init(g.M, g.N, (int)gridDim.x, (int)blockIdx.x);
                S.ppm = (k == 1 || k == 3) ? 64 : -1; S.pcnt = (k == 1) ? 12 : 4;
                for (int rep = 0; rep < 1 + ((PROBE_KIND == 11 && k == 0) ? PROBE_N : 0); ++rep) pg8::gemm_phase<pg8::EpiBf16<0>, Sched, false>(lds, g, S, E, nullptr); }
                if (k == 1) { if (!(SKIP & 16)) phase_post(p, l, lds); }
                if (k == 3) { if (!(SKIP & 64)) phase_onorm(p, l, nsk); }
            }
            else if (k == 2) { if (!(SKIP & 32)) phase_scan(p, l, lds); }
            else if (k == 5) { if (!(SKIP & 2)) phase_rows(p, l, l + 1 < 2 ? l + 1 : -1, lds); }
        }
#if PROBE_KIND
        {
            const int l2 = ph >= 3 ? (ph - 3) / 6 : 0, k2 = ph >= 3 ? (ph - 3) % 6 : -1;
            for (int rep = 0; rep < PROBE_N; ++rep) {
                if (PROBE_KIND == 6 && ph == 2) xcd_barrier(xb);
                if (PROBE_KIND == 1 && k2 == 1) phase_post(p, l2, lds);
                if (PROBE_KIND == 3 && k2 == 3) phase_onorm(p, l2, 0);
                if (PROBE_KIND == 13 && k2 == 5 && l2 == 0) phase_rows(p, 0, 1, lds);
                if (PROBE_KIND == 14 && ph == 0) phase_convert(p, lds);
                if (PROBE_KIND == 7 && k2 == 1) { for (int idx = blockIdx.x; idx < 1024; idx += gridDim.x) chunk_item<PROBE_N>(p, l2, idx, lds); }
                if (PROBE_KIND == 8 && k2 == 1) { for (int idx = blockIdx.x; idx < 512; idx += gridDim.x) pool_item(p, l2, idx, lds); }
                if (PROBE_KIND == 9 && k2 == 2) { if (blockIdx.x < 128) { const int blk = blockIdx.x; scan_item(p, l2, (blk & 7) + 8 * (blk >> 5), (blk >> 3) & 3, lds); __syncthreads(); } }
                if (PROBE_KIND == 10 && k2 == 2) { if (blockIdx.x >= 128) { for (int it = (int)blockIdx.x - 128; it < 144; it += 128) { if (it < 128) sample_item(p, l2, it, lds); else sample_pool_item(p, l2, it - 128, lds); } } }
                if (PROBE_KIND == 5 && ph == 2) phase_rows(p, -1, 0, lds);
            }
        }
#endif
        if (ph + 1 < p.ph_hi) xcd_barrier(xb);
    }
}

extern "C" void kernel_launch(void* const* d_in, const int* in_sizes, int n_in, void* d_out, int out_size, void* d_ws, size_t ws_size, hipStream_t stream) {
    static int grid = 0;
    if (grid == 0) {
        if (n_in != 19 || ws_size < WS_END) { fprintf(stderr, "kernel_launch: unexpected n_in %d or ws_size %zu (< %zu)\n", n_in, ws_size, (size_t)WS_END); grid = -1; return; }
        int dev = 0, cus = 0, per_cu = 0;
        hipGetDevice(&dev); hipDeviceGetAttribute(&cus, hipDeviceAttributeMultiprocessorCount, dev);
        if (hipFuncSetAttribute((const void*)mk_fwd, hipFuncAttributeMaxDynamicSharedMemorySize, LDS_BYTES) != hipSuccess) { fprintf(stderr, "kernel_launch: hipFuncSetAttribute failed\n"); }
        if (hipOccupancyMaxActiveBlocksPerMultiprocessor(&per_cu, (const void*)mk_fwd, 512, LDS_BYTES) != hipSuccess || per_cu < 1) per_cu = 1;
        (void)hipGetLastError();
        grid = cus * 1;
        if (grid <= 0) grid = 256;
    }
    if (grid < 0) return;
    if (hipMemsetAsync((char*)d_ws + WS_BAR, 0, 16384, stream) != hipSuccess) { fprintf(stderr, "kernel_launch: memset failed\n"); return; }
    Params p{};
    const float** f = (const float**)&p;
    for (int i = 0; i < 19; ++i) f[i] = (const float*)d_in[i];
    p.out = (float*)d_out; p.ws = (unsigned char*)d_ws; p.ph_lo = 0; p.ph_hi = 15;
    void* args[] = {&p};
    hipError_t e = hipLaunchCooperativeKernel((const void*)mk_fwd, dim3(grid), dim3(512), args, LDS_BYTES, stream);
    if (e != hipSuccess) fprintf(stderr, "cooperative launch failed: %s (grid %d)\n", hipGetErrorString(e), grid);
}
```

```cpp
#include <hip/hip_runtime.h>
#include <hip/hip_cooperative_groups.h>
#include <cstdio>
namespace cg = cooperative_groups;
__device__ __forceinline__ int opq_tid() { int t = (int)threadIdx.x; asm volatile("" : "+v"(t)); return t; }
namespace pg8 {
#define PG8_LAS __attribute__((address_space(3)))
typedef unsigned short bf16_t;
typedef short bf16x8 __attribute__((ext_vector_type(8)));
typedef float f32x4 __attribute__((ext_vector_type(4)));
typedef unsigned u32x4 __attribute__((ext_vector_type(4)));
constexpr int BM = 256, BK = 64, HALF = 128, HTB = HALF * BK * 2  , STAGE_BYTES = 8 * HTB, NXCD = 8, WGM = 8;

__host__ __device__ __forceinline__ int lds_byte(int r, int c) { const int st = (r >> 4) * 2 + (c >> 5), rr = r & 15, cc = c & 31, ob = rr * 64 + cc * 2; return st * 1024 + (ob ^ (((ob >> 9) & 1) << 5)); }
__host__ __device__ __forceinline__ void stage_rc(int b, int& R, int& C) { const int st = b / 1024, sb = b % 1024, swz = sb ^ (((sb >> 9) & 1) << 5); R = (st >> 1) * 16 + swz / 64; C = (st & 1) * 32 + (swz % 64) / 2; }
__host__ __device__ __forceinline__ int perm32(int rho) { const int n = rho >> 4, i = rho & 15; return 8 * (i >> 2) + 4 * n + (i & 3); }

struct Unit { int pm, pn; };
struct Gemm { const bf16_t* A; const bf16_t* Bt; int M, N, K; };
struct StaticOrder {
    int nM, nN, nwg, G, c;
    __host__ __device__ void init(int M, int N, int G_, int c_) { nM = M / BM; nN = N / BM; nwg = nM * nN; G = G_; c = c_; }
    __host__ __device__ bool next(int i, Unit& u) const {
        const long L = (long)i * G + c; if (L >= nwg) return false;
        int wgid = (int)L; { const int q = nwg / NXCD, r = nwg % NXCD, xcd = wgid % NXCD, off = wgid / NXCD; wgid = (xcd < r ? xcd * (q + 1) : r * (q + 1) + (xcd - r) * q) + off; }
        const int nig = WGM * nN, gid = wgid / nig, fm = gid * WGM, gsz = (nM - fm) < WGM ? (nM - fm) : WGM;
        u.pm = fm + ((wgid % nig) % gsz); u.pn = (wgid % nig) / gsz; return true;
    }
    __device__ __forceinline__ void a_ready(const Unit&) const {}
    __device__ __forceinline__ void done(const Unit&) const {}
};
__device__ __forceinline__ unsigned cvt_pk_bf16(float lo, float hi) { unsigned r; asm volatile("v_cvt_pk_bf16_f32 %0, %1, %2" : "=v"(r) : "v"(lo), "v"(hi)); return r; }
typedef float f32x2 __attribute__((ext_vector_type(2)));
__device__ __forceinline__ f32x2 gelu_pk(f32x2 v) {
    const f32x2 av = __builtin_elementwise_abs(v), d = av * 0.2316418882f + 1.0f;
    f32x2 t; t.x = __builtin_amdgcn_rcpf(d.x); t.y = __builtin_amdgcn_rcpf(d.y);
    f32x2 q = t * 0.5307027145f + (-0.7265760135f); q = q * t + 0.7107068705f; q = q * t + (-0.142248368f); q = q * t + 0.127414796f; q = q * t;
    const f32x2 s = (v * v) * (-0.72134752044f);
    f32x2 e; e.x = __builtin_amdgcn_exp2f(s.x); e.y = __builtin_amdgcn_exp2f(s.y);
    const f32x2 m = v * (q * e), r = v - m;
    f32x2 o; o.x = v.x < 0.f ? m.x : r.x; o.y = v.y < 0.f ? m.y : r.y; return o;
}

struct EpiF32 {
    static constexpr bool PERM = false, AFTER_DRAIN = false;
    float* C; int ldc; const float* bias;
    __device__ __forceinline__ void operator()(const f32x4 (&acc)[2][2][4][2], const Unit& u, int wr, int wc, int fr, int fq) const {
        const int row0 = u.pm * BM + wr * 64 + fr, col0 = u.pn * BM + wc * 32 + 4 * fq;
        f32x4 bv[2][2];
#pragma unroll
        for (int bj = 0; bj < 2; ++bj)
#pragma unroll
            for (int n = 0; n < 2; ++n) bv[bj][n] = bias ? *(const f32x4*)(bias + col0 + bj * HALF + n * 16) : (f32x4){0.f, 0.f, 0.f, 0.f};
#pragma unroll
        for (int ai = 0; ai < 2; ++ai)
#pragma unroll
            for (int m = 0; m < 4; ++m) { float* rowp = C + (size_t)(row0 + ai * HALF + m * 16) * ldc + col0;
#pragma unroll
                for (int bj = 0; bj < 2; ++bj)
#pragma unroll
                    for (int n = 0; n < 2; ++n) *(f32x4*)(rowp + bj * HALF + n * 16) = acc[ai][bj][m][n] + bv[bj][n]; }
    }
};
template <int ACT  > struct EpiBf16 {
    static constexpr bool PERM = true, AFTER_DRAIN = false;
    bf16_t* O; int ldc; const float* bias; int split_cols; size_t split_stride;
    __device__ __forceinline__ void operator()(const f32x4 (&acc)[2][2][4][2], const Unit& u, int wr, int wc, int fr, int fq) const {
        const int row0 = u.pm * BM + wr * 64 + fr; int colt = u.pn * BM; bf16_t* base = O;
        if (split_cols) { const int t = colt / split_cols; base += (size_t)t * split_stride; colt -= t * split_cols; }
        const int col0 = colt + wc * 32 + 8 * fq, bcol0 = u.pn * BM + wc * 32 + 8 * fq;
        f32x4 bv[2][2];
#pragma unroll
        for (int bj = 0; bj < 2; ++bj)
#pragma unroll
            for (int n = 0; n < 2; ++n) bv[bj][n] = bias ? *(const f32x4*)(bias + bcol0 + bj * HALF + 4 * n) : (f32x4){0.f, 0.f, 0.f, 0.f};
#pragma unroll
        for (int ai = 0; ai < 2; ++ai)
#pragma unroll
            for (int m = 0; m < 4; ++m) { bf16_t* rowp = base + (size_t)(row0 + ai * HALF + m * 16) * ldc + col0;
#pragma unroll
                for (int bj = 0; bj < 2; ++bj) { f32x4 v0 = acc[ai][bj][m][0] + bv[bj][0], v1 = acc[ai][bj][m][1] + bv[bj][1];
                    if (ACT == 1) { f32x2 a = gelu_pk((f32x2){v0[0], v0[1]}), b = gelu_pk((f32x2){v0[2], v0[3]}), c = gelu_pk((f32x2){v1[0], v1[1]}), d = gelu_pk((f32x2){v1[2], v1[3]});
                        v0 = (f32x4){a.x, a.y, b.x, b.y}; v1 = (f32x4){c.x, c.y, d.x, d.y}; }
                    if (ACT == 2) {
#pragma unroll
                        for (int j = 0; j < 4; ++j) { v0[j] = 0.5f * v0[j] * (1.0f + erff(v0[j] * 0.70710678f)); v1[j] = 0.5f * v1[j] * (1.0f + erff(v1[j] * 0.70710678f)); } }
                    u32x4 w; w.x = cvt_pk_bf16(v0[0], v0[1]); w.y = cvt_pk_bf16(v0[2], v0[3]); w.z = cvt_pk_bf16(v1[0], v1[1]); w.w = cvt_pk_bf16(v1[2], v1[3]);
                    *(u32x4*)(rowp + bj * HALF) = w; } }
    }
};
template <class Epi, class Sched, bool STAMP = false>
__device__ __forceinline__ void gemm_phase(PG8_LAS unsigned char* lds, const Gemm g, const Sched& S, const Epi& E, unsigned long long* stamps) {
    const int tid = opq_tid(), wid = __builtin_amdgcn_readfirstlane(tid >> 6), lane = tid & 63, wr = wid >> 2, wc = wid & 3, fr = lane & 15, fq = lane >> 4;
    const int K = g.K, nt = K / BK;
    int ts_lo = 0, ts_hi = 0, nts = 0; const unsigned long long rt_entry = STAMP ? (unsigned long long)wall_clock64() : 0ull;
#define PG8_STAMP() do { if (STAMP && wid == 0 && nts < 64) { const unsigned long long _c = (unsigned long long)clock64(); \
        ts_lo = (lane == nts) ? (int)(unsigned)_c : ts_lo; ts_hi = (lane == nts) ? (int)(unsigned)(_c >> 32) : ts_hi; ++nts; } } while (0)
    PG8_STAMP();
    unsigned voffA[2], voffB[2];
#pragma unroll
    for (int i = 0; i < 2; ++i) { int R, C; stage_rc(tid * 16 + i * 8192, R, C); const int Rb = Epi::PERM ? ((R & ~31) + perm32(R & 31)) : R;
        voffA[i] = (unsigned)(R * K + C) * 2u; voffB[i] = (unsigned)(Rb * K + C) * 2u; }
    const size_t kstep = (size_t)(BK * 2);
    const size_t hstep = (size_t)HALF * K * 2;
    const size_t tstep = 2 * hstep;
    const unsigned ldsw = (unsigned)wid * 1024u;
    const int aoff = lds_byte(wr * 64 + fr, fq * 8), boff = lds_byte(wc * 32 + fr, fq * 8);
#define PG8_SA(b, h) (((b) * 2 + (h)) * HTB)
#define PG8_SB(b, h) ((4 + (b) * 2 + (h)) * HTB)
#define PG8_STAGE(bufoff, gbase, voff) do { _Pragma("unroll") for (int _i = 0; _i < 2; ++_i) \
        __builtin_amdgcn_global_load_lds((const unsigned*)((const char*)(gbase) + (voff)[_i]), (PG8_LAS unsigned*)(lds + (bufoff) + ldsw + _i * 8192), 16, 0, 0); } while (0)
#define PG8_LDA(dst, b, h) do { _Pragma("unroll") for (int m = 0; m < 4; ++m) _Pragma("unroll") for (int k = 0; k < 2; ++k) dst[m][k] = *(const PG8_LAS bf16x8*)(lds + PG8_SA(b, h) + aoff + m * 2048 + k * 1024); } while (0)
#define PG8_LDB(dst, b, h) do { _Pragma("unroll") for (int n = 0; n < 2; ++n) _Pragma("unroll") for (int k = 0; k < 2; ++k) dst[n][k] = *(const PG8_LAS bf16x8*)(lds + PG8_SB(b, h) + boff + n * 2048 + k * 1024); } while (0)
#define PG8_MMA(ai, bj, At, Bt) do { __builtin_amdgcn_s_setprio(1); _Pragma("unroll") for (int m = 0; m < 4; ++m) _Pragma("unroll") for (int n = 0; n < 2; ++n) _Pragma("unroll") for (int k = 0; k < 2; ++k) \
        acc[ai][bj][m][n] = __builtin_amdgcn_mfma_f32_16x16x32_bf16(Bt[n][k], At[m][k], acc[ai][bj][m][n], 0, 0, 0); __builtin_amdgcn_s_setprio(0); } while (0)
#define PG8_WAIT_V(n) asm volatile("s_waitcnt vmcnt(" #n ")" ::: "memory")
#define PG8_WAIT_L(n) asm volatile("s_waitcnt lgkmcnt(" #n ")" ::: "memory")
#define PG8_BAR __builtin_amdgcn_s_barrier()
#define PG8_SCHED __builtin_amdgcn_sched_barrier(0)
    Unit cur, nxt; int ui = 0;
    if (!S.next(0, cur)) return;
    f32x4 acc[2][2][4][2];
#pragma unroll
    for (int a = 0; a < 2; ++a)
#pragma unroll
        for (int b = 0; b < 2; ++b)
#pragma unroll
            for (int m = 0; m < 4; ++m)
#pragma unroll
                for (int n = 0; n < 2; ++n) acc[a][b][m][n] = (f32x4){0.f, 0.f, 0.f, 0.f};
    bf16x8 At[4][2], B0[2][2], B1[2][2];
    const char* cA = (const char*)g.A + (size_t)cur.pm * tstep; const char* cB = (const char*)g.Bt + (size_t)cur.pn * tstep;
    S.a_ready(cur);
    PG8_STAGE(PG8_SB(0, 0), cB, voffB); PG8_STAGE(PG8_SA(0, 0), cA, voffA); PG8_STAGE(PG8_SB(0, 1), cB + hstep, voffB); PG8_STAGE(PG8_SA(0, 1), cA + hstep, voffA);
    if (wr == 1) PG8_BAR;
    PG8_WAIT_V(4); PG8_BAR;
    PG8_STAGE(PG8_SB(1, 0), cB + kstep, voffB); PG8_STAGE(PG8_SA(1, 0), cA + kstep, voffA); PG8_STAGE(PG8_SB(1, 1), cB + hstep + kstep, voffB);
    PG8_WAIT_V(6); PG8_BAR;
    PG8_STAMP();
    for (;;) {
        const bool has_next = S.next(ui + 1, nxt);
        const char* nA = has_next ? (const char*)g.A + (size_t)nxt.pm * tstep : cA; const char* nB = has_next ? (const char*)g.Bt + (size_t)nxt.pn * tstep : cB;
        for (int t = 0; t < nt; t += 2) {
            const bool last = (t == nt - 2);
            const char* a1 = cA + (size_t)(t + 1) * kstep;
            const char* a2 = last ? nA : cA + (size_t)(t + 2) * kstep; const char* b2 = last ? nB : cB + (size_t)(t + 2) * kstep;
            const char* a3 = a2 + kstep; const char* b3 = b2 + kstep;
            if (last && has_next) S.a_ready(nxt);
            PG8_LDB(B0, 0, 0); PG8_SCHED; PG8_LDA(At, 0, 0); PG8_STAGE(PG8_SA(1, 1), a1 + hstep, voffA);
            PG8_WAIT_L(8); PG8_BAR; PG8_WAIT_L(0); PG8_MMA(0, 0, At, B0); PG8_BAR; PG8_SCHED;
            PG8_LDB(B1, 0, 1); PG8_STAGE(PG8_SB(0, 0), b2, voffB);
            PG8_BAR; PG8_WAIT_L(0); PG8_MMA(0, 1, At, B1); PG8_BAR;
            PG8_LDA(At, 0, 1); PG8_STAGE(PG8_SA(0, 0), a2, voffA);
            PG8_BAR; PG8_WAIT_L(0); PG8_MMA(1, 0, At, B0); PG8_BAR; PG8_SCHED;
            PG8_STAGE(PG8_SB(0, 1), b2 + hstep, voffB);
            PG8_WAIT_V(6); PG8_BAR; PG8_MMA(1, 1, At, B1); PG8_BAR;
            PG8_LDB(B0, 1, 0); PG8_SCHED; PG8_LDA(At, 1, 0); PG8_STAGE(PG8_SA(0, 1), a2 + hstep, voffA);
            PG8_WAIT_L(8); PG8_BAR; PG8_WAIT_L(0); PG8_MMA(0, 0, At, B0); PG8_BAR; PG8_SCHED;
            PG8_LDB(B1, 1, 1); PG8_STAGE(PG8_SB(1, 0), b3, voffB);
            PG8_BAR; PG8_WAIT_L(0); PG8_MMA(0, 1, At, B1); PG8_BAR;
            PG8_LDA(At, 1, 1); PG8_STAGE(PG8_SA(1, 0), a3, voffA);
            PG8_BAR; PG8_WAIT_L(0); PG8_MMA(1, 0, At, B0); PG8_BAR; PG8_SCHED;
            PG8_STAGE(PG8_SB(1, 1), b3 + hstep, voffB);
            PG8_WAIT_V(6); PG8_BAR; PG8_MMA(1, 1, At, B1); PG8_BAR;
        }
        PG8_STAMP();
        if constexpr (!Epi::AFTER_DRAIN) { E(acc, cur, wr, wc, fr, fq); S.done(cur); }
        PG8_STAMP();
        if (!has_next) break;
#pragma unroll
        for (int a = 0; a < 2; ++a)
#pragma unroll
            for (int b = 0; b < 2; ++b)
#pragma unroll
                for (int m = 0; m < 4; ++m)
#pragma unroll
                    for (int n = 0; n < 2; ++n) acc[a][b][m][n] = (f32x4){0.f, 0.f, 0.f, 0.f};
        cur = nxt; cA = nA; cB = nB; ++ui;
    }
    PG8_WAIT_V(0);
    if (wr == 0) PG8_BAR;
    PG8_BAR;
    if constexpr (Epi::AFTER_DRAIN) { E.fused(acc, cur, wr, wc, fr, fq, lds, wid, lane); S.done(cur); }
    PG8_STAMP();
    if (STAMP && wid == 0) { stamps[lane] = lane < nts ? (((unsigned long long)(unsigned)ts_hi << 32) | (unsigned)ts_lo) : 0ull;
        if (lane == 62) stamps[62] = rt_entry; if (lane == 63) stamps[63] = (unsigned long long)wall_clock64(); }
#undef PG8_STAMP
#undef PG8_SA
#undef PG8_SB
#undef PG8_STAGE
#undef PG8_LDA
#undef PG8_LDB
#undef PG8_MMA
#undef PG8_WAIT_V
#undef PG8_WAIT_L
#undef PG8_BAR
#undef PG8_SCHED
}
}
#include <cstdint>
#include <cstdlib>
#include <vector>

#define XB_TMO      128
#define XB_XCNT(j)  (256  + 64 * (j))
#define XB_XSUB(j)  (1280 + 64 * (j))
#define XB_XGEN(j)  (2304 + 64 * (j))
#define XB_TOP      3328
#define XB_TOPGEN   3392
#define XCD_BAR_WORDS 3456
#define XB_SPIN_CAP (1u << 18)
#define XLAS __attribute__((address_space(3)))

__device__ __forceinline__ unsigned xb_ld(unsigned* p)              { return __hip_atomic_load(p, __ATOMIC_RELAXED, __HIP_MEMORY_SCOPE_AGENT); }
__device__ __forceinline__ unsigned xb_add(unsigned* p, unsigned v) { return __hip_atomic_fetch_add(p, v, __ATOMIC_RELAXED, __HIP_MEMORY_SCOPE_AGENT); }
__device__ __forceinline__ unsigned xb_xcc_id() { return (unsigned)__builtin_amdgcn_s_getreg((3 << 11) | 20) & 0xFu; }
#define XB_SPIN(cond, bar) do { unsigned _sp = 0; while (cond) { __builtin_amdgcn_s_sleep(1); \
    if ((++_sp & 255u) == 0u) { if (xb_ld(&(bar)[XB_TMO])) break; if (_sp > XB_SPIN_CAP) { atomicAdd(&(bar)[XB_TMO], 1u); break; } } } } while (0)

struct XcdBarrier {
    unsigned* bar; unsigned x;
    volatile XLAS unsigned* st;
};

__device__ __forceinline__ XcdBarrier xcd_barrier_post(unsigned* bar, volatile XLAS unsigned* st) {
    XcdBarrier b; b.bar = bar; b.x = xb_xcc_id(); b.st = st;
    if (threadIdx.x == 0) (void)xb_add(&bar[XB_XCNT(b.x)], 1u);
    return b;
}
__device__ __forceinline__ void xcd_barrier_complete(unsigned* bar, unsigned x, unsigned& nloc, unsigned& nx) {
    const unsigned G = gridDim.x * gridDim.y * gridDim.z;
    unsigned sum, cnt, mine, sp = 0u;
    for (;;) {
        sum = 0u; cnt = 0u; mine = 0u;
#pragma unroll
        for (unsigned j = 0; j < 16; ++j) { const unsigned c = xb_ld(&bar[XB_XCNT(j)]); sum += c; cnt += (c > 0u) ? 1u : 0u; mine = (j == x) ? c : mine; }
        if (sum == G) break;
        __builtin_amdgcn_s_sleep(1);
        if ((++sp & 255u) == 0u) { if (xb_ld(&bar[XB_TMO])) break; if (sp > XB_SPIN_CAP) { atomicAdd(&bar[XB_TMO], 1u); break; } }
    }
    nloc = mine > 0u ? mine : 1u; nx = cnt > 0u ? cnt : 1u;
}

__device__ __forceinline__ void xcd_barrier(const XcdBarrier& b) {
    asm volatile("s_waitcnt vmcnt(0)" ::: "memory");
    __syncthreads();
    if (threadIdx.x == 0) {
        unsigned* bar = b.bar;
        __builtin_amdgcn_s_waitcnt(0);
        unsigned nloc = b.st[0], nx = b.st[1];
        if (nloc == 0u) { xcd_barrier_complete(bar, b.x, nloc, nx); b.st[0] = nloc; b.st[1] = nx; }
        const unsigned old = xb_add(&bar[XB_XSUB(b.x)], 1u);
        const unsigned gen = old / nloc;
        if (old + 1u == (gen + 1u) * nloc) {
            __builtin_amdgcn_fence(__ATOMIC_RELEASE, "agent");
            asm volatile("s_waitcnt vmcnt(0)" ::: "memory");
            const unsigned og = xb_add(&bar[XB_TOP], 1u);
            const unsigned tg = og / nx;
            if (og + 1u == (tg + 1u) * nx) xb_add(&bar[XB_TOPGEN], 1u);
            else XB_SPIN(xb_ld(&bar[XB_TOPGEN]) == tg, bar);
            __builtin_amdgcn_fence(__ATOMIC_ACQUIRE, "agent");
            xb_add(&bar[XB_XGEN(b.x)], 1u);
            asm volatile("s_waitcnt vmcnt(0)" ::: "memory");
        } else {
            XB_SPIN(xb_ld(&bar[XB_XGEN(b.x)]) == gen, bar);
            __builtin_amdgcn_fence(__ATOMIC_ACQUIRE, "agent");
            asm volatile("s_waitcnt vmcnt(0)" ::: "memory");
        }
    }
    __syncthreads();
}

#ifndef SKIP
#define SKIP 0
#endif
#ifndef PROBE_KIND
#define PROBE_KIND 0
#define PROBE_N 0
#endif
#define LAS PG8_LAS
typedef pg8::bf16_t bf16_t;
typedef pg8::bf16x8 bf16x8;
typedef pg8::f32x4 f32x4;
typedef pg8::u32x4 u32x4;
typedef unsigned u32x2 __attribute__((ext_vector_type(2)));
constexpr int NP = 16384, NS = 128, NR = NP + NS, MPAD = 16640, DM = 1024, DIN = 3080;
constexpr int LDS_BYTES = 131072 + 16;
constexpr size_t OYS = 16777216, OPP = 16908288, OCP = 17031168, OSP = 17104896, OPS = 18153472, OCS = 20119552, OSS = 21299200;
constexpr size_t WS_WTIN = 0;
constexpr size_t WS_WTOUT = WS_WTIN + 12582912;
constexpr size_t WS_WTPOOL = WS_WTOUT + 4194304;
constexpr size_t WS_MOD = WS_WTPOOL + 262144;
constexpr size_t WS_H = WS_MOD + 6291456;
constexpr size_t WS_P0 = WS_H + 34078720;
constexpr size_t WS_P1 = WS_P0 + 34078720;
constexpr size_t WS_P2 = WS_P1 + 34078720;
constexpr size_t WS_G = WS_P2 + 34078720;
constexpr size_t WS_BETA = WS_G + 264192;
constexpr size_t WS_GL = WS_BETA + 264192;
constexpr size_t WS_W = WS_GL + 4096;
constexpr size_t WS_QG = WS_W + 16777216;
constexpr size_t WS_KGT = WS_QG + 16777216;
constexpr size_t WS_QK = WS_KGT + 16777216;
constexpr size_t WS_U = WS_QK + 8388608;
constexpr size_t WS_WTADA = WS_U;
constexpr size_t WS_AC = WS_U + 12582912;
constexpr size_t WS_BAR = WS_U + 33554432;
constexpr size_t WS_END = WS_BAR + 16384;

struct Params {
    const float* x_prompt; const float* x_sample; const float* c_prompt; const float* c_sample;
    const float* state_pool; const float* state_conv; const float* state_ssm;
    const float* w_ada; const float* b_ada; const float* pre_norm_w; const float* post_norm_w; const float* w_in; const float* conv_w;
    const float* pool_w; const float* pool_scale; const float* a_log; const float* dt_bias; const float* o_norm_w; const float* w_out;
    float* out; unsigned char* ws; int ph_lo, ph_hi;
};

__device__ __forceinline__ float bf2f(unsigned short b) { return __uint_as_float(((unsigned)b) << 16); }
typedef __bf16 bf16x2_t __attribute__((ext_vector_type(2)));
typedef float f32x2_t __attribute__((ext_vector_type(2)));
__device__ __forceinline__ unsigned pk2(float lo, float hi) { f32x2_t v = {lo, hi}; bf16x2_t r = __builtin_convertvector(v, bf16x2_t); unsigned u; __builtin_memcpy(&u, &r, 4); return u; }
__device__ __forceinline__ unsigned short f2bf(float f) { return (unsigned short)(pk2(f, 0.f) & 0xffffu); }
__device__ __forceinline__ float silu_f(float x) { return x * __builtin_amdgcn_rcpf(1.0f + __expf(-x)); }
__device__ __forceinline__ void unpack8(const u32x4 v, float* x) {
    x[0] = __uint_as_float(v.x << 16); x[1] = __uint_as_float(v.x & 0xffff0000u); x[2] = __uint_as_float(v.y << 16); x[3] = __uint_as_float(v.y & 0xffff0000u);
    x[4] = __uint_as_float(v.z << 16); x[5] = __uint_as_float(v.z & 0xffff0000u); x[6] = __uint_as_float(v.w << 16); x[7] = __uint_as_float(v.w & 0xffff0000u);
}
__device__ __forceinline__ u32x4 pack8(const float* x) { u32x4 w; w.x = pk2(x[0], x[1]); w.y = pk2(x[2], x[3]); w.z = pk2(x[4], x[5]); w.w = pk2(x[6], x[7]); return w; }
__device__ __forceinline__ float wave_sum(float v) {
#pragma unroll
    for (int o = 32; o >= 1; o >>= 1) v += __shfl_xor(v, o);
    return v;
}

__device__ __forceinline__ void transpose_tile(const float* __restrict__ src, int ld, bf16_t* __restrict__ dst, int ldd, int k0, int n0, LAS float* tile) {
    const int tid = opq_tid();
#pragma unroll
    for (int p = 0; p < 2; ++p) {
        const int kk = (tid >> 4) + 32 * p, n4 = (tid & 15) * 4;
        const float4 v = *(const float4*)(src + (size_t)(k0 + kk) * ld + n0 + n4);
        tile[kk * 65 + n4 + 0] = v.x; tile[kk * 65 + n4 + 1] = v.y; tile[kk * 65 + n4 + 2] = v.z; tile[kk * 65 + n4 + 3] = v.w;
    }
    __syncthreads();
    const int n = tid >> 3, k8 = (tid & 7) * 8;
    float x[8];
#pragma unroll
    for (int i = 0; i < 8; ++i) x[i] = tile[(k8 + i) * 65 + n];
    *(u32x4*)(dst + (size_t)(n0 + n) * ldd + k0 + k8) = pack8(x);
    __syncthreads();
}

__device__ __forceinline__ void phase_convert(const Params& p, LAS unsigned char* lds, int part) {
    LAS float* tile = (LAS float*)lds;
    bf16_t* WtIn = (bf16_t*)(p.ws + WS_WTIN); bf16_t* WtAda = (bf16_t*)(p.ws + WS_WTADA); bf16_t* WtOut = (bf16_t*)(p.ws + WS_WTOUT); bf16_t* WtPool = (bf16_t*)(p.ws + WS_WTPOOL);
    const int nb = part == 0 ? (int)gridDim.x : ((int)gridDim.x > 48 ? (int)gridDim.x - 24 : (int)gridDim.x);
    const int b0 = part == 0 ? (int)blockIdx.x : ((int)gridDim.x > 48 ? (int)blockIdx.x - 24 : (int)blockIdx.x);
    if (b0 >= 0) for (int t0 = b0; t0 < (part == 0 ? 1536 : 2080); t0 += nb) {
        const int t = part == 0 ? t0 + 1536 : (t0 < 1536 ? t0 : t0 + 1536);
        if (t < 1536) { const int l = t / 768, rem = t % 768; transpose_tile(p.w_in + (size_t)l * 1024 * DIN, DIN, WtIn + (size_t)l * 3072 * 1024, 1024, (rem / 48) * 64, (rem % 48) * 64, tile); }
        else if (t < 3072) { const int tt = t - 1536, l = tt / 768, rem = tt % 768; transpose_tile(p.w_ada + (size_t)l * 1024 * 3072, 3072, WtAda + (size_t)l * 3072 * 1024, 1024, (rem / 48) * 64, (rem % 48) * 64, tile); }
        else if (t < 3584) { const int tt = t - 3072, l = tt / 256, rem = tt % 256; transpose_tile(p.w_out + (size_t)l * 1024 * 1024, 1024, WtOut + (size_t)l * 1024 * 1024, 1024, (rem / 16) * 64, (rem % 16) * 64, tile); }
        else { const int tt = t - 3584, lg = tt / 4, rem = tt % 4; transpose_tile(p.pool_w + (size_t)lg * 16384, 128, WtPool + (size_t)lg * 16384, 128, (rem / 2) * 64, (rem % 2) * 64, tile); }
    }
    bf16_t* Ac = (bf16_t*)(p.ws + WS_AC);
    if (part == 0) for (int i = blockIdx.x * 512 + opq_tid(); i < 65536; i += gridDim.x * 512) {
        const int row = i >> 8, c4 = (i & 255) * 4;
        float4 v = make_float4(0.f, 0.f, 0.f, 0.f);
        if (row < 8) v = *(const float4*)(p.c_prompt + row * 1024 + c4); else if (row < 136) v = *(const float4*)(p.c_sample + (row - 8) * 1024 + c4);
        uint2 w; w.x = pk2(silu_f(v.x), silu_f(v.y)); w.y = pk2(silu_f(v.z), silu_f(v.w));
        *(uint2*)(Ac + row * 1024 + c4) = w;
    }
}

struct RowVecs { float4 gp[4], sh[4], ps[4]; };
__device__ __forceinline__ void row_body(const Params& p, int lF, int lA, int row, int lane, float4 (&yv)[4], float4 (&xv)[4], const RowVecs& v, LAS float* W8t) {
    float* xout = p.out + (size_t)row * 1024;
    bf16_t* H = (bf16_t*)(p.ws + WS_H);
    float* Gd = (float*)(p.ws + WS_G); float* Bd = (float*)(p.ws + WS_BETA);
    if (lF >= 0) {
        float ss = 0.f;
#pragma unroll
        for (int i = 0; i < 4; ++i) ss += yv[i].x * yv[i].x + yv[i].y * yv[i].y + yv[i].z * yv[i].z + yv[i].w * yv[i].w;
        ss = wave_sum(ss);
        const float rstd = rsqrtf(ss * (1.0f / 1024.0f) + 1e-6f);
#pragma unroll
        for (int i = 0; i < 4; ++i) {
            const int c = lane * 4 + 256 * i;
            xv[i].x += v.gp[i].x * (yv[i].x * rstd); xv[i].y += v.gp[i].y * (yv[i].y * rstd);
            xv[i].z += v.gp[i].z * (yv[i].z * rstd); xv[i].w += v.gp[i].w * (yv[i].w * rstd);
            *(float4*)(xout + c) = xv[i];
        }
    }
    if (lA >= 0) {
        asm volatile("" ::: "memory");
        float ss = 0.f;
#pragma unroll
        for (int i = 0; i < 4; ++i) ss += xv[i].x * xv[i].x + xv[i].y * xv[i].y + xv[i].z * xv[i].z + xv[i].w * xv[i].w;
        ss = wave_sum(ss);
        const float rstd = rsqrtf(ss * (1.0f / 1024.0f) + 1e-6f);
        float d[8];
#pragma unroll
        for (int j = 0; j < 8; ++j) d[j] = 0.f;
#pragma unroll
        for (int i = 0; i < 4; ++i) {
            const int c = lane * 4 + 256 * i;
            float4 hv;
            hv.x = xv[i].x * rstd * v.ps[i].x + v.sh[i].x; hv.y = xv[i].y * rstd * v.ps[i].y + v.sh[i].y;
            hv.z = xv[i].z * rstd * v.ps[i].z + v.sh[i].z; hv.w = xv[i].w * rstd * v.ps[i].w + v.sh[i].w;
            uint2 w; w.x = pk2(hv.x, hv.y); w.y = pk2(hv.z, hv.w);
            *(uint2*)(H + (size_t)row * 1024 + c) = w;
#pragma unroll
            for (int j = 0; j < 8; ++j) { const f32x4 wv = *(const LAS f32x4*)(W8t + j * 1024 + c); d[j] += hv.x * wv[0] + hv.y * wv[1] + hv.z * wv[2] + hv.w * wv[3]; }
        }
#pragma unroll
        for (int j = 0; j < 8; ++j) d[j] = wave_sum(d[j]);
        if (lane < 4) {
            const float br = lane == 0 ? d[0] : lane == 1 ? d[1] : lane == 2 ? d[2] : d[3];
            const float ar = lane == 0 ? d[4] : lane == 1 ? d[5] : lane == 2 ? d[6] : d[7];
            const float xs = ar + p.dt_bias[lA * 4 + lane];
            const float sp = fmaxf(xs, 0.f) + log1pf(__expf(-fabsf(xs)));
            Bd[row * 4 + lane] = 1.0f / (1.0f + __expf(-br));
            Gd[row * 4 + lane] = -__expf(p.a_log[lA * 4 + lane]) * sp;
        }
    }
}
__device__ __forceinline__ void row_vecs(RowVecs& v, const Params& p, int lF, int lA, int mrow, int lane) {
    const float* mod = (const float*)(p.ws + WS_MOD) + (size_t)mrow * 6144;
#pragma unroll
    for (int i = 0; i < 4; ++i) {
        const int c = lane * 4 + 256 * i;
        if (lF >= 0) { const float4 g = *(const float4*)(mod + lF * 3072 + 2048 + c), w = *(const float4*)(p.post_norm_w + lF * 1024 + c); v.gp[i] = make_float4(g.x * w.x, g.y * w.y, g.z * w.z, g.w * w.w); }
        if (lA >= 0) { v.sh[i] = *(const float4*)(mod + lA * 3072 + c); const float4 sc = *(const float4*)(mod + lA * 3072 + 1024 + c), w = *(const float4*)(p.pre_norm_w + lA * 1024 + c);
                       v.ps[i] = make_float4(w.x * (1.0f + sc.x), w.y * (1.0f + sc.y), w.z * (1.0f + sc.z), w.w * (1.0f + sc.w)); }
    }
}
__device__ __forceinline__ void row_load(const Params& p, int lF, int row, int lane, float4 (&yv)[4], float4 (&xv)[4]) {
    const float* xorig = row < NP ? p.x_prompt + (size_t)row * 1024 : p.x_sample + (size_t)(row - NP) * 1024;
    const float* xsrc = (lF <= 0) ? xorig : p.out + (size_t)row * 1024;
    const bf16_t* yrow = (const bf16_t*)(p.ws + WS_P0) + (size_t)row * 1024;
#pragma unroll
    for (int i = 0; i < 4; ++i) {
        xv[i] = *(const float4*)(xsrc + lane * 4 + 256 * i);
        if (lF >= 0) { const uint2 t = *(const uint2*)(yrow + lane * 4 + 256 * i); yv[i] = make_float4(__uint_as_float(t.x << 16), __uint_as_float(t.x & 0xffff0000u), __uint_as_float(t.y << 16), __uint_as_float(t.y & 0xffff0000u)); }
    }
}
__device__ __forceinline__ void phase_rows(const Params& p, int lF, int lA, LAS unsigned char* lds) {
    const int tid = opq_tid(), wid = tid >> 6, lane = tid & 63;
    LAS float* W8t = (LAS float*)lds;
    if (lA >= 0) {
        for (int i = tid; i < 8192; i += 512) { const int k = i >> 3, j = i & 7; W8t[j * 1024 + k] = p.w_in[(size_t)lA * 1024 * DIN + (size_t)k * DIN + 3072 + j]; }
        __syncthreads();
    }
    const int nwaves = (int)gridDim.x * 8, gw = (int)blockIdx.x * 8 + wid;
    for (int r0 = gw * 8; r0 < NP; r0 += nwaves * 8) {
        RowVecs v; row_vecs(v, p, lF, lA, r0 >> 11, lane);
        float4 ya[4], xa[4], yb[4], xb[4];
        row_load(p, lF, r0, lane, ya, xa);
#pragma unroll 1
        for (int rr = 0; rr < 8; rr += 2) {
            row_load(p, lF, r0 + rr + 1, lane, yb, xb);
            row_body(p, lF, lA, r0 + rr, lane, ya, xa, v, W8t);
            if (rr + 2 < 8) row_load(p, lF, r0 + rr + 2, lane, ya, xa);
            row_body(p, lF, lA, r0 + rr + 1, lane, yb, xb, v, W8t);
        }
    }
    for (int row = NP + gw; row < NR; row += nwaves) {
        RowVecs v; row_vecs(v, p, lF, lA, 8 + row - NP, lane);
        float4 ya[4], xa[4];
        row_load(p, lF, row, lane, ya, xa);
        row_body(p, lF, lA, row, lane, ya, xa, v, W8t);
    }
}

__device__ __forceinline__ void conv16(const u32x4 (&xr)[4][2], int tok, const LAS float* cw, float* out, float* xcur) {
    float acc[16];
#pragma unroll
    for (int i = 0; i < 16; ++i) acc[i] = 0.f;
#pragma unroll
    for (int j = 0; j < 4; ++j) {
        const bool valid = (tok - 3 + j) >= 0;
        float x[16]; unpack8(xr[j][0], x); unpack8(xr[j][1], x + 8);
#pragma unroll
        for (int q = 0; q < 4; ++q) {
            const f32x4 w = *(const LAS f32x4*)(cw + j * 128 + 4 * q);
            const float x0 = valid ? x[4 * q] : 0.f, x1 = valid ? x[4 * q + 1] : 0.f, x2 = valid ? x[4 * q + 2] : 0.f, x3 = valid ? x[4 * q + 3] : 0.f;
            acc[4 * q] += x0 * w[0]; acc[4 * q + 1] += x1 * w[1]; acc[4 * q + 2] += x2 * w[2]; acc[4 * q + 3] += x3 * w[3];
        }
        if (j == 3) {
#pragma unroll
            for (int i = 0; i < 16; ++i) xcur[i] = x[i];
        }
    }
#pragma unroll
    for (int i = 0; i < 16; ++i) out[i] = silu_f(acc[i]);
}

template <int STOP> __device__ __forceinline__ void chunk_item(const Params& p, int l, int idx, LAS unsigned char* lds) {
    const int tid = opq_tid(), wid = tid >> 6, lane = tid & 63;
    const int b = idx >> 7, h = (idx >> 5) & 3, n = idx & 31, R0 = b * 2048 + n * 64;
    LAS bf16_t* KB = (LAS bf16_t*)lds; LAS bf16_t* QB = (LAS bf16_t*)(lds + 17408);
    LAS float* AT = (LAS float*)(lds + 34816); LAS float* RHS = (LAS float*)(lds + 51200);
    LAS float* GC = (LAS float*)(lds + 116736); LAS float* BT = GC + 64; LAS float* EG = GC + 128;
    const float* Gd = (const float*)(p.ws + WS_G); const float* Bd = (const float*)(p.ws + WS_BETA);
    const bf16_t* P1 = (const bf16_t*)(p.ws + WS_P1); const bf16_t* P2 = (const bf16_t*)(p.ws + WS_P2);
    bf16_t* Wd = (bf16_t*)(p.ws + WS_W) + (size_t)idx * 8192; bf16_t* QGd = (bf16_t*)(p.ws + WS_QG) + (size_t)idx * 8192;
    bf16_t* KGTd = (bf16_t*)(p.ws + WS_KGT) + (size_t)idx * 8192; bf16_t* QKd = (bf16_t*)(p.ws + WS_QK) + (size_t)idx * 4096;
    bf16_t* Ud = (bf16_t*)(p.ws + WS_U) + (size_t)idx * 8192; float* GLd = (float*)(p.ws + WS_GL);
    const int et = tid >> 3, ec0 = (tid & 7) * 16, etok = n * 64 + et;
    u32x4 xr[3][4][2];
#pragma unroll
    for (int a = 0; a < 3; ++a) {
        const bf16_t* base = (a == 0 ? P1 + h * 128 : a == 1 ? P1 + 512 + h * 128 : P2 + h * 128) + ec0;
#pragma unroll
        for (int j = 0; j < 4; ++j) {
            const int tj = etok - 3 + j, tjc = tj < 0 ? 0 : tj;
            const bf16_t* ptr = base + (size_t)(b * 2048 + tjc) * 1024;
            xr[a][j][0] = *(const u32x4*)ptr; xr[a][j][1] = *(const u32x4*)(ptr + 8);
        }
    }
    LAS float* CW = (LAS float*)(lds + 117504);
    if (tid >= 128) { const int ci = tid - 128, a = ci >> 7, d = ci & 127;
#pragma unroll
        for (int j = 0; j < 4; ++j) CW[(a * 4 + j) * 128 + d] = p.conv_w[(size_t)l * 4 * 1536 + j * 1536 + a * 512 + h * 128 + d]; }
    if (tid < 64) {
        float v = Gd[(R0 + tid) * 4 + h];
#pragma unroll
        for (int o = 1; o < 64; o <<= 1) { const float t = __shfl_up(v, o); if (lane >= o) v += t; }
        GC[tid] = v; BT[tid] = Bd[(R0 + tid) * 4 + h]; const float e = __expf(v); EG[tid] = e;
        if (tid == 63) GLd[idx] = e;
    }
    __syncthreads();
    if (STOP == 1) { if (xr[0][0][0][0] == 0x12345u && xr[2][3][1][3] == 0x54321u) GLd[idx] = 0.f; return; }
    {
        const int t = et, c0 = ec0, tok = etok;
        const float bt = BT[t], eg = EG[t];
        float s[16], xc[16];
        conv16(xr[0], tok, CW + c0, s, xc);
        if (n == 31 && t >= 61) { float* o = p.out + OCP + ((size_t)(l * 8 + b) * 3 + (t - 61)) * 1536 + h * 128 + c0;
#pragma unroll
            for (int i = 0; i < 16; ++i) o[i] = xc[i]; }
        float ss = 0.f;
#pragma unroll
        for (int i = 0; i < 16; ++i) ss += s[i] * s[i];
        ss += __shfl_xor(ss, 1); ss += __shfl_xor(ss, 2); ss += __shfl_xor(ss, 4);
        float rs = rsqrtf(ss + 1e-6f) * 0.08838834764831845f;
        float qn[16];
#pragma unroll
        for (int i = 0; i < 16; ++i) qn[i] = s[i] * rs;
        *(LAS u32x4*)(QB + t * 136 + c0) = pack8(qn); *(LAS u32x4*)(QB + t * 136 + c0 + 8) = pack8(qn + 8);
#pragma unroll
        for (int i = 0; i < 16; ++i) qn[i] *= eg;
        *(u32x4*)(QGd + (((((t >> 4) * 4 + (c0 >> 5)) * 4 + ((c0 >> 3) & 3)) * 16 + (t & 15)) * 8)) = pack8(qn);
        *(u32x4*)(QGd + (((((t >> 4) * 4 + ((c0 + 8) >> 5)) * 4 + (((c0 + 8) >> 3) & 3)) * 16 + (t & 15)) * 8)) = pack8(qn + 8);
        conv16(xr[1], tok, CW + 512 + c0, s, xc);
        if (n == 31 && t >= 61) { float* o = p.out + OCP + ((size_t)(l * 8 + b) * 3 + (t - 61)) * 1536 + 512 + h * 128 + c0;
#pragma unroll
            for (int i = 0; i < 16; ++i) o[i] = xc[i]; }
        ss = 0.f;
#pragma unroll
        for (int i = 0; i < 16; ++i) ss += s[i] * s[i];
        ss += __shfl_xor(ss, 1); ss += __shfl_xor(ss, 2); ss += __shfl_xor(ss, 4);
        rs = rsqrtf(ss + 1e-6f);
#pragma unroll
        for (int i = 0; i < 16; ++i) s[i] *= rs;
        *(LAS u32x4*)(KB + t * 136 + c0) = pack8(s); *(LAS u32x4*)(KB + t * 136 + c0 + 8) = pack8(s + 8);
        const float be = bt * eg;
#pragma unroll
        for (int i = 0; i < 16; i += 4) *(LAS f32x4*)(RHS + t * 256 + 128 + c0 + i) = (f32x4){s[i] * be, s[i + 1] * be, s[i + 2] * be, s[i + 3] * be};
        conv16(xr[2], tok, CW + 1024 + c0, s, xc);
        if (n == 31 && t >= 61) { float* o = p.out + OCP + ((size_t)(l * 8 + b) * 3 + (t - 61)) * 1536 + 1024 + h * 128 + c0;
#pragma unroll
            for (int i = 0; i < 16; ++i) o[i] = xc[i]; }
#pragma unroll
        for (int i = 0; i < 16; i += 4) *(LAS f32x4*)(RHS + t * 256 + c0 + i) = (f32x4){s[i] * bt, s[i + 1] * bt, s[i + 2] * bt, s[i + 3] * bt};
    }
    __syncthreads();
    if (STOP == 2) return;
    {
        const int lr = lane & 15, lq = lane >> 4;
#pragma unroll 1
        for (int jj = 0; jj < 4; ++jj) {
            const int job = wid * 4 + jj, which = job >> 4, tile = job & 15, mi = tile >> 2, nj = tile & 3;
            LAS bf16_t* As = which ? QB : KB;
            f32x4 acc = {0.f, 0.f, 0.f, 0.f};
            if (!which) {
#pragma unroll
                for (int s = 0; s < 4; ++s) {
                    const bf16x8 a = *(const LAS bf16x8*)(As + (16 * mi + lr) * 136 + 32 * s + 8 * lq);
                    const bf16x8 bb = *(const LAS bf16x8*)(KB + (16 * nj + lr) * 136 + 32 * s + 8 * lq);
                    acc = __builtin_amdgcn_mfma_f32_16x16x32_bf16(a, bb, acc, 0, 0, 0);
                }
                const int j = 16 * nj + lr, i0 = 16 * mi + 4 * lq;
                const float gj = GC[j];
                f32x4 o;
#pragma unroll
                for (int r = 0; r < 4; ++r) { const int i = i0 + r; o[r] = (i > j) ? BT[i] * acc[r] * __expf(GC[i] - gj) : 0.f; }
                *(LAS f32x4*)(AT + j * 64 + i0) = o;
            } else {
#pragma unroll
                for (int s = 0; s < 4; ++s) {
                    const bf16x8 a = *(const LAS bf16x8*)(As + (16 * mi + lr) * 136 + 32 * s + 8 * lq);
                    const bf16x8 bb = *(const LAS bf16x8*)(KB + (16 * nj + lr) * 136 + 32 * s + 8 * lq);
                    acc = __builtin_amdgcn_mfma_f32_16x16x32_bf16(bb, a, acc, 0, 0, 0);
                }
                const int i = 16 * mi + lr, j0 = 16 * nj + 4 * lq;
                const float gi = GC[i];
                float v[4];
#pragma unroll
                for (int r = 0; r < 4; ++r) { const int j = j0 + r; v[r] = (i >= j) ? acc[r] * __expf(gi - GC[j]) : 0.f; }
                u32x2 w; w.x = pk2(v[0], v[1]); w.y = pk2(v[2], v[3]);
                *(u32x2*)(QKd + ((((mi * 2 + (j0 >> 5)) * 4 + ((j0 >> 3) & 3)) * 16 + lr) * 8 + (j0 & 7))) = w;
            }
        }
    }
    __syncthreads();
    if (STOP == 3) return;
    if (tid < 256) {
        const int c = tid;
        float r[64];
#pragma unroll
        for (int i = 0; i < 64; ++i) r[i] = RHS[i * 256 + c];
        f32x4 ab[2][16];
#pragma unroll
        for (int q = 0; q < 16; ++q) ab[0][q] = *(const LAS f32x4*)(AT + 0 * 64 + 4 * q);
#pragma unroll
        for (int j = 0; j < 63; ++j) {
            if (j + 1 < 63) {
#pragma unroll
                for (int i4 = ((j + 2) & ~3); i4 < 64; i4 += 4) ab[(j + 1) & 1][i4 >> 2] = *(const LAS f32x4*)(AT + (j + 1) * 64 + i4);
            }
            __builtin_amdgcn_sched_barrier(0);
            const float xj = r[j];
#pragma unroll
            for (int i4 = ((j + 1) & ~3); i4 < 64; i4 += 4) {
                const f32x4 a = ab[j & 1][i4 >> 2];
                r[i4 + 0] -= a[0] * xj; r[i4 + 1] -= a[1] * xj; r[i4 + 2] -= a[2] * xj; r[i4 + 3] -= a[3] * xj;
            }
            __builtin_amdgcn_sched_barrier(0);
        }
#pragma unroll
        for (int i = 0; i < 64; ++i) RHS[i * 256 + c] = r[i];
    } else {
        const int d = (tid - 256) >> 1, th = tid & 1;
        const float gcl = GC[63];
        float x[32];
#pragma unroll
        for (int i = 0; i < 32; ++i) { const int t = 32 * th + i; x[i] = bf2f(KB[t * 136 + d]) * __expf(gcl - GC[t]); }
#pragma unroll
        for (int q = 0; q < 4; ++q) *(u32x4*)(KGTd + (((((d >> 4) * 2 + th) * 4 + q) * 16 + (d & 15)) * 8)) = pack8(x + 8 * q);
    }
    __syncthreads();
    {
#pragma unroll
        for (int k = 0; k < 4; ++k) {
            const int pi = tid + 512 * k, nn = pi & 1, ulr = (pi >> 1) & 15, ulq = (pi >> 5) & 3, um = (pi >> 7) & 3, usl = pi >> 9;
            const int row = 16 * um + 4 * ulq, col = 32 * usl + 16 * nn + ulr;
            u32x2 uw; uw.x = pk2(RHS[row * 256 + col], RHS[(row + 1) * 256 + col]); uw.y = pk2(RHS[(row + 2) * 256 + col], RHS[(row + 3) * 256 + col]);
            *(u32x2*)(Ud + pi * 4) = uw;
        }
#pragma unroll
        for (int k = 0; k < 2; ++k) {
            const int pw = tid + 512 * k, wl = pw & 63, wms = pw >> 6, row = 16 * (wms >> 2) + (wl & 15), c8 = 32 * (wms & 3) + 8 * (wl >> 4);
            const f32x4 v0 = *(const LAS f32x4*)(RHS + row * 256 + 128 + c8), v1 = *(const LAS f32x4*)(RHS + row * 256 + 128 + c8 + 4);
            u32x4 w; w.x = pk2(v0[0], v0[1]); w.y = pk2(v0[2], v0[3]); w.z = pk2(v1[0], v1[1]); w.w = pk2(v1[2], v1[3]);
            *(u32x4*)(Wd + pw * 8) = w;
        }
    }
    __syncthreads();
}

template <int W> __device__ __forceinline__ void pool_rows(const float (&uv)[47], LAS bf16_t* PB, int i0, int c, int t0) {
    float s = 0.f;
#pragma unroll
    for (int j = 1; j < W; ++j) s += uv[15 - j];
#pragma unroll
    for (int ii = 0; ii < 32; ++ii) {
        const float cur = uv[15 + ii];
        s += cur;
        const int tk = t0 + i0 + ii + 1;
        const float inv = tk < W ? __builtin_amdgcn_rcpf((float)tk) : (1.0f / (float)W);
        PB[(i0 + ii) * 136 + c] = f2bf(s * inv - cur);
        s -= uv[15 + ii - (W - 1)];
    }
}
__device__ __forceinline__ void pool_item(const Params& p, int l, int pidx, LAS unsigned char* lds) {
    const int tid = opq_tid(), wid = tid >> 6, lane = tid & 63;
    const int g = pidx & 3, T = pidx >> 2, w = 2 << g;
    const int rowbase = T * 128, b = rowbase >> 11, t0 = rowbase & 2047;
    LAS bf16_t* UT = (LAS bf16_t*)lds; LAS bf16_t* PB = (LAS bf16_t*)(lds + 38912); LAS bf16_t* WB = (LAS bf16_t*)(lds + 73728);
    const bf16_t* P0 = (const bf16_t*)(p.ws + WS_P0);
    const bf16_t* WtPool = (const bf16_t*)(p.ws + WS_WTPOOL) + (size_t)(l * 4 + g) * 16384;
    bf16_t* YM = (bf16_t*)(p.ws + WS_H);
#pragma unroll
    for (int q = 0; q < 4; ++q) { const int piece = tid + 512 * q, d = piece >> 4, k8 = (piece & 15) * 8; *(LAS u32x4*)(WB + d * 136 + k8) = *(const u32x4*)(WtPool + d * 128 + k8); }
#pragma unroll
    for (int q = 0; q < 5; ++q) {
        const int piece = tid + 512 * q;
        if (piece < 143 * 16) {
            const int rr = piece >> 4, c8 = (piece & 15) * 8, tok = t0 - 15 + rr;
            u32x4 v = *(const u32x4*)(P0 + (size_t)(b * 2048 + (tok < 0 ? 0 : tok)) * 1024 + g * 128 + c8);
            if (tok < 0) v = (u32x4){0u, 0u, 0u, 0u};
            *(LAS u32x4*)(UT + rr * 136 + c8) = v;
        }
    }
    __syncthreads();
    {
        const int c = tid & 127, q = tid >> 7, i0 = 32 * q;
        float uv[47];
#pragma unroll
        for (int k = 0; k < 47; ++k) uv[k] = bf2f(UT[(i0 + k) * 136 + c]);
        if (g == 0) pool_rows<2>(uv, PB, i0, c, t0); else if (g == 1) pool_rows<4>(uv, PB, i0, c, t0); else if (g == 2) pool_rows<8>(uv, PB, i0, c, t0); else pool_rows<16>(uv, PB, i0, c, t0);
        if (t0 == 1920 && q == 3) {
#pragma unroll
            for (int i = 113; i < 128; ++i) p.out[OPP + ((size_t)(l * 8 + b) * 15 + (i - 113)) * 512 + g * 128 + c] = uv[i - 96 + 15];
        }
    }
    __syncthreads();
    {
        const int lr = lane & 15, lq = lane >> 4;
        bf16x8 a[4];
#pragma unroll
        for (int s = 0; s < 4; ++s) a[s] = *(const LAS bf16x8*)(PB + (16 * wid + lr) * 136 + 32 * s + 8 * lq);
        const size_t prow = (size_t)(rowbase + 16 * wid + lr);
        u32x2 zr[8];
#pragma unroll
        for (int nt = 0; nt < 8; ++nt) zr[nt] = *(const u32x2*)(P0 + prow * 1024 + 512 + g * 128 + 16 * nt + 4 * lq);
#pragma unroll
        for (int nt = 0; nt < 8; ++nt) {
            f32x4 acc = {0.f, 0.f, 0.f, 0.f};
#pragma unroll
            for (int s = 0; s < 4; ++s) { const bf16x8 bb = *(const LAS bf16x8*)(WB + (16 * nt + lr) * 136 + 32 * s + 8 * lq); acc = __builtin_amdgcn_mfma_f32_16x16x32_bf16(bb, a[s], acc, 0, 0, 0); }
            const int d = g * 128 + 16 * nt + 4 * lq;
            const float4 ps = *(const float4*)(p.pool_scale + l * 512 + d);
            const float z0 = __uint_as_float(zr[nt].x << 16), z1 = __uint_as_float(zr[nt].x & 0xffff0000u), z2 = __uint_as_float(zr[nt].y << 16), z3 = __uint_as_float(zr[nt].y & 0xffff0000u);
            u32x2 w2; w2.x = pk2(acc[0] * ps.x * silu_f(z0), acc[1] * ps.y * silu_f(z1)); w2.y = pk2(acc[2] * ps.z * silu_f(z2), acc[3] * ps.w * silu_f(z3));
            *(u32x2*)(YM + prow * 1024 + d) = w2;
        }
    }
    __syncthreads();
}

__device__ __forceinline__ void sample_pool_item(const Params& p, int l, int sidx, LAS unsigned char* lds) {
    const int tid = opq_tid(), wid = tid >> 6, lane = tid & 63;
    const int g = sidx & 3, tq = sidx >> 2, w = 2 << g;
    LAS bf16_t* PB = (LAS bf16_t*)(lds + 38912); LAS bf16_t* WB = (LAS bf16_t*)(lds + 73728);
    const bf16_t* P0 = (const bf16_t*)(p.ws + WS_P0);
    const bf16_t* WtPool = (const bf16_t*)(p.ws + WS_WTPOOL) + (size_t)(l * 4 + g) * 16384;
    bf16_t* YM = (bf16_t*)(p.ws + WS_H);
#pragma unroll
    for (int q = 0; q < 4; ++q) { const int piece = tid + 512 * q, d = piece >> 4, k8 = (piece & 15) * 8; *(LAS u32x4*)(WB + d * 136 + k8) = *(const u32x4*)(WtPool + d * 128 + k8); }
    {
        const int c = tid & 127, q = tid >> 7;
#pragma unroll 2
        for (int ii = 0; ii < 8; ++ii) {
            const int il = 8 * q + ii, i = 32 * tq + il;
            const float cur = bf2f(P0[(size_t)(NP + i) * 1024 + g * 128 + c]);
            const float* sp = p.state_pool + ((size_t)(l * 128 + i) * 15) * 512 + g * 128 + c;
            float* op = p.out + OPS + ((size_t)(l * 128 + i) * 15) * 512 + g * 128 + c;
            float v[15];
#pragma unroll
            for (int j = 0; j < 15; ++j) v[j] = sp[(size_t)j * 512];
            float s = cur;
#pragma unroll
            for (int j = 0; j < 15; ++j) { if (14 - j <= w - 2) s += v[j]; if (j >= 1) op[(size_t)(j - 1) * 512] = v[j]; }
            op[(size_t)14 * 512] = cur;
            PB[il * 136 + c] = f2bf(s * (1.0f / (float)w) - cur);
        }
    }
    __syncthreads();
    if (wid < 2) {
        const int lr = lane & 15, lq = lane >> 4;
        bf16x8 a[4];
#pragma unroll
        for (int s = 0; s < 4; ++s) a[s] = *(const LAS bf16x8*)(PB + (16 * wid + lr) * 136 + 32 * s + 8 * lq);
        const size_t prow = (size_t)(NP + 32 * tq + 16 * wid + lr);
        u32x2 zr[8];
#pragma unroll
        for (int nt = 0; nt < 8; ++nt) zr[nt] = *(const u32x2*)(P0 + prow * 1024 + 512 + g * 128 + 16 * nt + 4 * lq);
#pragma unroll
        for (int nt = 0; nt < 8; ++nt) {
            f32x4 acc = {0.f, 0.f, 0.f, 0.f};
#pragma unroll
            for (int s = 0; s < 4; ++s) { const bf16x8 bb = *(const LAS bf16x8*)(WB + (16 * nt + lr) * 136 + 32 * s + 8 * lq); acc = __builtin_amdgcn_mfma_f32_16x16x32_bf16(bb, a[s], acc, 0, 0, 0); }
            const int d = g * 128 + 16 * nt + 4 * lq;
            const float4 ps = *(const float4*)(p.pool_scale + l * 512 + d);
            const float z0 = __uint_as_float(zr[nt].x << 16), z1 = __uint_as_float(zr[nt].x & 0xffff0000u), z2 = __uint_as_float(zr[nt].y << 16), z3 = __uint_as_float(zr[nt].y & 0xffff0000u);
            u32x2 w2; w2.x = pk2(acc[0] * ps.x * silu_f(z0), acc[1] * ps.y * silu_f(z1)); w2.y = pk2(acc[2] * ps.z * silu_f(z2), acc[3] * ps.w * silu_f(z3));
            *(u32x2*)(YM + prow * 1024 + d) = w2;
        }
    }
    __syncthreads();
}

__device__ __forceinline__ void sample_item(const Params& p, int l, int b, LAS unsigned char* lds) {
    const int tid = opq_tid(), wid = tid >> 6, lane = tid & 63;
    const int hd = tid >> 7, e = tid & 127;
    const size_t r = (size_t)(NP + b);
    LAS float* SQ = (LAS float*)lds; LAS float* SK = SQ + 512; LAS float* SV = SQ + 1024; LAS float* SO = SQ + 1536;
    LAS float* RED = SQ + 2048; LAS float* RED2 = SQ + 2560; LAS float* RW = SQ + 3072;
    const bf16_t* P1 = (const bf16_t*)(p.ws + WS_P1); const bf16_t* P2 = (const bf16_t*)(p.ws + WS_P2);
    const float* Gd = (const float*)(p.ws + WS_G); const float* Bd = (const float*)(p.ws + WS_BETA);
    bf16_t* YM = (bf16_t*)(p.ws + WS_H);
    const float* sc = p.state_conv + (size_t)(l * 128 + b) * 3 * 1536; const float* cw = p.conv_w + (size_t)l * 4 * 1536;
    float* oc = p.out + OCS + (size_t)(l * 128 + b) * 3 * 1536;
    const int part = hd;
    float sreg[32];
    {
        const float* Sin0 = p.state_ssm + ((size_t)((l * 128 + b) * 4 + 0) * 128) * 128;
#pragma unroll
        for (int dd = 0; dd < 32; ++dd) sreg[dd] = Sin0[(part * 32 + dd) * 128 + e];
    }
    float xin[3], cv[3];
    xin[0] = bf2f(P1[r * 1024 + tid]); xin[1] = bf2f(P1[r * 1024 + 512 + tid]); xin[2] = bf2f(P2[r * 1024 + tid]);
#pragma unroll
    for (int k = 0; k < 3; ++k) {
        const int ch = tid + 512 * k;
        const float b0 = sc[ch], b1 = sc[1536 + ch], b2 = sc[3072 + ch];
        cv[k] = silu_f(b0 * cw[ch] + b1 * cw[1536 + ch] + b2 * cw[3072 + ch] + xin[k] * cw[4608 + ch]);
        oc[ch] = b1; oc[1536 + ch] = b2; oc[3072 + ch] = xin[k];
    }
    const float sq = wave_sum(cv[0] * cv[0]), sk = wave_sum(cv[1] * cv[1]);
    if (lane == 0) { RW[wid] = sq; RW[8 + wid] = sk; }
    __syncthreads();
    {
        const float ssq = RW[2 * hd] + RW[2 * hd + 1], ssk = RW[8 + 2 * hd] + RW[8 + 2 * hd + 1];
        SQ[tid] = cv[0] * rsqrtf(ssq + 1e-6f) * 0.08838834764831845f; SK[tid] = cv[1] * rsqrtf(ssk + 1e-6f); SV[tid] = cv[2];
    }
    __syncthreads();
#pragma unroll 1
    for (int hh = 0; hh < 4; ++hh) {
        const float eg = __expf(Gd[r * 4 + hh]), bt = Bd[r * 4 + hh];
        float* Sout = p.out + OSS + ((size_t)((l * 128 + b) * 4 + hh) * 128) * 128;
        float kvp = 0.f;
#pragma unroll
        for (int dd = 0; dd < 32; ++dd) { sreg[dd] *= eg; kvp += SK[hh * 128 + part * 32 + dd] * sreg[dd]; }
        RED[part * 128 + e] = kvp;
        __syncthreads();
        const float kv = RED[e] + RED[128 + e] + RED[256 + e] + RED[384 + e];
        const float delta = (SV[hh * 128 + e] - kv) * bt;
        float op = 0.f;
#pragma unroll
        for (int dd = 0; dd < 32; ++dd) { const int d = part * 32 + dd; const float sv = sreg[dd] + SK[hh * 128 + d] * delta; Sout[d * 128 + e] = sv; op += SQ[hh * 128 + d] * sv; }
        if (hh < 3) {
            const float* Sin = p.state_ssm + ((size_t)((l * 128 + b) * 4 + hh + 1) * 128) * 128;
#pragma unroll
            for (int dd = 0; dd < 32; ++dd) sreg[dd] = Sin[(part * 32 + dd) * 128 + e];
        }
        RED2[part * 128 + e] = op;
        __syncthreads();
        if (part == 0) SO[hh * 128 + e] = RED2[e] + RED2[128 + e] + RED2[256 + e] + RED2[384 + e];
    }
    __syncthreads();
    const float o = SO[tid];
    const float so = wave_sum(o * o);
    if (lane == 0) RW[16 + wid] = so;
    __syncthreads();
    {
        const float rstd = rsqrtf((RW[16 + 2 * hd] + RW[16 + 2 * hd + 1]) * (1.0f / 128.0f) + 1e-6f);
        const float zb = bf2f(P2[r * 1024 + 512 + tid]);
        YM[r * 1024 + 512 + tid] = f2bf(o * rstd * p.o_norm_w[l * 128 + e] * silu_f(zb));
    }
    __syncthreads();
}

__device__ __forceinline__ void phase_post(const Params& p, int l, LAS unsigned char* lds) {
    for (int idx = blockIdx.x; idx < 1024 + 512; idx += gridDim.x) {
        if (idx < 1024) { if (!(SKIP & 128)) chunk_item<0>(p, l, idx, lds); }
        else { if (!(SKIP & 256)) pool_item(p, l, idx - 1024, lds); }
    }
}

struct ScanOps { bf16x8 aA[4]; bf16x8 kgA[2]; u32x4 x8[2]; float gl; };
struct ScanPtrs { const char* a; const char* kg; const char* x; const float* gl; int xitem, xstep; };
__device__ __forceinline__ void scan_load(ScanOps& o, const ScanPtrs& q, int nc) {
    const char* ap = q.a + (size_t)nc * 16384; const char* kp = q.kg + (size_t)nc * 16384; const char* xp = q.x + (size_t)nc * q.xitem;
#pragma unroll
    for (int s = 0; s < 4; ++s) o.aA[s] = *(const bf16x8*)(ap + 1024 * s);
#pragma unroll
    for (int s = 0; s < 2; ++s) o.kgA[s] = *(const bf16x8*)(kp + 1024 * s);
#pragma unroll
    for (int s = 0; s < 2; ++s) o.x8[s] = *(const u32x4*)(xp + s * q.xstep);
    o.gl = q.gl[nc];
}

__device__ __forceinline__ void scan_step(const ScanOps& c, int m, int hi, int wid, int lr, int lq, f32x4 (&Sacc)[2], LAS bf16_t* ST, LAS bf16_t* VT, LAS float* OB) {
    f32x4 acc[2] = {{0.f, 0.f, 0.f, 0.f}, {0.f, 0.f, 0.f, 0.f}};
#pragma unroll
    for (int s = 0; s < 4; ++s)
#pragma unroll
        for (int nn = 0; nn < 2; ++nn) {
            const bf16x8 sb = *(const LAS bf16x8*)(ST + (16 * nn + lr) * 136 + 32 * s + 8 * lq);
            acc[nn] = __builtin_amdgcn_mfma_f32_16x16x32_bf16(c.aA[s], sb, acc[nn], 0, 0, 0);
        }
    if (!hi) {
#pragma unroll
        for (int nn = 0; nn < 2; ++nn) {
            const unsigned ua = c.x8[0][2 * nn], ub = c.x8[0][2 * nn + 1];
            u32x2 w; w.x = pk2(__uint_as_float(ua << 16) - acc[nn][0], __uint_as_float(ua & 0xffff0000u) - acc[nn][1]); w.y = pk2(__uint_as_float(ub << 16) - acc[nn][2], __uint_as_float(ub & 0xffff0000u) - acc[nn][3]);
            *(LAS u32x2*)(VT + (16 * nn + lr) * 72 + 16 * m + 4 * lq) = w;
        }
    }
    __syncthreads();
    bf16x8 vb[2][2];
#pragma unroll
    for (int nn = 0; nn < 2; ++nn)
#pragma unroll
        for (int s = 0; s < 2; ++s) vb[nn][s] = *(const LAS bf16x8*)(VT + (16 * nn + lr) * 72 + 32 * s + 8 * lq);
    if (hi) {
#pragma unroll
        for (int nn = 0; nn < 2; ++nn) {
#pragma unroll
            for (int s = 0; s < 2; ++s) { bf16x8 qa; u32x4 t = c.x8[s]; __builtin_memcpy(&qa, &t, 16); acc[nn] = __builtin_amdgcn_mfma_f32_16x16x32_bf16(qa, vb[nn][s], acc[nn], 0, 0, 0); }
#pragma unroll
            for (int r = 0; r < 4; ++r) OB[(16 * m + 4 * lq + r) * 36 + 16 * nn + lr] = acc[nn][r];
        }
    }
#pragma unroll
    for (int nn = 0; nn < 2; ++nn) {
        Sacc[nn] = Sacc[nn] * c.gl;
        Sacc[nn] = __builtin_amdgcn_mfma_f32_16x16x32_bf16(c.kgA[0], vb[nn][0], Sacc[nn], 0, 0, 0);
        Sacc[nn] = __builtin_amdgcn_mfma_f32_16x16x32_bf16(c.kgA[1], vb[nn][1], Sacc[nn], 0, 0, 0);
        u32x2 w; w.x = pk2(Sacc[nn][0], Sacc[nn][1]); w.y = pk2(Sacc[nn][2], Sacc[nn][3]);
        *(LAS u32x2*)(ST + (16 * nn + lr) * 136 + 16 * wid + 4 * lq) = w;
    }
    __syncthreads();
}

__device__ __forceinline__ void scan_item(const Params& p, int l, int bh, int slice, LAS unsigned char* lds) {
    const int tid = opq_tid(), wid = tid >> 6, lane = tid & 63, lr = lane & 15, lq = lane >> 4, m = wid & 3, hi = wid >> 2;
    const int b = bh >> 2, h = bh & 3;
    LAS bf16_t* ST = (LAS bf16_t*)lds;
    LAS bf16_t* VT = (LAS bf16_t*)(lds + 8704);
    LAS float* OB = (LAS float*)(lds + 13312);
    for (int i = tid; i < 32 * 136 / 2; i += 512) ((LAS unsigned*)ST)[i] = 0u;
    f32x4 Sacc[2] = {{0.f, 0.f, 0.f, 0.f}, {0.f, 0.f, 0.f, 0.f}};
    ScanPtrs q;
    const size_t ci0 = (size_t)bh * 32;
    q.a = (const char*)(p.ws + (hi ? WS_QG : WS_W)) + ci0 * 16384 + (m * 4 * 64 + lane) * 16;
    q.kg = (const char*)(p.ws + WS_KGT) + ci0 * 16384 + (wid * 2 * 64 + lane) * 16;
    q.x = hi ? (const char*)(p.ws + WS_QK) + ci0 * 8192 + (m * 2 * 64 + lane) * 16
             : (const char*)(p.ws + WS_U) + ci0 * 16384 + ((((slice * 4 + m) * 4 + lq) * 16 + lr) * 8) * 2;
    q.xitem = hi ? 8192 : 16384; q.xstep = hi ? 1024 : 0;
    q.gl = (const float*)(p.ws + WS_GL) + ci0;
    bf16_t* Orow = (bf16_t*)(p.ws + WS_P1) + ((size_t)b * 2048 + (tid >> 3)) * 512 + h * 128 + 32 * slice + (tid & 7) * 4;
    const int obo = (tid >> 3) * 36 + (tid & 7) * 4;
    ScanOps st[4];
#pragma unroll
    for (int d = 0; d < 4; ++d) scan_load(st[d], q, d);
    __syncthreads();
#pragma unroll 1
    for (int nc0 = 0; nc0 < 32; nc0 += 4) {
#pragma unroll
        for (int d = 0; d < 4; ++d) {
            const int nc = nc0 + d;
            if (nc > 0) { const f32x4 ov = *(const LAS f32x4*)(OB + obo); u32x2 ow; ow.x = pk2(ov[0], ov[1]); ow.y = pk2(ov[2], ov[3]); *(u32x2*)(Orow + (size_t)(nc - 1) * 64 * 512) = ow; }
            scan_step(st[d], m, hi, wid, lr, lq, Sacc, ST, VT, OB);
            scan_load(st[d], q, nc + 4 < 32 ? nc + 4 : 31);
        }
    }
    { const f32x4 ov = *(const LAS f32x4*)(OB + obo); u32x2 ow; ow.x = pk2(ov[0], ov[1]); ow.y = pk2(ov[2], ov[3]); *(u32x2*)(Orow + (size_t)31 * 64 * 512) = ow; }
    float* So = p.out + OSP + ((size_t)((l * 8 + b) * 4 + h) * 128) * 128;
#pragma unroll
    for (int nn = 0; nn < 2; ++nn)
#pragma unroll
        for (int r = 0; r < 4; ++r) So[(16 * wid + 4 * lq + r) * 128 + 32 * slice + 16 * nn + lr] = Sacc[nn][r];
}

__device__ __forceinline__ void phase_scan(const Params& p, int l, LAS unsigned char* lds) {
    const int G = (int)gridDim.x, nscan = G >= 256 ? 128 : G / 2;
    if ((int)blockIdx.x < nscan) {
        for (int blk = blockIdx.x; blk < 128; blk += nscan) {
            const int bh = (blk & 7) + 8 * (blk >> 5), slice = (blk >> 3) & 3;
            scan_item(p, l, bh, slice, lds);
            __syncthreads();
        }
    } else {
        for (int it = (int)blockIdx.x - nscan; it < 128 + 16; it += G - nscan) {
            if (it < 128) sample_item(p, l, it, lds); else sample_pool_item(p, l, it - 128, lds);
        }
    }
}

__device__ __forceinline__ void phase_onorm(const Params& p, int l, int nskip) {
    if ((int)blockIdx.x < nskip) return;
    const int tid = opq_tid(), wid = tid >> 6, lane = tid & 63;
    const bf16_t* Od = (const bf16_t*)(p.ws + WS_P1); const bf16_t* P2 = (const bf16_t*)(p.ws + WS_P2); bf16_t* YM = (bf16_t*)(p.ws + WS_H);
    const int c = lane * 8;
    const float4 w0 = *(const float4*)(p.o_norm_w + l * 128 + (c & 127)), w1 = *(const float4*)(p.o_norm_w + l * 128 + (c & 127) + 4);
    for (int row = ((int)blockIdx.x - nskip) * 8 + wid; row < NP; row += ((int)gridDim.x - nskip) * 8) {
        float ov[8]; unpack8(*(const u32x4*)(Od + (size_t)row * 512 + c), ov);
        const float4 a = make_float4(ov[0], ov[1], ov[2], ov[3]), bq = make_float4(ov[4], ov[5], ov[6], ov[7]);
        float ss = a.x * a.x + a.y * a.y + a.z * a.z + a.w * a.w + bq.x * bq.x + bq.y * bq.y + bq.z * bq.z + bq.w * bq.w;
        ss += __shfl_xor(ss, 1); ss += __shfl_xor(ss, 2); ss += __shfl_xor(ss, 4); ss += __shfl_xor(ss, 8);
        const float rstd = rsqrtf(ss * (1.0f / 128.0f) + 1e-6f);
        float z[8]; unpack8(*(const u32x4*)(P2 + (size_t)row * 1024 + 512 + c), z);
        float y[8];
        y[0] = a.x * rstd * w0.x * silu_f(z[0]); y[1] = a.y * rstd * w0.y * silu_f(z[1]); y[2] = a.z * rstd * w0.z * silu_f(z[2]); y[3] = a.w * rstd * w0.w * silu_f(z[3]);
        y[4] = bq.x * rstd * w1.x * silu_f(z[4]); y[5] = bq.y * rstd * w1.y * silu_f(z[5]); y[6] = bq.z * rstd * w1.z * silu_f(z[6]); y[7] = bq.w * rstd * w1.w * silu_f(z[7]);
        *(u32x4*)(YM + (size_t)row * 1024 + 512 + c) = pack8(y);
    }
}

struct Sched : pg8::StaticOrder {
    int ppm, pcnt;
    __device__ __forceinline__ bool next(int i, pg8::Unit& u) const {
        if (ppm < 0) return pg8::StaticOrder::next(i, u);
        const long L = (long)i * G + c; if (L >= pcnt) return false;
        u.pm = ppm; u.pn = (int)L; return true;
    }
};
__global__ void __launch_bounds__(512, 2) mk_fwd(Params p) {
    extern __shared__ __attribute__((aligned(16))) unsigned char shm[];
    LAS unsigned char* lds = (LAS unsigned char*)shm;
    cg::grid_group grid = cg::this_grid();
    volatile XLAS unsigned* xst = (volatile XLAS unsigned*)(lds + 131072);
    if (threadIdx.x == 0) { xst[0] = 0u; xst[1] = 0u; }
    __syncthreads();
    const XcdBarrier xb = xcd_barrier_post((unsigned*)(p.ws + WS_BAR), xst);
    if (p.ph_lo < 0) grid.sync();
    for (int ph = p.ph_lo; ph < p.ph_hi; ++ph) {
        if (ph == 0) { if (!(SKIP & 1)) phase_convert(p, lds, 0); }
        else if (ph == 2) { if (!(SKIP & 2)) phase_rows(p, -1, 0, lds); }
        else {
            const int l = ph >= 3 ? (ph - 3) / 6 : 0, k = ph >= 3 ? (ph - 3) % 6 : -1;
            const int nsk = (int)gridDim.x > 8 ? 4 : 0;
            if (ph == 1) { if (!(SKIP & 4)) {
                pg8::Gemm g; pg8::EpiF32 E; Sched S; S.ppm = -1; S.pcnt = 0;
                g.A = (const bf16_t*)(p.ws + WS_AC); g.Bt = (const bf16_t*)(p.ws + WS_WTADA); g.M = 256; g.N = 6144; g.K = 1024; E.C = (float*)(p.ws + WS_MOD); E.ldc = 6144; E.bias = p.b_ada;
                S.init(g.M, g.N, (int)gridDim.x, (int)blockIdx.x);
                pg8::gemm_phase<pg8::EpiF32, Sched, false>(lds, g, S, E, nullptr);
                phase_convert(p, lds, 1); }
            } else if (k == 0 || k == 1 || k == 3 || k == 4) { if (!(SKIP & 8)) {
                pg8::Gemm g; pg8::EpiBf16<0> E; Sched S; E.bias = nullptr;
                g.A = (const bf16_t*)(p.ws + WS_H); g.K = 1024; g.M = NP;
                if (k <= 1) { g.Bt = (const bf16_t*)(p.ws + WS_WTIN) + (size_t)l * 3072 * 1024; g.N = 3072; E.O = (bf16_t*)(p.ws + WS_P0); E.ldc = 1024; E.split_cols = 1024; E.split_stride = (size_t)MPAD * 1024; }
                else { g.Bt = (const bf16_t*)(p.ws + WS_WTOUT) + (size_t)l * 1024 * 1024; g.N = 1024; E.O = (bf16_t*)(p.ws + WS_P0); E.ldc = 1024; E.split_cols = 0; E.split_stride = 0; }
                S.init(g.M, g.N, (int)gridDim.x, (int)blockIdx.x);
                S.ppm = (k == 1 || k == 3) ? 64 : -1; S.pcnt = (k == 1) ? 12 : 4;
                for (int rep = 0; rep < 1 + ((PROBE_KIND == 11 && k == 0) ? PROBE_N : 0); ++rep) pg8::gemm_phase<pg8::EpiBf16<0>, Sched, false>(lds, g, S, E, nullptr); }
                if (k == 1) { if (!(SKIP & 16)) phase_post(p, l, lds); }
                if (k == 3) { if (!(SKIP & 64)) phase_onorm(p, l, nsk); }
            }
            else if (k == 2) { if (!(SKIP & 32)) phase_scan(p, l, lds); }
            else if (k == 5) { if (!(SKIP & 2)) phase_rows(p, l, l + 1 < 2 ? l + 1 : -1, lds); }
        }
#if PROBE_KIND
        {
            const int l2 = ph >= 3 ? (ph - 3) / 6 : 0, k2 = ph >= 3 ? (ph - 3) % 6 : -1;
            for (int rep = 0; rep < PROBE_N; ++rep) {
                if (PROBE_KIND == 6 && ph == 2) xcd_barrier(xb);
                if (PROBE_KIND == 1 && k2 == 1) phase_post(p, l2, lds);
                if (PROBE_KIND == 3 && k2 == 3) phase_onorm(p, l2, 0);
                if (PROBE_KIND == 13 && k2 == 5 && l2 == 0) phase_rows(p, 0, 1, lds);
                if (PROBE_KIND == 14 && ph == 0) phase_convert(p, lds, 0);
                if (PROBE_KIND == 7 && k2 == 1) { for (int idx = blockIdx.x; idx < 1024; idx += gridDim.x) chunk_item<PROBE_N>(p, l2, idx, lds); }
                if (PROBE_KIND == 8 && k2 == 1) { for (int idx = blockIdx.x; idx < 512; idx += gridDim.x) pool_item(p, l2, idx, lds); }
                if (PROBE_KIND == 9 && k2 == 2) { if (blockIdx.x < 128) { const int blk = blockIdx.x; scan_item(p, l2, (blk & 7) + 8 * (blk >> 5), (blk >> 3) & 3, lds); __syncthreads(); } }
                if (PROBE_KIND == 10 && k2 == 2) { if (blockIdx.x >= 128) { for (int it = (int)blockIdx.x - 128; it < 144; it += 128) { if (it < 128) sample_item(p, l2, it, lds); else sample_pool_item(p, l2, it - 128, lds); } } }
                if (PROBE_KIND == 5 && ph == 2) phase_rows(p, -1, 0, lds);
            }
        }
#endif
        if (ph + 1 < p.ph_hi) xcd_barrier(xb);
    }
}

extern "C" void kernel_launch(void* const* d_in, const int* in_sizes, int n_in, void* d_out, int out_size, void* d_ws, size_t ws_size, hipStream_t stream) {
    static int grid = 0;
    if (grid == 0) {
        if (n_in != 19 || ws_size < WS_END) { fprintf(stderr, "kernel_launch: unexpected n_in %d or ws_size %zu (< %zu)\n", n_in, ws_size, (size_t)WS_END); grid = -1; return; }
        int dev = 0, cus = 0, per_cu = 0;
        hipGetDevice(&dev); hipDeviceGetAttribute(&cus, hipDeviceAttributeMultiprocessorCount, dev);
        if (hipFuncSetAttribute((const void*)mk_fwd, hipFuncAttributeMaxDynamicSharedMemorySize, LDS_BYTES) != hipSuccess) { fprintf(stderr, "kernel_launch: hipFuncSetAttribute failed\n"); }
        if (hipOccupancyMaxActiveBlocksPerMultiprocessor(&per_cu, (const void*)mk_fwd, 512, LDS_BYTES) != hipSuccess || per_cu < 1) per_cu = 1;
        (void)hipGetLastError();
        grid = cus * 1;
        if (grid <= 0) grid = 256;
    }
    if (grid < 0) return;
    if (hipMemsetAsync((char*)d_ws + WS_BAR, 0, 16384, stream) != hipSuccess) { fprintf(stderr, "kernel_launch: memset failed\n"); return; }
    Params p{};
    const float** f = (const float**)&p;
    for (int i = 0; i < 19; ++i) f[i] = (const float*)d_in[i];
    p.out = (float*)d_out; p.ws = (unsigned char*)d_ws; p.ph_lo = 0; p.ph_hi = 15;
    void* args[] = {&p};
    hipError_t e = hipLaunchCooperativeKernel((const void*)mk_fwd, dim3(grid), dim3(512), args, LDS_BYTES, stream);
    if (e != hipSuccess) fprintf(stderr, "cooperative launch failed: %s (grid %d)\n", hipGetErrorString(e), grid);
}
```
